# Optimizing an MI355X kernel written in HIP

```python
import jax, jax.numpy as jnp
from jax import lax
import numpy as np

D_MODEL = 1024
BATCH = 4
SEQ = 8192
DEPTH = 1

CHUNK = 64
N_MEM = 256
HEAD_DIM = D_MODEL // 16
A_HEADS = 8
B_HEADS = 4
C_HEADS = 4
A_WIDTH = A_HEADS * HEAD_DIM
B_WIDTH = B_HEADS * HEAD_DIM
C_WIDTH = C_HEADS * HEAD_DIM
MIX_WIDTH = A_WIDTH + B_WIDTH + C_WIDTH
IN_COLS = 3 * A_WIDTH + 4 * B_WIDTH + C_WIDTH
LEFT_CHUNKS = 8
BAND_CHUNKS = LEFT_CHUNKS + 1
MAX_REL_DIST = 128
REL_TABLE = MAX_REL_DIST + CHUNK
ROPE_BASE = 10000.0
N_GROUPS = 4
EXPERTS_PER_GROUP = 8
N_EXPERTS = N_GROUPS * EXPERTS_PER_GROUP
TOP_K = 2
D_EXPERT = D_MODEL // 2
ROW_BLOCK = 256
EPS = 1e-6
NEG_INF = -1e30

kernel_name = "hybrid_chunk_attn_retention_memxattn_hiermoe"


def rms_norm(x, g):
    xf = x.astype(jnp.float32)
    y = xf * lax.rsqrt(jnp.mean(xf * xf, axis=-1, keepdims=True) + EPS)
    return (y * g.astype(jnp.float32)).astype(x.dtype)


def split_heads(t, n_heads):
    b, s, _ = t.shape
    return t.reshape(b, s, n_heads, -1).transpose(0, 2, 1, 3)


def merge_heads(t):
    b, h, s, d = t.shape
    return t.transpose(0, 2, 1, 3).reshape(b, s, h * d)


def chunked_relpos_attention(q, k, v, rel_bias):
    b, h, s, dh = q.shape
    nc = s // CHUNK
    qc = q.reshape(b, h, nc, CHUNK, dh)
    pad = ((0, 0), (0, 0), (LEFT_CHUNKS * CHUNK, 0), (0, 0))
    kp = jnp.pad(k, pad).reshape(b, h, nc + LEFT_CHUNKS, CHUNK, dh)
    vp = jnp.pad(v, pad).reshape(b, h, nc + LEFT_CHUNKS, CHUNK, dh)
    band_idx = jnp.arange(nc)[:, None] + jnp.arange(BAND_CHUNKS)[None, :]
    kb = kp[:, :, band_idx].reshape(b, h, nc, BAND_CHUNKS * CHUNK, dh)
    vb = vp[:, :, band_idx].reshape(b, h, nc, BAND_CHUNKS * CHUNK, dh)
    scores = jnp.einsum('bhcqd,bhckd->bhcqk', qc, kb).astype(jnp.float32) * (dh ** -0.5)
    qpos = LEFT_CHUNKS * CHUNK + jnp.arange(CHUNK)
    kpos = jnp.arange(BAND_CHUNKS * CHUNK)
    rel = jnp.clip(qpos[:, None] - kpos[None, :], -(CHUNK - 1), MAX_REL_DIST) + (CHUNK - 1)
    bias = rel_bias[:, rel].astype(jnp.float32)
    valid = jnp.repeat(band_idx >= LEFT_CHUNKS, CHUNK, axis=1)
    scores = scores + bias[None, :, None]
    scores = jnp.where(valid[None, None, :, None, :], scores, NEG_INF)
    probs = jax.nn.softmax(scores, axis=-1).astype(v.dtype)
    out = jnp.einsum('bhcqk,bhckd->bhcqd', probs, vb)
    return out.reshape(b, h, s, dh)


def rotary(t, positions):
    half = t.shape[-1] // 2
    inv = ROPE_BASE ** (-jnp.arange(half, dtype=jnp.float32) / half)
    ang = positions.astype(jnp.float32)[:, None, :, None] * inv
    cos, sin = jnp.cos(ang), jnp.sin(ang)
    t1, t2 = t[..., :half], t[..., half:]
    return jnp.concatenate([t1 * cos - t2 * sin, t1 * sin + t2 * cos], axis=-1)


def chunkwise_retention(q, k, v):
    b, h, s, dh = q.shape
    nc = s // CHUNK
    log_g = jnp.log(1.0 - jnp.exp2(-5.0 - jnp.arange(h, dtype=jnp.float32)))
    idx = jnp.arange(CHUNK, dtype=jnp.float32)
    diff = idx[:, None] - idx[None, :]
    decay = jnp.where(diff >= 0, jnp.exp(log_g[:, None, None] * jnp.maximum(diff, 0.0)), 0.0)
    qc = q.reshape(b, h, nc, CHUNK, dh)
    kc = k.reshape(b, h, nc, CHUNK, dh)
    vc = v.reshape(b, h, nc, CHUNK, dh)
    inner = jnp.einsum('bhcqd,bhckd->bhcqk', qc, kc) * decay[None, :, None]
    inner_out = jnp.einsum('bhcqk,bhckd->bhcqd', inner, vc)
    zeta = jnp.exp(log_g[:, None] * (CHUNK - 1 - idx))
    kv = jnp.einsum('bhckd,hk,bhcke->bhcde', kc, zeta, vc)
    chunk_decay = jnp.exp(log_g * CHUNK)[None, :, None, None]

    def step(state, kv_c):
        return chunk_decay * state + kv_c, state

    _, states_prev = lax.scan(step, jnp.zeros((b, h, dh, dh), jnp.float32), jnp.moveaxis(kv, 2, 0))
    states_prev = jnp.moveaxis(states_prev, 0, 2)
    xi = jnp.exp(log_g[:, None] * (idx + 1.0))
    cross = jnp.einsum('bhcqd,bhcde->bhcqe', qc, states_prev) * xi[None, :, None, :, None]
    return (inner_out + cross).reshape(b, h, s, dh)


def head_group_norm(o, g):
    mu = jnp.mean(o, axis=-1, keepdims=True)
    var = jnp.mean(jnp.square(o - mu), axis=-1, keepdims=True)
    y = (o - mu) * lax.rsqrt(var + EPS)
    return merge_heads(y) * g.astype(jnp.float32)


def memory_cross_attention(q, mem_n, w_mem_kv, qn_c, kn_c):
    kv = mem_n @ w_mem_kv
    k, v = jnp.split(kv, 2, axis=-1)
    qh = rms_norm(split_heads(q, C_HEADS), qn_c)
    kh = rms_norm(split_heads(k, C_HEADS), kn_c)
    vh = split_heads(v, C_HEADS)
    scores = jnp.einsum('bhsd,bhmd->bhsm', qh, kh).astype(jnp.float32) * (HEAD_DIM ** -0.5)
    probs = jax.nn.softmax(scores, axis=-1).astype(vh.dtype)
    return merge_heads(jnp.einsum('bhsm,bhmd->bhsd', probs, vh))


def hierarchical_moe(hf, w_router_group, b_router_group, w_router_expert, b_router_expert,
                     w_gate, w_up, w_down):
    t, d = hf.shape
    g_prob = jax.nn.softmax((hf @ w_router_group + b_router_group).astype(jnp.float32), axis=-1)
    g_sel = jnp.argmax(g_prob, axis=-1)
    p_group = jnp.take_along_axis(g_prob, g_sel[:, None], axis=-1)[:, 0]
    e_logits = (hf @ w_router_expert + b_router_expert).astype(jnp.float32)
    e_logits = e_logits.reshape(t, N_GROUPS, EXPERTS_PER_GROUP)
    e_in_group = jnp.take_along_axis(e_logits, g_sel[:, None, None], axis=1)[:, 0]
    e_prob = jax.nn.softmax(e_in_group, axis=-1)
    top_p, top_i = lax.top_k(e_prob, TOP_K)
    top_p = top_p / jnp.sum(top_p, axis=-1, keepdims=True)
    weights = p_group[:, None] * top_p
    expert_id = g_sel[:, None] * EXPERTS_PER_GROUP + top_i

    n_assign = t * TOP_K
    flat_e = expert_id.reshape(-1).astype(jnp.int32)
    flat_t = jnp.repeat(jnp.arange(t, dtype=jnp.int32), TOP_K)
    flat_w = weights.reshape(-1)
    order = jnp.argsort(flat_e)
    e_s, t_s, w_s = flat_e[order], flat_t[order], flat_w[order]
    counts = jnp.bincount(flat_e, length=N_EXPERTS)
    starts = jnp.cumsum(counts) - counts
    padded = (counts + ROW_BLOCK - 1) // ROW_BLOCK * ROW_BLOCK
    pends = jnp.cumsum(padded)
    pstarts = pends - padded
    dest = pstarts[e_s] + (jnp.arange(n_assign) - starts[e_s])
    n_blocks = -(-n_assign // ROW_BLOCK) + N_EXPERTS
    n_rows = n_blocks * ROW_BLOCK
    row_tok = jnp.zeros((n_rows,), jnp.int32).at[dest].set(t_s)
    row_w = jnp.zeros((n_rows,), hf.dtype).at[dest].set(w_s.astype(hf.dtype))
    block_e = jnp.minimum(jnp.searchsorted(pends, jnp.arange(n_blocks) * ROW_BLOCK, side='right'),
                          N_EXPERTS - 1)
    xs = hf[row_tok].reshape(n_blocks, ROW_BLOCK, d)

    def expert_block(args):
        xb, e = args
        return (jax.nn.silu(xb @ w_gate[e]) * (xb @ w_up[e])) @ w_down[e]

    ys = lax.map(expert_block, (xs, block_e)).reshape(n_rows, d)
    return jnp.zeros((t, d), hf.dtype).at[row_tok].add(ys * row_w[:, None])


def setup_inputs(seed: int = 0) -> dict:
    key = jax.random.key(seed)
    ks = jax.random.split(key, 24)
    f32 = jnp.float32
    nrm = lambda k, shape, scale: jax.random.normal(k, shape, f32) * scale
    gain = lambda k, shape: 1.0 + 0.02 * jax.random.normal(k, shape, f32)
    return {
        "x": nrm(ks[0], (BATCH, SEQ, D_MODEL), 1.0),
        "mem": nrm(ks[1], (BATCH, N_MEM, D_MODEL), 1.0),
        "positions": jnp.broadcast_to(jnp.arange(SEQ, dtype=jnp.int32), (BATCH, SEQ)),
        "mix_norm_g": gain(ks[2], (D_MODEL,)),
        "w_in": nrm(ks[3], (D_MODEL, IN_COLS), D_MODEL ** -0.5),
        "qn_a": gain(ks[4], (HEAD_DIM,)),
        "kn_a": gain(ks[5], (HEAD_DIM,)),
        "rel_bias": nrm(ks[6], (A_HEADS, REL_TABLE), 0.2),
        "ret_gn_g": gain(ks[7], (B_WIDTH,)),
        "mem_norm_g": gain(ks[8], (D_MODEL,)),
        "w_mem_kv": nrm(ks[9], (D_MODEL, 2 * C_WIDTH), D_MODEL ** -0.5),
        "qn_c": gain(ks[10], (HEAD_DIM,)),
        "kn_c": gain(ks[11], (HEAD_DIM,)),
        "w_out": nrm(ks[12], (MIX_WIDTH, D_MODEL), MIX_WIDTH ** -0.5),
        "ffn_norm_g": gain(ks[13], (D_MODEL,)),
        "w_router_group": nrm(ks[14], (D_MODEL, N_GROUPS), D_MODEL ** -0.5),
        "b_router_group": nrm(ks[15], (N_GROUPS,), 0.01),
        "w_router_expert": nrm(ks[16], (D_MODEL, N_EXPERTS), D_MODEL ** -0.5),
        "b_router_expert": nrm(ks[17], (N_EXPERTS,), 0.01),
        "w_gate": nrm(ks[18], (N_EXPERTS, D_MODEL, D_EXPERT), D_MODEL ** -0.5),
        "w_up": nrm(ks[19], (N_EXPERTS, D_MODEL, D_EXPERT), D_MODEL ** -0.5),
        "w_down": nrm(ks[20], (N_EXPERTS, D_EXPERT, D_MODEL), D_EXPERT ** -0.5),
    }


def reference(x, mem, positions, mix_norm_g, w_in, qn_a, kn_a, rel_bias, ret_gn_g, mem_norm_g,
              w_mem_kv, qn_c, kn_c, w_out, ffn_norm_g, w_router_group, b_router_group,
              w_router_expert, b_router_expert, w_gate, w_up, w_down):
    b, s, d = x.shape
    splits = [int(v) for v in np.cumsum([A_WIDTH, A_WIDTH, A_WIDTH, B_WIDTH, B_WIDTH, B_WIDTH, B_WIDTH])]
    mem_n = rms_norm(mem, mem_norm_g)
    h = x
    for _ in range(DEPTH):
        xn = rms_norm(h, mix_norm_g)
        proj = xn @ w_in
        qa, ka, va, qb, kb, vb, gb, qc = jnp.split(proj, splits, axis=-1)
        qah = rms_norm(split_heads(qa, A_HEADS), qn_a)
        kah = rms_norm(split_heads(ka, A_HEADS), kn_a)
        out_a = merge_heads(chunked_relpos_attention(qah, kah, split_heads(va, A_HEADS), rel_bias))
        qbh = rotary(split_heads(qb, B_HEADS).astype(jnp.float32), positions)
        kbh = rotary(split_heads(kb, B_HEADS).astype(jnp.float32), positions) * (HEAD_DIM ** -0.5)
        vbh = split_heads(vb, B_HEADS).astype(jnp.float32)
        ret = head_group_norm(chunkwise_retention(qbh, kbh, vbh), ret_gn_g)
        out_b = (jax.nn.silu(gb.astype(jnp.float32)) * ret).astype(h.dtype)
        out_c = memory_cross_attention(qc, mem_n, w_mem_kv, qn_c, kn_c)
        h = h + jnp.concatenate([out_a, out_b, out_c], axis=-1) @ w_out
        hn = rms_norm(h, ffn_norm_g).reshape(b * s, d)
        h = h + hierarchical_moe(hn, w_router_group, b_router_group, w_router_expert,
                                 b_router_expert, w_gate, w_up, w_down).reshape(b, s, d)
    return h
```

```cpp
#include <hip/hip_runtime.h>
#include <cstdio>
#include <cstdint>

typedef unsigned short bf16;
typedef float f32x4 __attribute__((ext_vector_type(4)));
typedef unsigned u32x4 __attribute__((ext_vector_type(4)));
typedef unsigned u32x2 __attribute__((ext_vector_type(2)));

constexpr int T = 32768, D = 1024, SEQ = 8192, NBATCH = 4, NMEM = 256, MEMROWS = NBATCH * NMEM;
constexpr int HD = 64, AH = 8, BH = 4, CH = 4;
constexpr int INCOLS = 2816, KVCOLS = 512;
constexpr int CHUNK = 64, NCHUNK = SEQ / CHUNK;
constexpr int NE = 32, DE = 512;
constexpr int MAXBLK = 288;
constexpr float EPS = 1e-6f;
constexpr float LOG2E = 1.4426950408889634f;
constexpr float QSCALE = 0.125f * LOG2E;

constexpr size_t MiB = 1u << 20;
constexpr size_t WS_CTL = 0, CTL_BYTES = 1 * MiB;
constexpr size_t WS_WINT = 2 * MiB;
constexpr size_t WS_WOUTT = 9 * MiB;
constexpr size_t WS_WGUT = 12 * MiB;
constexpr size_t WS_WDT = 76 * MiB;
constexpr size_t WS_XN = 108 * MiB;
constexpr size_t WS_ACT = 108 * MiB;
constexpr size_t WS_QA = 180 * MiB, WS_KA = 212 * MiB, WS_VA = 244 * MiB, WS_QB = 276 * MiB, WS_KB = 292 * MiB, WS_VB = 308 * MiB, WS_GB = 324 * MiB, WS_QC = 340 * MiB;
constexpr size_t WS_KM = 356 * MiB, WS_VM = 356 * MiB + 512 * 1024;
constexpr size_t WS_YB = 180 * MiB;
constexpr size_t WS_RKV = 357 * MiB;
constexpr size_t WS_CAT = 389 * MiB;
constexpr size_t WS_HN = 389 * MiB;
constexpr size_t WS_ROWTOK = 453 * MiB, WS_ROWW = 457 * MiB, WS_TOKTAB = 461 * MiB, WS_END = 462 * MiB;
constexpr int CW_CNT = 64;

struct PB { bf16 *QA, *KA, *VA, *QB, *KB, *VB, *GB, *QC, *KM, *VM; };

__device__ __forceinline__ float bf2f(bf16 v) { return __uint_as_float(((unsigned)v) << 16); }
__device__ __forceinline__ bf16 f2bf(float f) { unsigned u = __float_as_uint(f); return (bf16)((u + 0x7fffu + ((u >> 16) & 1u)) >> 16); }
__device__ __forceinline__ unsigned pk2(float lo, float hi) { return (unsigned)f2bf(lo) | ((unsigned)f2bf(hi) << 16); }
__device__ __forceinline__ float wave_sum(float v) {
#pragma unroll
    for (int o = 1; o < 64; o <<= 1) v += __shfl_xor(v, o);
    return v;
}
__device__ __forceinline__ float silu_f(float x) { return x / (1.f + __expf(-x)); }

__device__ __forceinline__ bf16* proj_ptr(const PB& pb, int row, int col) {
    if (col < 512) return pb.QA + (size_t)row * 512 + col;
    if (col < 1024) return pb.KA + (size_t)row * 512 + (col - 512);
    if (col < 1536) return pb.VA + (size_t)row * 512 + (col - 1024);
    if (col < 1792) return pb.QB + (size_t)row * 256 + (col - 1536);
    if (col < 2048) return pb.KB + (size_t)row * 256 + (col - 1792);
    if (col < 2304) return pb.VB + (size_t)row * 256 + (col - 2048);
    if (col < 2560) return pb.GB + (size_t)row * 256 + (col - 2304);
    if (col < 2816) return pb.QC + (size_t)row * 256 + (col - 2560);
    if (col < 3072) return pb.KM + (size_t)(row - T) * 256 + (col - 2816);
    return pb.VM + (size_t)(row - T) * 256 + (col - 3072);
}

__device__ __forceinline__ void transpose_item(const float* W, int K, int N, bf16* WT, int row_off, float* scr, int item, int lane) {
    const int nblk = N / 32, kb = item / nblk, nb = item % nblk, k0 = 64 * kb, n0 = 32 * nb;
#pragma unroll 8
    for (int i = 0; i < 32; ++i) { const int kk = 2 * i + (lane >> 5); scr[kk * 33 + (lane & 31)] = W[(size_t)(k0 + kk) * N + n0 + (lane & 31)]; }
    asm volatile("s_waitcnt lgkmcnt(0)" ::: "memory");
    const int c = lane & 7;
#pragma unroll
    for (int j = 0; j < 4; ++j) { const int n = (lane >> 3) + 8 * j; const float* s = scr + (8 * c) * 33 + n;
        u32x4 o; o.x = pk2(s[0 * 33], s[1 * 33]); o.y = pk2(s[2 * 33], s[3 * 33]); o.z = pk2(s[4 * 33], s[5 * 33]); o.w = pk2(s[6 * 33], s[7 * 33]);
        *(u32x4*)(WT + (size_t)(row_off + n0 + n) * K + k0 + 8 * c) = o; }
    asm volatile("s_waitcnt lgkmcnt(0)" ::: "memory");
}
__device__ __forceinline__ void rms_row_to_bf16(const float* xrow, const float* gain, bf16* orow, int lane) {
    const f32x4* xr = (const f32x4*)xrow + lane; const f32x4* gr = (const f32x4*)gain + lane;
    f32x4 v[4]; float s = 0.f;
#pragma unroll
    for (int j = 0; j < 4; ++j) { v[j] = xr[64 * j]; s += (v[j].x * v[j].x + v[j].y * v[j].y) + (v[j].z * v[j].z + v[j].w * v[j].w); }
    const float r = 1.f / sqrtf(wave_sum(s) * (1.f / D) + EPS);
    unsigned long long* o8 = (unsigned long long*)orow + lane;
#pragma unroll
    for (int j = 0; j < 4; ++j) { const f32x4 g = gr[64 * j];
        o8[64 * j] = (unsigned long long)pk2(v[j].x * r * g.x, v[j].y * r * g.y) | ((unsigned long long)pk2(v[j].z * r * g.z, v[j].w * r * g.w) << 32); }
}

struct P0Args { const float *x, *mem, *g_mix, *g_mem, *w_in, *w_mem_kv, *w_out, *w_gate, *w_up, *w_down; bf16 *XN, *WinT, *WoutT, *WguT, *WdT; };
__global__ void __launch_bounds__(512) k_prologue(P0Args a) {
    __shared__ float scr_all[8 * 64 * 33];
    const int lane = threadIdx.x & 63, wave = threadIdx.x >> 6;
    float* scr = scr_all + wave * 64 * 33;
    const int gw = blockIdx.x * 8 + wave, NGW = gridDim.x * 8;
    constexpr int I_IN = 16 * 88, I_KV = 16 * 16, I_O = 16 * 32, I_E = 256;
    constexpr int NITEMS = I_IN + I_KV + I_O + NE * 3 * I_E;
    for (int it = gw; it < NITEMS; it += NGW) {
        int r = it;
        if (r < I_IN) { transpose_item(a.w_in, D, INCOLS, a.WinT, 0, scr, r, lane); continue; } r -= I_IN;
        if (r < I_KV) { transpose_item(a.w_mem_kv, D, KVCOLS, a.WinT, INCOLS, scr, r, lane); continue; } r -= I_KV;
        if (r < I_O) { transpose_item(a.w_out, D, D, a.WoutT, 0, scr, r, lane); continue; } r -= I_O;
        const int e = r / (3 * I_E), q = r % (3 * I_E);
        if (q < I_E) transpose_item(a.w_gate + (size_t)e * D * DE, D, DE, a.WguT + (size_t)e * D * D, 0, scr, q, lane);
        else if (q < 2 * I_E) transpose_item(a.w_up + (size_t)e * D * DE, D, DE, a.WguT + (size_t)e * D * D, DE, scr, q - I_E, lane);
        else transpose_item(a.w_down + (size_t)e * DE * D, DE, D, a.WdT + (size_t)e * D * DE, 0, scr, q - 2 * I_E, lane);
    }
    for (int m = gw; m < T + MEMROWS; m += NGW) {
        if (m < T) rms_row_to_bf16(a.x + (size_t)m * D, a.g_mix, a.XN + (size_t)m * D, lane);
        else rms_row_to_bf16(a.mem + (size_t)(m - T) * D, a.g_mem, a.XN + (size_t)m * D, lane);
    }
}

template <bool DUAL, class RowMap, class Epi>
__device__ __forceinline__ void nv_gemm_tile(const bf16* A, int lda, const float* B, const float* B2, int ldb, int K, int row0, int col0, RowMap rm, Epi epi) {
    __shared__ float As[16][68];
    __shared__ float Bs[16][68];
    __shared__ float Bs2[DUAL ? 16 : 1][68];
    const int tid = threadIdx.x, tx = tid & 15, ty = tid >> 4;
    float acc[4][4], acc2[4][4];
#pragma unroll
    for (int i = 0; i < 4; ++i)
#pragma unroll
        for (int j = 0; j < 4; ++j) { acc[i][j] = 0.f; acc2[i][j] = 0.f; }
    const int ar = tid >> 2, akq = (tid & 3) * 4;
    const bf16* arow = A + (size_t)rm(row0 + ar) * lda + akq;
    const int bk = tid >> 4, bn = (tid & 15) * 4;
    for (int k0 = 0; k0 < K; k0 += 16) {
        const u32x2 av = *(const u32x2*)(arow + k0);
        As[akq + 0][ar] = __uint_as_float(av.x << 16); As[akq + 1][ar] = __uint_as_float(av.x & 0xffff0000u);
        As[akq + 2][ar] = __uint_as_float(av.y << 16); As[akq + 3][ar] = __uint_as_float(av.y & 0xffff0000u);
        const f32x4 bv = *(const f32x4*)(B + (size_t)(k0 + bk) * ldb + col0 + bn);
        Bs[bk][bn] = bv.x; Bs[bk][bn + 1] = bv.y; Bs[bk][bn + 2] = bv.z; Bs[bk][bn + 3] = bv.w;
        if (DUAL) { const f32x4 b2 = *(const f32x4*)(B2 + (size_t)(k0 + bk) * ldb + col0 + bn);
            Bs2[bk][bn] = b2.x; Bs2[bk][bn + 1] = b2.y; Bs2[bk][bn + 2] = b2.z; Bs2[bk][bn + 3] = b2.w; }
        __syncthreads();
#pragma unroll
        for (int k = 0; k < 16; ++k) {
            float a[4], b[4], c[4];
#pragma unroll
            for (int i = 0; i < 4; ++i) { a[i] = As[k][ty * 4 + i]; b[i] = Bs[k][tx * 4 + i]; c[i] = DUAL ? Bs2[k][tx * 4 + i] : 0.f; }
#pragma unroll
            for (int i = 0; i < 4; ++i)
#pragma unroll
                for (int j = 0; j < 4; ++j) { acc[i][j] += a[i] * b[j]; if (DUAL) acc2[i][j] += a[i] * c[j]; }
        }
        __syncthreads();
    }
#pragma unroll
    for (int i = 0; i < 4; ++i)
#pragma unroll
        for (int j = 0; j < 4; ++j) epi(row0 + ty * 4 + i, col0 + tx * 4 + j, acc[i][j], acc2[i][j]);
}
struct IdMap { __device__ __forceinline__ int operator()(int r) const { return r; } };

__global__ void __launch_bounds__(256) k_nv_inproj(const bf16* XN, const float* W, int ldb, int rowbase, int coloff, PB pb) {
    const int row0 = rowbase + blockIdx.y * 64, col0 = blockIdx.x * 64;
    auto epi = [&](int r, int c, float v, float) { *proj_ptr(pb, r, c + coloff) = f2bf(v); };
    nv_gemm_tile<false>(XN, D, W, nullptr, ldb, D, row0, col0, IdMap(), epi);
}
__global__ void __launch_bounds__(256) k_nv_outproj(const bf16* CAT, const float* W, const float* X, float* OUT) {
    const int row0 = blockIdx.y * 64, col0 = blockIdx.x * 64;
    auto epi = [&](int r, int c, float v, float) { OUT[(size_t)r * D + c] = X[(size_t)r * D + c] + v; };
    nv_gemm_tile<false>(CAT, D, W, nullptr, D, D, row0, col0, IdMap(), epi);
}

__global__ void __launch_bounds__(256) k_nv_postproc(PB pb, const int* positions, const float* qn_a, const float* kn_a, const float* qn_c, const float* kn_c) {
    const long id = (long)blockIdx.x * 256 + threadIdx.x;
    bf16* p; const float* gain = nullptr; float scale = 1.f; int mode; int row;
    if (id < (long)T * 32) {
        row = (int)(id >> 5); const int hi = (int)(id & 31);
        if (hi < 8) { p = pb.QA + (size_t)row * 512 + hi * 64; gain = qn_a; scale = QSCALE; mode = 0; }
        else if (hi < 16) { p = pb.KA + (size_t)row * 512 + (hi - 8) * 64; gain = kn_a; mode = 0; }
        else if (hi < 20) { p = pb.QB + (size_t)row * 256 + (hi - 16) * 64; mode = 1; }
        else if (hi < 24) { p = pb.KB + (size_t)row * 256 + (hi - 20) * 64; mode = 1; scale = 0.125f; }
        else if (hi < 28) { p = pb.GB + (size_t)row * 256 + (hi - 24) * 64; mode = 2; }
        else { p = pb.QC + (size_t)row * 256 + (hi - 28) * 64; gain = qn_c; scale = QSCALE; mode = 0; }
    } else {
        const long id2 = id - (long)T * 32; if (id2 >= MEMROWS * 4) return;
        row = (int)(id2 >> 2); p = pb.KM + (size_t)row * 256 + (id2 & 3) * 64; gain = kn_c; mode = 0;
    }
    if (mode == 0) {
        float ss = 0.f;
        for (int d = 0; d < 64; ++d) { const float v = bf2f(p[d]); ss += v * v; }
        const float r = 1.f / sqrtf(ss * (1.f / 64.f) + EPS);
        for (int d = 0; d < 64; ++d) p[d] = f2bf(bf2f(p[d]) * r * gain[d] * scale);
    } else if (mode == 1) {
        const float pos = (float)positions[row];
        for (int i = 0; i < 32; ++i) {
            const float inv = exp2f(-(float)i * (13.287712379549449f / 32.f));
            float rev = pos * inv * 0.15915494309189535f; rev -= floorf(rev);
            const float sn = __builtin_amdgcn_sinf(rev), cs = __builtin_amdgcn_cosf(rev);
            const float t1 = bf2f(p[i]), t2 = bf2f(p[i + 32]);
            p[i] = f2bf((t1 * cs - t2 * sn) * scale); p[i + 32] = f2bf((t1 * sn + t2 * cs) * scale);
        }
    } else {
        for (int d = 0; d < 64; ++d) p[d] = f2bf(silu_f(bf2f(p[d])));
    }
}

__global__ void __launch_bounds__(64) k_nv_attnA(const bf16* QA, const bf16* KA, const bf16* VA, const float* rel_bias, bf16* CAT) {
    const int c = blockIdx.x % NCHUNK, h = (blockIdx.x / NCHUNK) % AH, b = blockIdx.x / (NCHUNK * AH);
    const int i = threadIdx.x; const size_t qrow = (size_t)b * SEQ + c * CHUNK + i;
    float q[64];
#pragma unroll
    for (int d8 = 0; d8 < 8; ++d8) { const u32x4 v = *(const u32x4*)(QA + qrow * 512 + h * 64 + d8 * 8);
        q[d8 * 8 + 0] = __uint_as_float(v.x << 16); q[d8 * 8 + 1] = __uint_as_float(v.x & 0xffff0000u); q[d8 * 8 + 2] = __uint_as_float(v.y << 16); q[d8 * 8 + 3] = __uint_as_float(v.y & 0xffff0000u);
        q[d8 * 8 + 4] = __uint_as_float(v.z << 16); q[d8 * 8 + 5] = __uint_as_float(v.z & 0xffff0000u); q[d8 * 8 + 6] = __uint_as_float(v.w << 16); q[d8 * 8 + 7] = __uint_as_float(v.w & 0xffff0000u); }
    const float* bias = rel_bias + h * 192;
    float m = -3.0e38f;
    for (int pass = 0; pass < 2; ++pass) {
        float l = 0.f; float o[64];
#pragma unroll
        for (int d = 0; d < 64; ++d) o[d] = 0.f;
        for (int j = 0; j < 9; ++j) {
            const int kc = c - 8 + j; if (kc < 0) continue;
            for (int kk = 0; kk < 64; ++kk) {
                const size_t krow = (size_t)b * SEQ + kc * CHUNK + kk;
                const bf16* kp = KA + krow * 512 + h * 64;
                float s = 0.f;
#pragma unroll
                for (int d8 = 0; d8 < 8; ++d8) { const u32x4 v = *(const u32x4*)(kp + d8 * 8);
                    s += q[d8 * 8 + 0] * __uint_as_float(v.x << 16) + q[d8 * 8 + 1] * __uint_as_float(v.x & 0xffff0000u) + q[d8 * 8 + 2] * __uint_as_float(v.y << 16) + q[d8 * 8 + 3] * __uint_as_float(v.y & 0xffff0000u)
                       + q[d8 * 8 + 4] * __uint_as_float(v.z << 16) + q[d8 * 8 + 5] * __uint_as_float(v.z & 0xffff0000u) + q[d8 * 8 + 6] * __uint_as_float(v.w << 16) + q[d8 * 8 + 7] * __uint_as_float(v.w & 0xffff0000u); }
                int rel = (8 - j) * 64 + i - kk; rel = rel < -63 ? -63 : (rel > 128 ? 128 : rel);
                s += bias[rel + 63] * LOG2E;
                if (pass == 0) { m = fmaxf(m, s); }
                else {
                    const float p = exp2f(s - m); l += p;
                    const bf16* vp = VA + krow * 512 + h * 64;
#pragma unroll
                    for (int d8 = 0; d8 < 8; ++d8) { const u32x4 v = *(const u32x4*)(vp + d8 * 8);
                        o[d8 * 8 + 0] += p * __uint_as_float(v.x << 16); o[d8 * 8 + 1] += p * __uint_as_float(v.x & 0xffff0000u); o[d8 * 8 + 2] += p * __uint_as_float(v.y << 16); o[d8 * 8 + 3] += p * __uint_as_float(v.y & 0xffff0000u);
                        o[d8 * 8 + 4] += p * __uint_as_float(v.z << 16); o[d8 * 8 + 5] += p * __uint_as_float(v.z & 0xffff0000u); o[d8 * 8 + 6] += p * __uint_as_float(v.w << 16); o[d8 * 8 + 7] += p * __uint_as_float(v.w & 0xffff0000u); }
                }
            }
        }
        if (pass == 1) {
            const float il = 1.f / l; bf16* op = CAT + qrow * D + h * 64;
#pragma unroll
            for (int d = 0; d < 64; d += 2) *(unsigned*)(op + d) = pk2(o[d] * il, o[d + 1] * il);
        }
    }
}
__global__ void __launch_bounds__(64) k_nv_cross(const bf16* QC, const bf16* KM, const bf16* VM, bf16* CAT) {
    const int c = blockIdx.x % NCHUNK, h = (blockIdx.x / NCHUNK) % CH, b = blockIdx.x / (NCHUNK * CH);
    const int i = threadIdx.x; const size_t qrow = (size_t)b * SEQ + c * CHUNK + i;
    float q[64];
#pragma unroll
    for (int d8 = 0; d8 < 8; ++d8) { const u32x4 v = *(const u32x4*)(QC + qrow * 256 + h * 64 + d8 * 8);
        q[d8 * 8 + 0] = __uint_as_float(v.x << 16); q[d8 * 8 + 1] = __uint_as_float(v.x & 0xffff0000u); q[d8 * 8 + 2] = __uint_as_float(v.y << 16); q[d8 * 8 + 3] = __uint_as_float(v.y & 0xffff0000u);
        q[d8 * 8 + 4] = __uint_as_float(v.z << 16); q[d8 * 8 + 5] = __uint_as_float(v.z & 0xffff0000u); q[d8 * 8 + 6] = __uint_as_float(v.w << 16); q[d8 * 8 + 7] = __uint_as_float(v.w & 0xffff0000u); }
    float m = -3.0e38f;
    for (int pass = 0; pass < 2; ++pass) {
        float l = 0.f; float o[64];
#pragma unroll
        for (int d = 0; d < 64; ++d) o[d] = 0.f;
        for (int kk = 0; kk < NMEM; ++kk) {
            const size_t krow = (size_t)b * NMEM + kk;
            const bf16* kp = KM + krow * 256 + h * 64;
            float s = 0.f;
#pragma unroll
            for (int d8 = 0; d8 < 8; ++d8) { const u32x4 v = *(const u32x4*)(kp + d8 * 8);
                s += q[d8 * 8 + 0] * __uint_as_float(v.x << 16) + q[d8 * 8 + 1] * __uint_as_float(v.x & 0xffff0000u) + q[d8 * 8 + 2] * __uint_as_float(v.y << 16) + q[d8 * 8 + 3] * __uint_as_float(v.y & 0xffff0000u)
                   + q[d8 * 8 + 4] * __uint_as_float(v.z << 16) + q[d8 * 8 + 5] * __uint_as_float(v.z & 0xffff0000u) + q[d8 * 8 + 6] * __uint_as_float(v.w << 16) + q[d8 * 8 + 7] * __uint_as_float(v.w & 0xffff0000u); }
            if (pass == 0) { m = fmaxf(m, s); }
            else {
                const float p = exp2f(s - m); l += p;
                const bf16* vp = VM + krow * 256 + h * 64;
#pragma unroll
                for (int d8 = 0; d8 < 8; ++d8) { const u32x4 v = *(const u32x4*)(vp + d8 * 8);
                    o[d8 * 8 + 0] += p * __uint_as_float(v.x << 16); o[d8 * 8 + 1] += p * __uint_as_float(v.x & 0xffff0000u); o[d8 * 8 + 2] += p * __uint_as_float(v.y << 16); o[d8 * 8 + 3] += p * __uint_as_float(v.y & 0xffff0000u);
                    o[d8 * 8 + 4] += p * __uint_as_float(v.z << 16); o[d8 * 8 + 5] += p * __uint_as_float(v.z & 0xffff0000u); o[d8 * 8 + 6] += p * __uint_as_float(v.w << 16); o[d8 * 8 + 7] += p * __uint_as_float(v.w & 0xffff0000u); }
            }
        }
        if (pass == 1) {
            const float il = 1.f / l; bf16* op = CAT + qrow * D + 768 + h * 64;
#pragma unroll
            for (int d = 0; d < 64; d += 2) *(unsigned*)(op + d) = pk2(o[d] * il, o[d + 1] * il);
        }
    }
}
__global__ void __launch_bounds__(64) k_nv_ret(const bf16* QB, const bf16* KB, const bf16* VB, float* RET) {
    const int e = blockIdx.x & 63, h = (blockIdx.x >> 6) & 3, b = blockIdx.x >> 8; const int d = threadIdx.x;
    const float gamma = 1.f - exp2f(-5.f - (float)h);
    float S = 0.f;
    for (int n = 0; n < SEQ; ++n) {
        const size_t row = (size_t)b * SEQ + n;
        const float kd = bf2f(KB[row * 256 + h * 64 + d]), qd = bf2f(QB[row * 256 + h * 64 + d]), ve = bf2f(VB[row * 256 + h * 64 + e]);
        S = gamma * S + kd * ve;
        const float o = wave_sum(qd * S);
        if (d == 0) RET[row * 256 + h * 64 + e] = o;
    }
}
__global__ void __launch_bounds__(256) k_nv_retnorm(const float* RET, const bf16* GB, const float* gn_g, bf16* CAT) {
    const int id = blockIdx.x * 256 + threadIdx.x; const int row = id >> 2, h = id & 3;
    const float* r = RET + (size_t)row * 256 + h * 64;
    float mu = 0.f; for (int d = 0; d < 64; ++d) mu += r[d]; mu *= (1.f / 64.f);
    float var = 0.f; for (int d = 0; d < 64; ++d) { const float t = r[d] - mu; var += t * t; } var *= (1.f / 64.f);
    const float rs = 1.f / sqrtf(var + EPS);
    for (int d = 0; d < 64; ++d) { const float y = (r[d] - mu) * rs * gn_g[h * 64 + d];
        CAT[(size_t)row * D + 512 + h * 64 + d] = f2bf(bf2f(GB[(size_t)row * 256 + h * 64 + d]) * y); }
}

__global__ void __launch_bounds__(256) k_nv_router(const float* H, const float* g_ffn, const float* w_rg, const float* b_rg, const float* w_re, const float* b_re,
                                                   bf16* HN, unsigned* cnt, int* row_tok, float* row_w, int* toktab) {
    const int lane = threadIdx.x & 63, tok = blockIdx.x * 4 + (threadIdx.x >> 6);
    const float* hrow = H + (size_t)tok * D;
    float ss = 0.f;
#pragma unroll
    for (int j = 0; j < 16; ++j) { const float v = hrow[lane + 64 * j]; ss += v * v; }
    const float r = 1.f / sqrtf(wave_sum(ss) * (1.f / D) + EPS);
    float acc[36];
#pragma unroll
    for (int q = 0; q < 36; ++q) acc[q] = 0.f;
#pragma unroll 2
    for (int j = 0; j < 16; ++j) {
        const int k = lane + 64 * j; const float hn = hrow[k] * r * g_ffn[k];
        HN[(size_t)tok * D + k] = f2bf(hn);
        const f32x4 wg = *(const f32x4*)(w_rg + (size_t)k * 4);
        acc[0] += hn * wg.x; acc[1] += hn * wg.y; acc[2] += hn * wg.z; acc[3] += hn * wg.w;
#pragma unroll
        for (int q = 0; q < 8; ++q) { const f32x4 we = *(const f32x4*)(w_re + (size_t)k * 32 + 4 * q);
            acc[4 + 4 * q] += hn * we.x; acc[5 + 4 * q] += hn * we.y; acc[6 + 4 * q] += hn * we.z; acc[7 + 4 * q] += hn * we.w; }
    }
#pragma unroll
    for (int q = 0; q < 36; ++q) acc[q] = wave_sum(acc[q]);
    float gl[4];
#pragma unroll
    for (int g = 0; g < 4; ++g) gl[g] = acc[g] + b_rg[g];
    int gs = 0; float gm = gl[0];
#pragma unroll
    for (int g = 1; g < 4; ++g) if (gl[g] > gm) { gm = gl[g]; gs = g; }
    float gsum = 0.f;
#pragma unroll
    for (int g = 0; g < 4; ++g) gsum += __expf(gl[g] - gm);
    const float pg = 1.f / gsum;
    float el[8];
#pragma unroll
    for (int i = 0; i < 8; ++i) { const float k0 = gs == 0 ? 1.f : 0.f, k1 = gs == 1 ? 1.f : 0.f, k2 = gs == 2 ? 1.f : 0.f, k3 = gs == 3 ? 1.f : 0.f;
        el[i] = k0 * acc[4 + i] + k1 * acc[12 + i] + k2 * acc[20 + i] + k3 * acc[28 + i] + b_re[gs * 8 + i]; }
    int i0 = 0; float m0 = el[0];
#pragma unroll
    for (int i = 1; i < 8; ++i) if (el[i] > m0) { m0 = el[i]; i0 = i; }
    int i1 = -1; float m1 = -3.0e38f;
#pragma unroll
    for (int i = 0; i < 8; ++i) if (i != i0 && el[i] > m1) { m1 = el[i]; i1 = i; }
    const float p1 = __expf(m1 - m0);
    const float w0 = pg / (1.f + p1), w1 = pg * p1 / (1.f + p1);
    if (lane == 0) {
        const int e0 = gs * 8 + i0, e1 = gs * 8 + i1;
        const unsigned s0 = atomicAdd(&cnt[e0], 1u), s1 = atomicAdd(&cnt[e1], 1u);
        row_tok[(size_t)e0 * T + s0] = tok; row_w[(size_t)e0 * T + s0] = w0;
        row_tok[(size_t)e1 * T + s1] = tok; row_w[(size_t)e1 * T + s1] = w1;
        toktab[tok * 4 + 0] = e0; toktab[tok * 4 + 1] = (int)s0; toktab[tok * 4 + 2] = e1; toktab[tok * 4 + 3] = (int)s1;
    }
}

__device__ __forceinline__ void moe_blkstart(const unsigned* cnt, int* blkstart  ) {
    int s = 0;
    for (int e = 0; e < NE; ++e) { blkstart[e] = s; s += (int)((cnt[e] + 255u) >> 8); }
    blkstart[NE] = s;
}
struct GatherMap { const int* tok; unsigned n; int base; __device__ __forceinline__ int operator()(int r) const { const unsigned s = (unsigned)(r - base); return s < n ? tok[s] : 0; } };

__global__ void __launch_bounds__(256) k_nv_g1(const bf16* HN, const float* w_gate, const float* w_up, const unsigned* cnt, const int* row_tok, bf16* ACT) {
    __shared__ int bs[33];
    if (threadIdx.x == 0) moe_blkstart(cnt, bs);
    __syncthreads();
    const int sb = blockIdx.x, bidx = sb >> 2; if (bidx >= bs[NE]) return;
    int e = 0; while (bs[e + 1] <= bidx) ++e;
    const int rb = bidx - bs[e]; const int slot0 = rb * 256 + (sb & 3) * 64;
    const int prow0 = bidx * 256 + (sb & 3) * 64;
    GatherMap gm{row_tok + (size_t)e * T, cnt[e], prow0 - slot0};
    auto epi = [&](int r, int c, float g, float u) { ACT[(size_t)r * DE + c] = f2bf(silu_f(g) * u); };
    nv_gemm_tile<true>(HN, D, w_gate + (size_t)e * D * DE, w_up + (size_t)e * D * DE, DE, D, prow0, blockIdx.y * 64, gm, epi);
}
__global__ void __launch_bounds__(256) k_nv_g2(const bf16* ACT, const float* w_down, const unsigned* cnt, const float* row_w, bf16* YB) {
    __shared__ int bs[33];
    if (threadIdx.x == 0) moe_blkstart(cnt, bs);
    __syncthreads();
    const int sb = blockIdx.x, bidx = sb >> 2; if (bidx >= bs[NE]) return;
    int e = 0; while (bs[e + 1] <= bidx) ++e;
    const int rb = bidx - bs[e]; const int prow0 = bidx * 256 + (sb & 3) * 64; const int sbase = prow0 - (rb * 256 + (sb & 3) * 64);
    const float* wl = row_w + (size_t)e * T; const unsigned n = cnt[e];
    auto epi = [&](int r, int c, float v, float) { const unsigned s = (unsigned)(r - sbase); const float w = s < n ? wl[s] : 0.f; YB[(size_t)r * D + c] = f2bf(w * v); };
    nv_gemm_tile<false>(ACT, DE, w_down + (size_t)e * DE * D, nullptr, D, DE, prow0, blockIdx.y * 64, IdMap(), epi);
}
__global__ void __launch_bounds__(256) k_combine(float* OUT, const bf16* YB, const unsigned* cnt, const int* toktab) {
    __shared__ int bs[33];
    if (threadIdx.x == 0) moe_blkstart(cnt, bs);
    __syncthreads();
    const int tok = blockIdx.x; const int c = threadIdx.x * 4;
    const int e0 = toktab[tok * 4], s0 = toktab[tok * 4 + 1], e1 = toktab[tok * 4 + 2], s1 = toktab[tok * 4 + 3];
    const size_t p0 = (size_t)bs[e0] * 256 + s0, p1 = (size_t)bs[e1] * 256 + s1;
    f32x4 o = *(f32x4*)(OUT + (size_t)tok * D + c);
    const u32x2 a = *(const u32x2*)(YB + p0 * D + c), b = *(const u32x2*)(YB + p1 * D + c);
    o.x += __uint_as_float(a.x << 16) + __uint_as_float(b.x << 16); o.y += __uint_as_float(a.x & 0xffff0000u) + __uint_as_float(b.x & 0xffff0000u);
    o.z += __uint_as_float(a.y << 16) + __uint_as_float(b.y << 16); o.w += __uint_as_float(a.y & 0xffff0000u) + __uint_as_float(b.y & 0xffff0000u);
    *(f32x4*)(OUT + (size_t)tok * D + c) = o;
}

extern "C" void kernel_launch(void* const* d_in, const int* in_sizes, int n_in, void* d_out, int out_size, void* d_ws, size_t ws_size, hipStream_t stream) {
    if (n_in != 22 || out_size != T * D || ws_size < WS_END) { fprintf(stderr, "kernel_launch: unexpected sizes (n_in %d out %d ws %zu)\n", n_in, out_size, ws_size); return; }
    const float* x = (const float*)d_in[0]; const float* mem = (const float*)d_in[1]; const int* positions = (const int*)d_in[2];
    const float* g_mix = (const float*)d_in[3]; const float* w_in = (const float*)d_in[4]; const float* qn_a = (const float*)d_in[5]; const float* kn_a = (const float*)d_in[6];
    const float* rel_bias = (const float*)d_in[7]; const float* ret_gn_g = (const float*)d_in[8]; const float* g_mem = (const float*)d_in[9]; const float* w_mem_kv = (const float*)d_in[10];
    const float* qn_c = (const float*)d_in[11]; const float* kn_c = (const float*)d_in[12]; const float* w_out = (const float*)d_in[13]; const float* g_ffn = (const float*)d_in[14];
    const float* w_rg = (const float*)d_in[15]; const float* b_rg = (const float*)d_in[16]; const float* w_re = (const float*)d_in[17]; const float* b_re = (const float*)d_in[18];
    const float* w_gate = (const float*)d_in[19]; const float* w_up = (const float*)d_in[20]; const float* w_down = (const float*)d_in[21];
    unsigned char* ws = (unsigned char*)d_ws; float* out = (float*)d_out;
    hipMemsetAsync(ws + WS_CTL, 0, CTL_BYTES, stream);
    unsigned* cnt = (unsigned*)(ws + WS_CTL) + CW_CNT;
    PB pb{}; pb.QA = (bf16*)(ws + WS_QA); pb.KA = (bf16*)(ws + WS_KA); pb.VA = (bf16*)(ws + WS_VA); pb.QB = (bf16*)(ws + WS_QB); pb.KB = (bf16*)(ws + WS_KB);
    pb.VB = (bf16*)(ws + WS_VB); pb.GB = (bf16*)(ws + WS_GB); pb.QC = (bf16*)(ws + WS_QC); pb.KM = (bf16*)(ws + WS_KM); pb.VM = (bf16*)(ws + WS_VM);
    bf16* XN = (bf16*)(ws + WS_XN); bf16* CAT = (bf16*)(ws + WS_CAT); bf16* HN = (bf16*)(ws + WS_HN); bf16* ACT = (bf16*)(ws + WS_ACT); bf16* YB = (bf16*)(ws + WS_YB);
    float* RET = (float*)(ws + WS_RKV); int* row_tok = (int*)(ws + WS_ROWTOK); float* row_w = (float*)(ws + WS_ROWW); int* toktab = (int*)(ws + WS_TOKTAB);

    P0Args a{}; a.x = x; a.mem = mem; a.g_mix = g_mix; a.g_mem = g_mem; a.w_in = w_in; a.w_mem_kv = w_mem_kv; a.w_out = w_out; a.w_gate = w_gate; a.w_up = w_up; a.w_down = w_down;
    a.XN = XN; a.WinT = (bf16*)(ws + WS_WINT); a.WoutT = (bf16*)(ws + WS_WOUTT); a.WguT = (bf16*)(ws + WS_WGUT); a.WdT = (bf16*)(ws + WS_WDT);
    hipLaunchKernelGGL(k_prologue, dim3(256), dim3(512), 0, stream, a);
    hipLaunchKernelGGL(k_nv_inproj, dim3(INCOLS / 64, T / 64), dim3(256), 0, stream, XN, w_in, INCOLS, 0, 0, pb);
    hipLaunchKernelGGL(k_nv_inproj, dim3(KVCOLS / 64, MEMROWS / 64), dim3(256), 0, stream, XN, w_mem_kv, KVCOLS, T, INCOLS, pb);
    hipLaunchKernelGGL(k_nv_postproc, dim3((T * 32 + MEMROWS * 4 + 255) / 256), dim3(256), 0, stream, pb, positions, qn_a, kn_a, qn_c, kn_c);
    hipLaunchKernelGGL(k_nv_attnA, dim3(NBATCH * AH * NCHUNK), dim3(64), 0, stream, pb.QA, pb.KA, pb.VA, rel_bias, CAT);
    hipLaunchKernelGGL(k_nv_ret, dim3(NBATCH * BH * 64), dim3(64), 0, stream, pb.QB, pb.KB, pb.VB, RET);
    hipLaunchKernelGGL(k_nv_retnorm, dim3(T * 4 / 256), dim3(256), 0, stream, RET, pb.GB, ret_gn_g, CAT);
    hipLaunchKernelGGL(k_nv_cross, dim3(NBATCH * CH * NCHUNK), dim3(64), 0, stream, pb.QC, pb.KM, pb.VM, CAT);
    hipLaunchKernelGGL(k_nv_outproj, dim3(D / 64, T / 64), dim3(256), 0, stream, CAT, w_out, x, out);
    hipLaunchKernelGGL(k_nv_router, dim3(T / 4), dim3(256), 0, stream, out, g_ffn, w_rg, b_rg, w_re, b_re, HN, cnt, row_tok, row_w, toktab);
    hipLaunchKernelGGL(k_nv_g1, dim3(MAXBLK * 4, DE / 64), dim3(256), 0, stream, HN, w_gate, w_up, cnt, row_tok, ACT);
    hipLaunchKernelGGL(k_nv_g2, dim3(MAXBLK * 4, D / 64), dim3(256), 0, stream, ACT, w_down, cnt, row_w, YB);
    hipLaunchKernelGGL(k_combine, dim3(T), dim3(256), 0, stream, out, YB, cnt, toktab);
}
```

```cpp
#include <hip/hip_runtime.h>
#include <cstdio>
#include <cstdint>

typedef unsigned short bf16;
typedef float f32x4 __attribute__((ext_vector_type(4)));
typedef unsigned u32x4 __attribute__((ext_vector_type(4)));
typedef unsigned u32x2 __attribute__((ext_vector_type(2)));

constexpr int T = 32768, D = 1024, SEQ = 8192, NBATCH = 4, NMEM = 256, MEMROWS = NBATCH * NMEM;
constexpr int HD = 64, AH = 8, BH = 4, CH = 4;
constexpr int INCOLS = 2816, KVCOLS = 512;
constexpr int CHUNK = 64, NCHUNK = SEQ / CHUNK;
constexpr int NE = 32, DE = 512;
constexpr int MAXBLK = 288;
constexpr float EPS = 1e-6f;
constexpr float LOG2E = 1.4426950408889634f;
constexpr float QSCALE = 0.125f * LOG2E;

constexpr size_t MiB = 1u << 20;
constexpr size_t WS_CTL = 0, CTL_BYTES = 1 * MiB;
constexpr size_t WS_WINT = 2 * MiB;
constexpr size_t WS_WOUTT = 9 * MiB;
constexpr size_t WS_WGUT = 12 * MiB;
constexpr size_t WS_WDT = 76 * MiB;
constexpr size_t WS_XN = 108 * MiB;
constexpr size_t WS_ACT = 108 * MiB;
constexpr size_t WS_QA = 180 * MiB, WS_KA = 212 * MiB, WS_VA = 244 * MiB, WS_QB = 276 * MiB, WS_KB = 292 * MiB, WS_VB = 308 * MiB, WS_GB = 324 * MiB, WS_QC = 340 * MiB;
constexpr size_t WS_KM = 356 * MiB, WS_VM = 356 * MiB + 512 * 1024;
constexpr size_t WS_YB = 180 * MiB;
constexpr size_t WS_RKV = 357 * MiB;
constexpr size_t WS_CAT = 389 * MiB;
constexpr size_t WS_HN = 389 * MiB;
constexpr size_t WS_ROWTOK = 453 * MiB, WS_ROWW = 457 * MiB, WS_TOKTAB = 461 * MiB, WS_END = 462 * MiB;
constexpr int CW_CNT = 64;

struct PB { bf16 *QA, *KA, *VA, *QB, *KB, *VB, *GB, *QC, *KM, *VM; };

__device__ __forceinline__ float bf2f(bf16 v) { return __uint_as_float(((unsigned)v) << 16); }
__device__ __forceinline__ bf16 f2bf(float f) { unsigned u = __float_as_uint(f); return (bf16)((u + 0x7fffu + ((u >> 16) & 1u)) >> 16); }
__device__ __forceinline__ unsigned pk2(float lo, float hi) { return (unsigned)f2bf(lo) | ((unsigned)f2bf(hi) << 16); }
__device__ __forceinline__ float wave_sum(float v) {
#pragma unroll
    for (int o = 1; o < 64; o <<= 1) v += __shfl_xor(v, o);
    return v;
}
__device__ __forceinline__ float silu_f(float x) { return x / (1.f + __expf(-x)); }

__device__ __forceinline__ bf16* proj_ptr(const PB& pb, int row, int col) {
    if (col < 512) return pb.QA + (size_t)row * 512 + col;
    if (col < 1024) return pb.KA + (size_t)row * 512 + (col - 512);
    if (col < 1536) return pb.VA + (size_t)row * 512 + (col - 1024);
    if (col < 1792) return pb.QB + (size_t)row * 256 + (col - 1536);
    if (col < 2048) return pb.KB + (size_t)row * 256 + (col - 1792);
    if (col < 2304) return pb.VB + (size_t)row * 256 + (col - 2048);
    if (col < 2560) return pb.GB + (size_t)row * 256 + (col - 2304);
    if (col < 2816) return pb.QC + (size_t)row * 256 + (col - 2560);
    if (col < 3072) return pb.KM + (size_t)(row - T) * 256 + (col - 2816);
    return pb.VM + (size_t)(row - T) * 256 + (col - 3072);
}

__device__ __forceinline__ void transpose_item(const float* W, int K, int N, bf16* WT, int row_off, float* scr, int item, int lane) {
    const int nblk = N / 32, kb = item / nblk, nb = item % nblk, k0 = 64 * kb, n0 = 32 * nb;
#pragma unroll 8
    for (int i = 0; i < 32; ++i) { const int kk = 2 * i + (lane >> 5); scr[kk * 33 + (lane & 31)] = W[(size_t)(k0 + kk) * N + n0 + (lane & 31)]; }
    asm volatile("s_waitcnt lgkmcnt(0)" ::: "memory");
    const int c = lane & 7;
#pragma unroll
    for (int j = 0; j < 4; ++j) { const int n = (lane >> 3) + 8 * j; const float* s = scr + (8 * c) * 33 + n;
        u32x4 o; o.x = pk2(s[0 * 33], s[1 * 33]); o.y = pk2(s[2 * 33], s[3 * 33]); o.z = pk2(s[4 * 33], s[5 * 33]); o.w = pk2(s[6 * 33], s[7 * 33]);
        *(u32x4*)(WT + (size_t)(row_off + n0 + n) * K + k0 + 8 * c) = o; }
    asm volatile("s_waitcnt lgkmcnt(0)" ::: "memory");
}
__device__ __forceinline__ void rms_row_to_bf16(const float* xrow, const float* gain, bf16* orow, int lane) {
    const f32x4* xr = (const f32x4*)xrow + lane; const f32x4* gr = (const f32x4*)gain + lane;
    f32x4 v[4]; float s = 0.f;
#pragma unroll
    for (int j = 0; j < 4; ++j) { v[j] = xr[64 * j]; s += (v[j].x * v[j].x + v[j].y * v[j].y) + (v[j].z * v[j].z + v[j].w * v[j].w); }
    const float r = 1.f / sqrtf(wave_sum(s) * (1.f / D) + EPS);
    unsigned long long* o8 = (unsigned long long*)orow + lane;
#pragma unroll
    for (int j = 0; j < 4; ++j) { const f32x4 g = gr[64 * j];
        o8[64 * j] = (unsigned long long)pk2(v[j].x * r * g.x, v[j].y * r * g.y) | ((unsigned long long)pk2(v[j].z * r * g.z, v[j].w * r * g.w) << 32); }
}

struct P0Args { const float *x, *mem, *g_mix, *g_mem, *w_in, *w_mem_kv, *w_out, *w_gate, *w_up, *w_down; bf16 *XN, *WinT, *WoutT, *WguT, *WdT; };
__global__ void __launch_bounds__(512) k_prologue(P0Args a) {
    __shared__ float scr_all[8 * 64 * 33];
    const int lane = threadIdx.x & 63, wave = threadIdx.x >> 6;
    float* scr = scr_all + wave * 64 * 33;
    const int gw = blockIdx.x * 8 + wave, NGW = gridDim.x * 8;
    constexpr int I_IN = 16 * 88, I_KV = 16 * 16, I_O = 16 * 32, I_E = 256;
    constexpr int NITEMS = I_IN + I_KV + I_O + NE * 3 * I_E;
    for (int it = gw; it < NITEMS; it += NGW) {
        int r = it;
        if (r < I_IN) { transpose_item(a.w_in, D, INCOLS, a.WinT, 0, scr, r, lane); continue; } r -= I_IN;
        if (r < I_KV) { transpose_item(a.w_mem_kv, D, KVCOLS, a.WinT, INCOLS, scr, r, lane); continue; } r -= I_KV;
        if (r < I_O) { transpose_item(a.w_out, D, D, a.WoutT, 0, scr, r, lane); continue; } r -= I_O;
        const int e = r / (3 * I_E), q = r % (3 * I_E);
        if (q < I_E) transpose_item(a.w_gate + (size_t)e * D * DE, D, DE, a.WguT + (size_t)e * D * D, 0, scr, q, lane);
        else if (q < 2 * I_E) transpose_item(a.w_up + (size_t)e * D * DE, D, DE, a.WguT + (size_t)e * D * D, DE, scr, q - I_E, lane);
        else transpose_item(a.w_down + (size_t)e * DE * D, DE, D, a.WdT + (size_t)e * D * DE, 0, scr, q - 2 * I_E, lane);
    }
    for (int m = gw; m < T + MEMROWS; m += NGW) {
        if (m < T) rms_row_to_bf16(a.x + (size_t)m * D, a.g_mix, a.XN + (size_t)m * D, lane);
        else rms_row_to_bf16(a.mem + (size_t)(m - T) * D, a.g_mem, a.XN + (size_t)m * D, lane);
    }
}

template <bool DUAL, class RowMap, class Epi>
__device__ __forceinline__ void nv_gemm_tile(const bf16* A, int lda, const float* B, const float* B2, int ldb, int K, int row0, int col0, RowMap rm, Epi epi) {
    __shared__ float As[16][68];
    __shared__ float Bs[16][68];
    __shared__ float Bs2[DUAL ? 16 : 1][68];
    const int tid = threadIdx.x, tx = tid & 15, ty = tid >> 4;
    float acc[4][4], acc2[4][4];
#pragma unroll
    for (int i = 0; i < 4; ++i)
#pragma unroll
        for (int j = 0; j < 4; ++j) { acc[i][j] = 0.f; acc2[i][j] = 0.f; }
    const int ar = tid >> 2, akq = (tid & 3) * 4;
    const bf16* arow = A + (size_t)rm(row0 + ar) * lda + akq;
    const int bk = tid >> 4, bn = (tid & 15) * 4;
    for (int k0 = 0; k0 < K; k0 += 16) {
        const u32x2 av = *(const u32x2*)(arow + k0);
        As[akq + 0][ar] = __uint_as_float(av.x << 16); As[akq + 1][ar] = __uint_as_float(av.x & 0xffff0000u);
        As[akq + 2][ar] = __uint_as_float(av.y << 16); As[akq + 3][ar] = __uint_as_float(av.y & 0xffff0000u);
        const f32x4 bv = *(const f32x4*)(B + (size_t)(k0 + bk) * ldb + col0 + bn);
        Bs[bk][bn] = bv.x; Bs[bk][bn + 1] = bv.y; Bs[bk][bn + 2] = bv.z; Bs[bk][bn + 3] = bv.w;
        if (DUAL) { const f32x4 b2 = *(const f32x4*)(B2 + (size_t)(k0 + bk) * ldb + col0 + bn);
            Bs2[bk][bn] = b2.x; Bs2[bk][bn + 1] = b2.y; Bs2[bk][bn + 2] = b2.z; Bs2[bk][bn + 3] = b2.w; }
        __syncthreads();
#pragma unroll
        for (int k = 0; k < 16; ++k) {
            float a[4], b[4], c[4];
#pragma unroll
            for (int i = 0; i < 4; ++i) { a[i] = As[k][ty * 4 + i]; b[i] = Bs[k][tx * 4 + i]; c[i] = DUAL ? Bs2[k][tx * 4 + i] : 0.f; }
#pragma unroll
            for (int i = 0; i < 4; ++i)
#pragma unroll
                for (int j = 0; j < 4; ++j) { acc[i][j] += a[i] * b[j]; if (DUAL) acc2[i][j] += a[i] * c[j]; }
        }
        __syncthreads();
    }
#pragma unroll
    for (int i = 0; i < 4; ++i)
#pragma unroll
        for (int j = 0; j < 4; ++j) epi(row0 + ty * 4 + i, col0 + tx * 4 + j, acc[i][j], acc2[i][j]);
}
struct IdMap { __device__ __forceinline__ int operator()(int r) const { return r; } };

__global__ void __launch_bounds__(256) k_nv_inproj(const bf16* XN, const float* W, int ldb, int rowbase, int coloff, PB pb) {
    const int row0 = rowbase + blockIdx.y * 64, col0 = blockIdx.x * 64;
    auto epi = [&](int r, int c, float v, float) { *proj_ptr(pb, r, c + coloff) = f2bf(v); };
    nv_gemm_tile<false>(XN, D, W, nullptr, ldb, D, row0, col0, IdMap(), epi);
}
__global__ void __launch_bounds__(256) k_nv_outproj(const bf16* CAT, const float* W, const float* X, float* OUT) {
    const int row0 = blockIdx.y * 64, col0 = blockIdx.x * 64;
    auto epi = [&](int r, int c, float v, float) { OUT[(size_t)r * D + c] = X[(size_t)r * D + c] + v; };
    nv_gemm_tile<false>(CAT, D, W, nullptr, D, D, row0, col0, IdMap(), epi);
}

__global__ void __launch_bounds__(256) k_nv_postproc(PB pb, const int* positions, const float* qn_a, const float* kn_a, const float* qn_c, const float* kn_c) {
    const long id = (long)blockIdx.x * 256 + threadIdx.x;
    bf16* p; const float* gain = nullptr; float scale = 1.f; int mode; int row;
    if (id < (long)T * 32) {
        row = (int)(id >> 5); const int hi = (int)(id & 31);
        if (hi < 8) { p = pb.QA + (size_t)row * 512 + hi * 64; gain = qn_a; scale = QSCALE; mode = 0; }
        else if (hi < 16) { p = pb.KA + (size_t)row * 512 + (hi - 8) * 64; gain = kn_a; mode = 0; }
        else if (hi < 20) { p = pb.QB + (size_t)row * 256 + (hi - 16) * 64; mode = 1; }
        else if (hi < 24) { p = pb.KB + (size_t)row * 256 + (hi - 20) * 64; mode = 1; scale = 0.125f; }
        else if (hi < 28) { p = pb.GB + (size_t)row * 256 + (hi - 24) * 64; mode = 2; }
        else { p = pb.QC + (size_t)row * 256 + (hi - 28) * 64; gain = qn_c; scale = QSCALE; mode = 0; }
    } else {
        const long id2 = id - (long)T * 32; if (id2 >= MEMROWS * 4) return;
        row = (int)(id2 >> 2); p = pb.KM + (size_t)row * 256 + (id2 & 3) * 64; gain = kn_c; mode = 0;
    }
    if (mode == 0) {
        float ss = 0.f;
        for (int d = 0; d < 64; ++d) { const float v = bf2f(p[d]); ss += v * v; }
        const float r = 1.f / sqrtf(ss * (1.f / 64.f) + EPS);
        for (int d = 0; d < 64; ++d) p[d] = f2bf(bf2f(p[d]) * r * gain[d] * scale);
    } else if (mode == 1) {
        const float pos = (float)positions[row];
        for (int i = 0; i < 32; ++i) {
            const float inv = exp2f(-(float)i * (13.287712379549449f / 32.f));
            float rev = pos * inv * 0.15915494309189535f; rev -= floorf(rev);
            const float sn = __builtin_amdgcn_sinf(rev), cs = __builtin_amdgcn_cosf(rev);
            const float t1 = bf2f(p[i]), t2 = bf2f(p[i + 32]);
            p[i] = f2bf((t1 * cs - t2 * sn) * scale); p[i + 32] = f2bf((t1 * sn + t2 * cs) * scale);
        }
    } else {
        for (int d = 0; d < 64; ++d) p[d] = f2bf(silu_f(bf2f(p[d])));
    }
}

__device__ __forceinline__ void nv_attnA_unit(int u, int lane_, const bf16* QA, const bf16* KA, const bf16* VA, const float* rel_bias, bf16* CAT) {
    const int c = u % NCHUNK, h = (u / NCHUNK) % AH, b = u / (NCHUNK * AH);
    const int i = lane_; const size_t qrow = (size_t)b * SEQ + c * CHUNK + i;
    float q[64];
#pragma unroll
    for (int d8 = 0; d8 < 8; ++d8) { const u32x4 v = *(const u32x4*)(QA + qrow * 512 + h * 64 + d8 * 8);
        q[d8 * 8 + 0] = __uint_as_float(v.x << 16); q[d8 * 8 + 1] = __uint_as_float(v.x & 0xffff0000u); q[d8 * 8 + 2] = __uint_as_float(v.y << 16); q[d8 * 8 + 3] = __uint_as_float(v.y & 0xffff0000u);
        q[d8 * 8 + 4] = __uint_as_float(v.z << 16); q[d8 * 8 + 5] = __uint_as_float(v.z & 0xffff0000u); q[d8 * 8 + 6] = __uint_as_float(v.w << 16); q[d8 * 8 + 7] = __uint_as_float(v.w & 0xffff0000u); }
    const float* bias = rel_bias + h * 192;
    float m = -3.0e38f;
    for (int pass = 0; pass < 2; ++pass) {
        float l = 0.f; float o[64];
#pragma unroll
        for (int d = 0; d < 64; ++d) o[d] = 0.f;
        for (int j = 0; j < 9; ++j) {
            const int kc = c - 8 + j; if (kc < 0) continue;
            for (int kk = 0; kk < 64; ++kk) {
                const size_t krow = (size_t)b * SEQ + kc * CHUNK + kk;
                const bf16* kp = KA + krow * 512 + h * 64;
                float s = 0.f;
#pragma unroll
                for (int d8 = 0; d8 < 8; ++d8) { const u32x4 v = *(const u32x4*)(kp + d8 * 8);
                    s += q[d8 * 8 + 0] * __uint_as_float(v.x << 16) + q[d8 * 8 + 1] * __uint_as_float(v.x & 0xffff0000u) + q[d8 * 8 + 2] * __uint_as_float(v.y << 16) + q[d8 * 8 + 3] * __uint_as_float(v.y & 0xffff0000u)
                       + q[d8 * 8 + 4] * __uint_as_float(v.z << 16) + q[d8 * 8 + 5] * __uint_as_float(v.z & 0xffff0000u) + q[d8 * 8 + 6] * __uint_as_float(v.w << 16) + q[d8 * 8 + 7] * __uint_as_float(v.w & 0xffff0000u); }
                int rel = (8 - j) * 64 + i - kk; rel = rel < -63 ? -63 : (rel > 128 ? 128 : rel);
                s += bias[rel + 63] * LOG2E;
                if (pass == 0) { m = fmaxf(m, s); }
                else {
                    const float p = exp2f(s - m); l += p;
                    const bf16* vp = VA + krow * 512 + h * 64;
#pragma unroll
                    for (int d8 = 0; d8 < 8; ++d8) { const u32x4 v = *(const u32x4*)(vp + d8 * 8);
                        o[d8 * 8 + 0] += p * __uint_as_float(v.x << 16); o[d8 * 8 + 1] += p * __uint_as_float(v.x & 0xffff0000u); o[d8 * 8 + 2] += p * __uint_as_float(v.y << 16); o[d8 * 8 + 3] += p * __uint_as_float(v.y & 0xffff0000u);
                        o[d8 * 8 + 4] += p * __uint_as_float(v.z << 16); o[d8 * 8 + 5] += p * __uint_as_float(v.z & 0xffff0000u); o[d8 * 8 + 6] += p * __uint_as_float(v.w << 16); o[d8 * 8 + 7] += p * __uint_as_float(v.w & 0xffff0000u); }
                }
            }
        }
        if (pass == 1) {
            const float il = 1.f / l; bf16* op = CAT + qrow * D + h * 64;
#pragma unroll
            for (int d = 0; d < 64; d += 2) *(unsigned*)(op + d) = pk2(o[d] * il, o[d + 1] * il);
        }
    }
}
__device__ __forceinline__ void nv_cross_unit(int u, int lane_, const bf16* QC, const bf16* KM, const bf16* VM, bf16* CAT) {
    const int c = u % NCHUNK, h = (u / NCHUNK) % CH, b = u / (NCHUNK * CH);
    const int i = lane_; const size_t qrow = (size_t)b * SEQ + c * CHUNK + i;
    float q[64];
#pragma unroll
    for (int d8 = 0; d8 < 8; ++d8) { const u32x4 v = *(const u32x4*)(QC + qrow * 256 + h * 64 + d8 * 8);
        q[d8 * 8 + 0] = __uint_as_float(v.x << 16); q[d8 * 8 + 1] = __uint_as_float(v.x & 0xffff0000u); q[d8 * 8 + 2] = __uint_as_float(v.y << 16); q[d8 * 8 + 3] = __uint_as_float(v.y & 0xffff0000u);
        q[d8 * 8 + 4] = __uint_as_float(v.z << 16); q[d8 * 8 + 5] = __uint_as_float(v.z & 0xffff0000u); q[d8 * 8 + 6] = __uint_as_float(v.w << 16); q[d8 * 8 + 7] = __uint_as_float(v.w & 0xffff0000u); }
    float m = -3.0e38f;
    for (int pass = 0; pass < 2; ++pass) {
        float l = 0.f; float o[64];
#pragma unroll
        for (int d = 0; d < 64; ++d) o[d] = 0.f;
        for (int kk = 0; kk < NMEM; ++kk) {
            const size_t krow = (size_t)b * NMEM + kk;
            const bf16* kp = KM + krow * 256 + h * 64;
            float s = 0.f;
#pragma unroll
            for (int d8 = 0; d8 < 8; ++d8) { const u32x4 v = *(const u32x4*)(kp + d8 * 8);
                s += q[d8 * 8 + 0] * __uint_as_float(v.x << 16) + q[d8 * 8 + 1] * __uint_as_float(v.x & 0xffff0000u) + q[d8 * 8 + 2] * __uint_as_float(v.y << 16) + q[d8 * 8 + 3] * __uint_as_float(v.y & 0xffff0000u)
                   + q[d8 * 8 + 4] * __uint_as_float(v.z << 16) + q[d8 * 8 + 5] * __uint_as_float(v.z & 0xffff0000u) + q[d8 * 8 + 6] * __uint_as_float(v.w << 16) + q[d8 * 8 + 7] * __uint_as_float(v.w & 0xffff0000u); }
            if (pass == 0) { m = fmaxf(m, s); }
            else {
                const float p = exp2f(s - m); l += p;
                const bf16* vp = VM + krow * 256 + h * 64;
#pragma unroll
                for (int d8 = 0; d8 < 8; ++d8) { const u32x4 v = *(const u32x4*)(vp + d8 * 8);
                    o[d8 * 8 + 0] += p * __uint_as_float(v.x << 16); o[d8 * 8 + 1] += p * __uint_as_float(v.x & 0xffff0000u); o[d8 * 8 + 2] += p * __uint_as_float(v.y << 16); o[d8 * 8 + 3] += p * __uint_as_float(v.y & 0xffff0000u);
                    o[d8 * 8 + 4] += p * __uint_as_float(v.z << 16); o[d8 * 8 + 5] += p * __uint_as_float(v.z & 0xffff0000u); o[d8 * 8 + 6] += p * __uint_as_float(v.w << 16); o[d8 * 8 + 7] += p * __uint_as_float(v.w & 0xffff0000u); }
            }
        }
        if (pass == 1) {
            const float il = 1.f / l; bf16* op = CAT + qrow * D + 768 + h * 64;
#pragma unroll
            for (int d = 0; d < 64; d += 2) *(unsigned*)(op + d) = pk2(o[d] * il, o[d + 1] * il);
        }
    }
}
__device__ __forceinline__ void nv_ret_unit(int u, int lane_, const bf16* QB, const bf16* KB, const bf16* VB, float* RET) {
    const int e = u & 63, h = (u >> 6) & 3, b = u >> 8; const int d = lane_;
    const float gamma = 1.f - exp2f(-5.f - (float)h);
    float S = 0.f;
    for (int n = 0; n < SEQ; ++n) {
        const size_t row = (size_t)b * SEQ + n;
        const float kd = bf2f(KB[row * 256 + h * 64 + d]), qd = bf2f(QB[row * 256 + h * 64 + d]), ve = bf2f(VB[row * 256 + h * 64 + e]);
        S = gamma * S + kd * ve;
        const float o = wave_sum(qd * S);
        if (d == 0) RET[row * 256 + h * 64 + e] = o;
    }
}
__device__ __forceinline__ void nv_retnorm_item(int id, const float* RET, const bf16* GB, const float* gn_g, bf16* CAT) {
    const int row = id >> 2, h = id & 3;
    const float* r = RET + (size_t)row * 256 + h * 64;
    float mu = 0.f; for (int d = 0; d < 64; ++d) mu += r[d]; mu *= (1.f / 64.f);
    float var = 0.f; for (int d = 0; d < 64; ++d) { const float t = r[d] - mu; var += t * t; } var *= (1.f / 64.f);
    const float rs = 1.f / sqrtf(var + EPS);
    for (int d = 0; d < 64; ++d) { const float y = (r[d] - mu) * rs * gn_g[h * 64 + d];
        CAT[(size_t)row * D + 512 + h * 64 + d] = f2bf(bf2f(GB[(size_t)row * 256 + h * 64 + d]) * y); }
}

__global__ void __launch_bounds__(256) k_nv_router(const float* H, const float* g_ffn, const float* w_rg, const float* b_rg, const float* w_re, const float* b_re,
                                                   bf16* HN, unsigned* cnt, int* row_tok, float* row_w, int* toktab) {
    const int lane = threadIdx.x & 63, tok = blockIdx.x * 4 + (threadIdx.x >> 6);
    const float* hrow = H + (size_t)tok * D;
    float ss = 0.f;
#pragma unroll
    for (int j = 0; j < 16; ++j) { const float v = hrow[lane + 64 * j]; ss += v * v; }
    const float r = 1.f / sqrtf(wave_sum(ss) * (1.f / D) + EPS);
    float acc[36];
#pragma unroll
    for (int q = 0; q < 36; ++q) acc[q] = 0.f;
#pragma unroll 2
    for (int j = 0; j < 16; ++j) {
        const int k = lane + 64 * j; const float hn = hrow[k] * r * g_ffn[k];
        HN[(size_t)tok * D + k] = f2bf(hn);
        const f32x4 wg = *(const f32x4*)(w_rg + (size_t)k * 4);
        acc[0] += hn * wg.x; acc[1] += hn * wg.y; acc[2] += hn * wg.z; acc[3] += hn * wg.w;
#pragma unroll
        for (int q = 0; q < 8; ++q) { const f32x4 we = *(const f32x4*)(w_re + (size_t)k * 32 + 4 * q);
            acc[4 + 4 * q] += hn * we.x; acc[5 + 4 * q] += hn * we.y; acc[6 + 4 * q] += hn * we.z; acc[7 + 4 * q] += hn * we.w; }
    }
#pragma unroll
    for (int q = 0; q < 36; ++q) acc[q] = wave_sum(acc[q]);
    float gl[4];
#pragma unroll
    for (int g = 0; g < 4; ++g) gl[g] = acc[g] + b_rg[g];
    int gs = 0; float gm = gl[0];
#pragma unroll
    for (int g = 1; g < 4; ++g) if (gl[g] > gm) { gm = gl[g]; gs = g; }
    float gsum = 0.f;
#pragma unroll
    for (int g = 0; g < 4; ++g) gsum += __expf(gl[g] - gm);
    const float pg = 1.f / gsum;
    float el[8];
#pragma unroll
    for (int i = 0; i < 8; ++i) { const float k0 = gs == 0 ? 1.f : 0.f, k1 = gs == 1 ? 1.f : 0.f, k2 = gs == 2 ? 1.f : 0.f, k3 = gs == 3 ? 1.f : 0.f;
        el[i] = k0 * acc[4 + i] + k1 * acc[12 + i] + k2 * acc[20 + i] + k3 * acc[28 + i] + b_re[gs * 8 + i]; }
    int i0 = 0; float m0 = el[0];
#pragma unroll
    for (int i = 1; i < 8; ++i) if (el[i] > m0) { m0 = el[i]; i0 = i; }
    int i1 = -1; float m1 = -3.0e38f;
#pragma unroll
    for (int i = 0; i < 8; ++i) if (i != i0 && el[i] > m1) { m1 = el[i]; i1 = i; }
    const float p1 = __expf(m1 - m0);
    const float w0 = pg / (1.f + p1), w1 = pg * p1 / (1.f + p1);
    if (lane == 0) {
        const int e0 = gs * 8 + i0, e1 = gs * 8 + i1;
        const unsigned s0 = atomicAdd(&cnt[e0], 1u), s1 = atomicAdd(&cnt[e1], 1u);
        row_tok[(size_t)e0 * T + s0] = tok; row_w[(size_t)e0 * T + s0] = w0;
        row_tok[(size_t)e1 * T + s1] = tok; row_w[(size_t)e1 * T + s1] = w1;
        toktab[tok * 4 + 0] = e0; toktab[tok * 4 + 1] = (int)s0; toktab[tok * 4 + 2] = e1; toktab[tok * 4 + 3] = (int)s1;
    }
}

__device__ __forceinline__ void moe_blkstart(const unsigned* cnt, int* blkstart  ) {
    int s = 0;
    for (int e = 0; e < NE; ++e) { blkstart[e] = s; s += (int)((cnt[e] + 255u) >> 8); }
    blkstart[NE] = s;
}
struct GatherMap { const int* tok; unsigned n; int base; __device__ __forceinline__ int operator()(int r) const { const unsigned s = (unsigned)(r - base); return s < n ? tok[s] : 0; } };

__global__ void __launch_bounds__(256) k_nv_g1(const bf16* HN, const float* w_gate, const float* w_up, const unsigned* cnt, const int* row_tok, bf16* ACT) {
    __shared__ int bs[33];
    if (threadIdx.x == 0) moe_blkstart(cnt, bs);
    __syncthreads();
    const int sb = blockIdx.x, bidx = sb >> 2; if (bidx >= bs[NE]) return;
    int e = 0; while (bs[e + 1] <= bidx) ++e;
    const int rb = bidx - bs[e]; const int slot0 = rb * 256 + (sb & 3) * 64;
    const int prow0 = bidx * 256 + (sb & 3) * 64;
    GatherMap gm{row_tok + (size_t)e * T, cnt[e], prow0 - slot0};
    auto epi = [&](int r, int c, float g, float u) { ACT[(size_t)r * DE + c] = f2bf(silu_f(g) * u); };
    nv_gemm_tile<true>(HN, D, w_gate + (size_t)e * D * DE, w_up + (size_t)e * D * DE, DE, D, prow0, blockIdx.y * 64, gm, epi);
}
__global__ void __launch_bounds__(256) k_nv_g2(const bf16* ACT, const float* w_down, const unsigned* cnt, const float* row_w, bf16* YB) {
    __shared__ int bs[33];
    if (threadIdx.x == 0) moe_blkstart(cnt, bs);
    __syncthreads();
    const int sb = blockIdx.x, bidx = sb >> 2; if (bidx >= bs[NE]) return;
    int e = 0; while (bs[e + 1] <= bidx) ++e;
    const int rb = bidx - bs[e]; const int prow0 = bidx * 256 + (sb & 3) * 64; const int sbase = prow0 - (rb * 256 + (sb & 3) * 64);
    const float* wl = row_w + (size_t)e * T; const unsigned n = cnt[e];
    auto epi = [&](int r, int c, float v, float) { const unsigned s = (unsigned)(r - sbase); const float w = s < n ? wl[s] : 0.f; YB[(size_t)r * D + c] = f2bf(w * v); };
    nv_gemm_tile<false>(ACT, DE, w_down + (size_t)e * DE * D, nullptr, D, DE, prow0, blockIdx.y * 64, IdMap(), epi);
}
__global__ void __launch_bounds__(256) k_combine(float* OUT, const bf16* YB, const unsigned* cnt, const int* toktab) {
    __shared__ int bs[33];
    if (threadIdx.x == 0) moe_blkstart(cnt, bs);
    __syncthreads();
    const int tok = blockIdx.x; const int c = threadIdx.x * 4;
    const int e0 = toktab[tok * 4], s0 = toktab[tok * 4 + 1], e1 = toktab[tok * 4 + 2], s1 = toktab[tok * 4 + 3];
    const size_t p0 = (size_t)bs[e0] * 256 + s0, p1 = (size_t)bs[e1] * 256 + s1;
    f32x4 o = *(f32x4*)(OUT + (size_t)tok * D + c);
    const u32x2 a = *(const u32x2*)(YB + p0 * D + c), b = *(const u32x2*)(YB + p1 * D + c);
    o.x += __uint_as_float(a.x << 16) + __uint_as_float(b.x << 16); o.y += __uint_as_float(a.x & 0xffff0000u) + __uint_as_float(b.x & 0xffff0000u);
    o.z += __uint_as_float(a.y << 16) + __uint_as_float(b.y << 16); o.w += __uint_as_float(a.y & 0xffff0000u) + __uint_as_float(b.y & 0xffff0000u);
    *(f32x4*)(OUT + (size_t)tok * D + c) = o;
}

__global__ void __launch_bounds__(64) k_nv_attnA(const bf16* QA, const bf16* KA, const bf16* VA, const float* rel_bias, bf16* CAT) { nv_attnA_unit(blockIdx.x, threadIdx.x, QA, KA, VA, rel_bias, CAT); }
__global__ void __launch_bounds__(64) k_nv_cross(const bf16* QC, const bf16* KM, const bf16* VM, bf16* CAT) { nv_cross_unit(blockIdx.x, threadIdx.x, QC, KM, VM, CAT); }
__global__ void __launch_bounds__(64) k_nv_ret(const bf16* QB, const bf16* KB, const bf16* VB, float* RET) { nv_ret_unit(blockIdx.x, threadIdx.x, QB, KB, VB, RET); }
__global__ void __launch_bounds__(256) k_nv_retnorm(const float* RET, const bf16* GB, const float* gn_g, bf16* CAT) { nv_retnorm_item(blockIdx.x * 256 + threadIdx.x, RET, GB, gn_g, CAT); }
namespace pg8 {
#define PG8_LAS __attribute__((address_space(3)))
typedef short bf16x8 __attribute__((ext_vector_type(8)));
constexpr int BM = 256, BK = 64, HALF = 128, HTB = HALF * BK * 2, STAGE_BYTES = 8 * HTB, NXCD = 8, WGM = 8;

__host__ __device__ __forceinline__ int lds_byte(int r, int c) { const int st = (r >> 4) * 2 + (c >> 5), rr = r & 15, cc = c & 31, ob = rr * 64 + cc * 2; return st * 1024 + (ob ^ (((ob >> 9) & 1) << 5)); }
__host__ __device__ __forceinline__ void stage_rc(int b, int& R, int& C) { const int st = b / 1024, sb = b % 1024, swz = sb ^ (((sb >> 9) & 1) << 5); R = (st >> 1) * 16 + swz / 64; C = (st & 1) * 32 + (swz % 64) / 2; }
__host__ __device__ __forceinline__ int perm32(int rho) { const int n = rho >> 4, i = rho & 15; return 8 * (i >> 2) + 4 * n + (i & 3); }

struct Unit { int pm, pn; const char* a; const char* b; int e, rb; };

__device__ __forceinline__ void static_map(int L, int nM, int nN, int& pm, int& pn) {
    const int nwg = nM * nN; int wgid = L;
    { const int q = nwg / NXCD, r = nwg % NXCD, xcd = wgid % NXCD, off = wgid / NXCD; wgid = (xcd < r ? xcd * (q + 1) : r * (q + 1) + (xcd - r) * q) + off; }
    const int nig = WGM * nN, gid = wgid / nig, fm = gid * WGM, gsz = (nM - fm) < WGM ? (nM - fm) : WGM;
    pm = fm + ((wgid % nig) % gsz); pn = (wgid % nig) / gsz;
}

__device__ __forceinline__ unsigned cvt_pk_bf16(float lo, float hi) { unsigned r; asm volatile("v_cvt_pk_bf16_f32 %0, %1, %2" : "=v"(r) : "v"(lo), "v"(hi)); return r; }

template <class Epi, class Sched, bool ALIGN_EPI, bool GATHER>
__device__ __forceinline__ void gemm_phase(PG8_LAS unsigned char* lds, const int K, const unsigned hstepA, const unsigned hstepB, PG8_LAS unsigned* gspill, const Sched& S, const Epi& E) {
    const int tid = threadIdx.x, wid = __builtin_amdgcn_readfirstlane(tid >> 6), lane = tid & 63, wr = wid >> 2, wc = wid & 3, fr = lane & 15, fq = lane >> 4;
    const int nt = K / BK;
    unsigned vA[2][2], voffB[2];
#pragma unroll
    for (int i = 0; i < 2; ++i) { int R, C; stage_rc(tid * 16 + i * 8192, R, C);
        const int Rb = Epi::BMAP == 0 ? R : (Epi::BMAP == 1 ? ((R & ~31) + perm32(R & 31)) : (2 * (R & ~31) + perm32(R & 31)));
        voffB[i] = (unsigned)(Rb * K + C) * 2u; vA[0][i] = (unsigned)(R * K + C) * 2u; vA[1][i] = vA[0][i] + hstepA; }
    const size_t kstep = (size_t)(BK * 2);
    const unsigned ldsw = (unsigned)wid * 1024u;
    const int aoff = lds_byte(wr * 64 + fr, fq * 8), boff = lds_byte(wc * 32 + fr, fq * 8);
#define PG8_SA(b, h) (((b) * 2 + (h)) * HTB)
#define PG8_SB(b, h) ((4 + (b) * 2 + (h)) * HTB)
#define PG8_STAGE_B(bufoff, gbase) do { _Pragma("unroll") for (int _i = 0; _i < 2; ++_i) \
        __builtin_amdgcn_global_load_lds((const unsigned*)((const char*)(gbase) + voffB[_i]), (PG8_LAS unsigned*)(lds + (bufoff) + ldsw + _i * 8192), 16, 0, 0); } while (0)
#define PG8_STAGE_A(bufoff, gbase, h) do { _Pragma("unroll") for (int _i = 0; _i < 2; ++_i) \
        __builtin_amdgcn_global_load_lds((const unsigned*)((const char*)(gbase) + vA[h][_i]), (PG8_LAS unsigned*)(lds + (bufoff) + ldsw + _i * 8192), 16, 0, 0); } while (0)
#define PG8_LDA(dst, b, h) do { _Pragma("unroll") for (int m = 0; m < 4; ++m) _Pragma("unroll") for (int k = 0; k < 2; ++k) dst[m][k] = *(const PG8_LAS bf16x8*)(lds + PG8_SA(b, h) + aoff + m * 2048 + k * 1024); } while (0)
#define PG8_LDB(dst, b, h) do { _Pragma("unroll") for (int n = 0; n < 2; ++n) _Pragma("unroll") for (int k = 0; k < 2; ++k) dst[n][k] = *(const PG8_LAS bf16x8*)(lds + PG8_SB(b, h) + boff + n * 2048 + k * 1024); } while (0)
#define PG8_MMA(ai, bj, At, Bt) do { __builtin_amdgcn_s_setprio(1); _Pragma("unroll") for (int m = 0; m < 4; ++m) _Pragma("unroll") for (int n = 0; n < 2; ++n) _Pragma("unroll") for (int k = 0; k < 2; ++k) \
        acc[ai][bj][m][n] = __builtin_amdgcn_mfma_f32_16x16x32_bf16(Bt[n][k], At[m][k], acc[ai][bj][m][n], 0, 0, 0); __builtin_amdgcn_s_setprio(0); } while (0)
#define PG8_WAIT_V(n) asm volatile("s_waitcnt vmcnt(" #n ")" ::: "memory")
#define PG8_WAIT_L(n) asm volatile("s_waitcnt lgkmcnt(" #n ")" ::: "memory")
#define PG8_BAR __builtin_amdgcn_s_barrier()
#define PG8_SCHED __builtin_amdgcn_sched_barrier(0)
    Unit cur, nxt; int ui = 0;
    if (!S.next(0, cur)) return;
    if constexpr (GATHER) {
#pragma unroll
        for (int i = 0; i < 2; ++i) { int R, C; stage_rc(tid * 16 + i * 8192, R, C);
#pragma unroll
            for (int h = 0; h < 2; ++h) vA[h][i] = (unsigned)S.arow(cur, h * HALF + R) * (unsigned)(K * 2) + (unsigned)(C * 2); }
    }
    f32x4 acc[2][2][4][2];
#pragma unroll
    for (int a = 0; a < 2; ++a)
#pragma unroll
        for (int b = 0; b < 2; ++b)
#pragma unroll
            for (int m = 0; m < 4; ++m)
#pragma unroll
                for (int n = 0; n < 2; ++n) acc[a][b][m][n] = (f32x4){0.f, 0.f, 0.f, 0.f};
    bf16x8 At[4][2], B0[2][2], B1[2][2];
    const char* cA = cur.a; const char* cB = cur.b;
    PG8_STAGE_B(PG8_SB(0, 0), cB); PG8_STAGE_B(PG8_SB(0, 1), cB + hstepB); PG8_STAGE_A(PG8_SA(0, 0), cA, 0); PG8_STAGE_A(PG8_SA(0, 1), cA, 1);
    if (wr == 1) PG8_BAR;
    PG8_WAIT_V(2); PG8_BAR;
    PG8_STAGE_B(PG8_SB(1, 0), cB + kstep); PG8_STAGE_A(PG8_SA(1, 0), cA + kstep, 0); PG8_STAGE_B(PG8_SB(1, 1), cB + hstepB + kstep);
    PG8_WAIT_V(6); PG8_BAR;
    for (;;) {
        const bool has_next = S.next(ui + 1, nxt);
        const char* nA = has_next ? nxt.a : cA; const char* nB = has_next ? nxt.b : cB;
        if constexpr (GATHER) {
            if (has_next) {
                unsigned o[4];
#pragma unroll
                for (int i = 0; i < 2; ++i) { int R, C; stage_rc(tid * 16 + i * 8192, R, C);
#pragma unroll
                    for (int h = 0; h < 2; ++h) o[h * 2 + i] = (unsigned)S.arow(nxt, h * HALF + R) * (unsigned)(K * 2) + (unsigned)(C * 2); }
                *(PG8_LAS u32x4*)(gspill + tid * 4) = (u32x4){o[0], o[1], o[2], o[3]};
            }
        }
        for (int t = 0; t < nt; t += 2) {
            const bool last = (t == nt - 2);
            const char* a1 = cA + (size_t)(t + 1) * kstep;
            const char* a2 = last ? nA : cA + (size_t)(t + 2) * kstep; const char* b2 = last ? nB : cB + (size_t)(t + 2) * kstep;
            const char* a3 = a2 + kstep; const char* b3 = b2 + kstep;
            PG8_LDB(B0, 0, 0); PG8_LDB(B1, 0, 1); PG8_SCHED; PG8_LDA(At, 0, 0); PG8_STAGE_A(PG8_SA(1, 1), a1, 1);
            if constexpr (GATHER) { if (last && has_next) { const u32x4 o = *(const PG8_LAS u32x4*)(gspill + tid * 4); vA[0][0] = o.x; vA[0][1] = o.y; vA[1][0] = o.z; vA[1][1] = o.w; } }
            PG8_WAIT_V(8); PG8_WAIT_L(0); PG8_BAR; PG8_MMA(0, 0, At, B0); PG8_MMA(0, 1, At, B1); PG8_BAR; PG8_SCHED;
            PG8_LDA(At, 0, 1); PG8_STAGE_B(PG8_SB(0, 0), b2); PG8_STAGE_B(PG8_SB(0, 1), b2 + hstepB); PG8_STAGE_A(PG8_SA(0, 0), a2, 0);
            PG8_WAIT_V(8); PG8_WAIT_L(0); PG8_BAR; PG8_MMA(1, 0, At, B0); PG8_MMA(1, 1, At, B1); PG8_BAR; PG8_SCHED;
            PG8_LDB(B0, 1, 0); PG8_LDB(B1, 1, 1); PG8_SCHED; PG8_LDA(At, 1, 0); PG8_STAGE_A(PG8_SA(0, 1), a2, 1);
            PG8_WAIT_V(8); PG8_WAIT_L(0); PG8_BAR; PG8_MMA(0, 0, At, B0); PG8_MMA(0, 1, At, B1); PG8_BAR; PG8_SCHED;
            PG8_LDA(At, 1, 1); PG8_STAGE_B(PG8_SB(1, 0), b3); PG8_STAGE_B(PG8_SB(1, 1), b3 + hstepB); PG8_STAGE_A(PG8_SA(1, 0), a3, 0);
            PG8_WAIT_V(8); PG8_WAIT_L(0); PG8_BAR; PG8_MMA(1, 0, At, B0); PG8_MMA(1, 1, At, B1); PG8_BAR; PG8_SCHED;
        }
        if constexpr (ALIGN_EPI) { if (wr == 0) PG8_BAR; }
        E(acc, cur, wr, wc, fr, fq);
        if (!has_next) break;
#pragma unroll
        for (int a = 0; a < 2; ++a)
#pragma unroll
            for (int b = 0; b < 2; ++b)
#pragma unroll
                for (int m = 0; m < 4; ++m)
#pragma unroll
                    for (int n = 0; n < 2; ++n) acc[a][b][m][n] = (f32x4){0.f, 0.f, 0.f, 0.f};
        cur = nxt; cA = nA; cB = nB; ++ui;
        if constexpr (ALIGN_EPI) { if (wr == 1) PG8_BAR; }
    }
    PG8_WAIT_V(0);
    if constexpr (!ALIGN_EPI) { if (wr == 0) PG8_BAR; }
    PG8_BAR;
#undef PG8_SA
#undef PG8_SB
#undef PG8_STAGE_A
#undef PG8_STAGE_B
#undef PG8_LDA
#undef PG8_LDB
#undef PG8_MMA
#undef PG8_WAIT_V
#undef PG8_WAIT_L
#undef PG8_BAR
#undef PG8_SCHED
}

struct ProjOrder {
    int G, c; const char* A; const char* Bt;
    __device__ __forceinline__ bool next(int i, Unit& u) const {
        const int L = i * G + c; if (L >= 1416) return false;
        int pm, pn;
        if (L < 1408) static_map(L, 128, 11, pm, pn); else { const int j = L - 1408; pm = 128 + (j >> 1); pn = 11 + (j & 1); }
        u.pm = pm; u.pn = pn; u.a = A + (size_t)pm * (256 * 2048); u.b = Bt + (size_t)pn * (256 * 2048); u.e = 0; u.rb = 0; return true;
    }
    __device__ __forceinline__ int arow(const Unit&, int) const { return 0; }
};
struct PlainOrder {
    int G, c, nM, nN; const char* A; const char* Bt; int ldbytes;
    __device__ __forceinline__ bool next(int i, Unit& u) const {
        const int L = i * G + c; if (L >= nM * nN) return false;
        int pm, pn; static_map(L, nM, nN, pm, pn);
        u.pm = pm; u.pn = pn; u.a = A + (size_t)pm * 256 * ldbytes; u.b = Bt + (size_t)pn * 256 * ldbytes; u.e = 0; u.rb = 0; return true;
    }
    __device__ __forceinline__ int arow(const Unit&, int) const { return 0; }
};

struct MoeOrder {
    int G, c, nunits; const PG8_LAS int* blkstart; const PG8_LAS int* blk2e;
    const char* Abase; size_t aBlk; const char* Bbase; size_t bExp, bTile; const int* row_tok; const unsigned* cnt;
    __device__ __forceinline__ bool next(int i, Unit& u) const {
        const int L = i * G + c; if (L >= nunits) return false;
        const int bidx = L >> 2, pn = L & 3;
        const int e = __builtin_amdgcn_readfirstlane(blk2e[bidx]); const int rb = bidx - __builtin_amdgcn_readfirstlane(blkstart[e]);
        u.pm = bidx; u.pn = pn; u.e = e; u.rb = rb; u.a = Abase + (size_t)bidx * aBlk; u.b = Bbase + (size_t)e * bExp + (size_t)pn * bTile; return true;
    }
    __device__ __forceinline__ int arow(const Unit& u, int r) const { const unsigned s = (unsigned)(u.rb * 256 + r); return s < cnt[u.e] ? row_tok[(size_t)u.e * T + s] : 0; }
};

struct EpiProj {
    static constexpr int BMAP = 2;
    PB pb; const int* positions; const float *qn_a, *kn_a, *qn_c, *kn_c;
    __device__ __forceinline__ void operator()(const f32x4 (&acc)[2][2][4][2], const Unit& u, int wr, int wc, int fr, int fq) const {
        const int pn = u.pn;
        bf16* dst; int ld, colbase = 0, mode = 3; const float* gain = nullptr; float scale = 1.f; int rowoff = 0;
        if (pn < 2) { dst = pb.QA; ld = 512; colbase = pn * 256; mode = 0; gain = qn_a; scale = QSCALE; }
        else if (pn < 4) { dst = pb.KA; ld = 512; colbase = (pn - 2) * 256; mode = 0; gain = kn_a; }
        else if (pn < 6) { dst = pb.VA; ld = 512; colbase = (pn - 4) * 256; }
        else if (pn == 6) { dst = pb.QB; ld = 256; mode = 1; }
        else if (pn == 7) { dst = pb.KB; ld = 256; mode = 1; scale = 0.125f; }
        else if (pn == 8) { dst = pb.VB; ld = 256; }
        else if (pn == 9) { dst = pb.GB; ld = 256; mode = 2; }
        else if (pn == 10) { dst = pb.QC; ld = 256; mode = 0; gain = qn_c; scale = QSCALE; }
        else if (pn == 11) { dst = pb.KM; ld = 256; mode = 0; gain = kn_c; rowoff = T; }
        else { dst = pb.VM; ld = 256; rowoff = T; }
        const int row0 = u.pm * BM + wr * 64 + fr - rowoff;
        bf16* base = dst + colbase + wc * 64 + 8 * fq;
        if (mode == 0) {
            f32x4 g[2][2];
#pragma unroll
            for (int bj = 0; bj < 2; ++bj)
#pragma unroll
                for (int n = 0; n < 2; ++n) g[bj][n] = *(const f32x4*)(gain + 32 * bj + 8 * fq + 4 * n) * scale;
#pragma unroll
            for (int ai = 0; ai < 2; ++ai)
#pragma unroll
                for (int m = 0; m < 4; ++m) {
                    float ss = 0.f;
#pragma unroll
                    for (int bj = 0; bj < 2; ++bj)
#pragma unroll
                        for (int n = 0; n < 2; ++n) { const f32x4 v = acc[ai][bj][m][n]; ss += (v.x * v.x + v.y * v.y) + (v.z * v.z + v.w * v.w); }
                    ss += __shfl_xor(ss, 16); ss += __shfl_xor(ss, 32);
                    const float r = 1.f / sqrtf(ss * (1.f / 64.f) + EPS);
                    bf16* rowp = base + (size_t)(row0 + ai * HALF + m * 16) * ld;
#pragma unroll
                    for (int bj = 0; bj < 2; ++bj) { const f32x4 v0 = acc[ai][bj][m][0] * g[bj][0] * r, v1 = acc[ai][bj][m][1] * g[bj][1] * r;
                        u32x4 w; w.x = cvt_pk_bf16(v0.x, v0.y); w.y = cvt_pk_bf16(v0.z, v0.w); w.z = cvt_pk_bf16(v1.x, v1.y); w.w = cvt_pk_bf16(v1.z, v1.w);
                        *(u32x4*)(rowp + 32 * bj) = w; }
                }
        } else if (mode == 1) {
            float inv[2][4];
#pragma unroll
            for (int n = 0; n < 2; ++n)
#pragma unroll
                for (int i = 0; i < 4; ++i) inv[n][i] = exp2f(-(float)(8 * fq + 4 * n + i) * (13.287712379549449f / 32.f)) * 0.15915494309189535f;
#pragma unroll
            for (int ai = 0; ai < 2; ++ai)
#pragma unroll
                for (int m = 0; m < 4; ++m) {
                    const int row = row0 + ai * HALF + m * 16; const float pos = (float)positions[row];
                    f32x4 o0[2], o1[2];
#pragma unroll
                    for (int n = 0; n < 2; ++n)
#pragma unroll
                        for (int i = 0; i < 4; ++i) { float rev = pos * inv[n][i]; rev -= floorf(rev);
                            const float sn = __builtin_amdgcn_sinf(rev), cs = __builtin_amdgcn_cosf(rev);
                            const float t1 = acc[ai][0][m][n][i], t2 = acc[ai][1][m][n][i];
                            o0[n][i] = (t1 * cs - t2 * sn) * scale; o1[n][i] = (t1 * sn + t2 * cs) * scale; }
                    bf16* rowp = base + (size_t)row * ld;
                    u32x4 w; w.x = cvt_pk_bf16(o0[0].x, o0[0].y); w.y = cvt_pk_bf16(o0[0].z, o0[0].w); w.z = cvt_pk_bf16(o0[1].x, o0[1].y); w.w = cvt_pk_bf16(o0[1].z, o0[1].w);
                    *(u32x4*)(rowp) = w;
                    w.x = cvt_pk_bf16(o1[0].x, o1[0].y); w.y = cvt_pk_bf16(o1[0].z, o1[0].w); w.z = cvt_pk_bf16(o1[1].x, o1[1].y); w.w = cvt_pk_bf16(o1[1].z, o1[1].w);
                    *(u32x4*)(rowp + 32) = w;
                }
        } else {
#pragma unroll
            for (int ai = 0; ai < 2; ++ai)
#pragma unroll
                for (int m = 0; m < 4; ++m) {
                    bf16* rowp = base + (size_t)(row0 + ai * HALF + m * 16) * ld;
#pragma unroll
                    for (int bj = 0; bj < 2; ++bj) { f32x4 v0 = acc[ai][bj][m][0], v1 = acc[ai][bj][m][1];
                        if (mode == 2) {
#pragma unroll
                            for (int i = 0; i < 4; ++i) { v0[i] = v0[i] / (1.f + __expf(-v0[i])); v1[i] = v1[i] / (1.f + __expf(-v1[i])); } }
                        u32x4 w; w.x = cvt_pk_bf16(v0.x, v0.y); w.y = cvt_pk_bf16(v0.z, v0.w); w.z = cvt_pk_bf16(v1.x, v1.y); w.w = cvt_pk_bf16(v1.z, v1.w);
                        *(u32x4*)(rowp + 32 * bj) = w; }
                }
        }
    }
};
struct EpiOutProj {
    static constexpr int BMAP = 0;
    const float* X; float* OUT;
    __device__ __forceinline__ void operator()(const f32x4 (&acc)[2][2][4][2], const Unit& u, int wr, int wc, int fr, int fq) const {
        const int row0 = u.pm * BM + wr * 64 + fr, col0 = u.pn * BM + wc * 32 + 4 * fq;
#pragma unroll
        for (int ai = 0; ai < 2; ++ai)
#pragma unroll
            for (int m = 0; m < 4; ++m) { const size_t off = (size_t)(row0 + ai * HALF + m * 16) * D + col0;
#pragma unroll
                for (int bj = 0; bj < 2; ++bj)
#pragma unroll
                    for (int n = 0; n < 2; ++n) *(f32x4*)(OUT + off + bj * HALF + n * 16) = *(const f32x4*)(X + off + bj * HALF + n * 16) + acc[ai][bj][m][n]; }
    }
};
struct EpiG1 {
    static constexpr int BMAP = 1;
    bf16* ACT;
    __device__ __forceinline__ void operator()(const f32x4 (&acc)[2][2][4][2], const Unit& u, int wr, int wc, int fr, int fq) const {
        const int row0 = u.pm * BM + wr * 64 + fr; bf16* base = ACT + u.pn * 128 + wc * 32 + 8 * fq;
#pragma unroll
        for (int ai = 0; ai < 2; ++ai)
#pragma unroll
            for (int m = 0; m < 4; ++m) {
                f32x4 o[2];
#pragma unroll
                for (int n = 0; n < 2; ++n)
#pragma unroll
                    for (int i = 0; i < 4; ++i) { const float g = acc[ai][0][m][n][i]; o[n][i] = g / (1.f + __expf(-g)) * acc[ai][1][m][n][i]; }
                u32x4 w; w.x = cvt_pk_bf16(o[0].x, o[0].y); w.y = cvt_pk_bf16(o[0].z, o[0].w); w.z = cvt_pk_bf16(o[1].x, o[1].y); w.w = cvt_pk_bf16(o[1].z, o[1].w);
                *(u32x4*)(base + (size_t)(row0 + ai * HALF + m * 16) * DE) = w;
            }
    }
};
struct EpiG2 {
    static constexpr int BMAP = 1;
    bf16* YB; const float* row_w; const unsigned* cnt;
    __device__ __forceinline__ void operator()(const f32x4 (&acc)[2][2][4][2], const Unit& u, int wr, int wc, int fr, int fq) const {
        const int r0 = wr * 64 + fr; const unsigned n = cnt[u.e]; const float* wl = row_w + (size_t)u.e * T + u.rb * 256;
        bf16* base = YB + (size_t)u.pm * BM * D + u.pn * BM + wc * 32 + 8 * fq;
#pragma unroll
        for (int ai = 0; ai < 2; ++ai)
#pragma unroll
            for (int m = 0; m < 4; ++m) {
                const int r = r0 + ai * HALF + m * 16; const float w = (unsigned)(u.rb * 256 + r) < n ? wl[r] : 0.f;
                bf16* rowp = base + (size_t)r * D;
#pragma unroll
                for (int bj = 0; bj < 2; ++bj) { const f32x4 v0 = acc[ai][bj][m][0] * w, v1 = acc[ai][bj][m][1] * w;
                    u32x4 q; q.x = cvt_pk_bf16(v0.x, v0.y); q.y = cvt_pk_bf16(v0.z, v0.w); q.z = cvt_pk_bf16(v1.x, v1.y); q.w = cvt_pk_bf16(v1.z, v1.w);
                    *(u32x4*)(rowp + bj * HALF) = q; }
            }
    }
};
}
constexpr int NWAVES = 8;
constexpr int RING_OFF = 0, RING_BYTES = 131072, SCRATCH_BYTES = 147456;
constexpr int GSPILL_OFF = SCRATCH_BYTES;
constexpr int MOE_OFF = GSPILL_OFF + 8192;
constexpr int MISC_OFF = MOE_OFF + 2048;
constexpr int LDS_BYTES = 163840;
static_assert(MISC_OFF + 512 <= LDS_BYTES, "LDS map");
constexpr int CW_BAR = 4096;

#define GAS __attribute__((address_space(1)))
#define LAS __attribute__((address_space(3)))
#define XB_TMO      128
#define XB_XCNT(j)  (256  + 64 * (j))
#define XB_XSUB(j)  (1280 + 64 * (j))
#define XB_XGEN(j)  (2304 + 64 * (j))
#define XB_TOP      3328
#define XB_TOPGEN   3392
#define XCD_BAR_WORDS 3456
#define XB_SPIN_CAP (1u << 18)
__device__ __forceinline__ unsigned xb_ld(unsigned* p)              { return __hip_atomic_load(p, __ATOMIC_RELAXED, __HIP_MEMORY_SCOPE_AGENT); }
__device__ __forceinline__ unsigned xb_add(unsigned* p, unsigned v) { return __hip_atomic_fetch_add(p, v, __ATOMIC_RELAXED, __HIP_MEMORY_SCOPE_AGENT); }
__device__ __forceinline__ unsigned xb_xcc_id() { return (unsigned)__builtin_amdgcn_s_getreg((3 << 11) | 20) & 0xFu; }
#define XB_SPIN(cond, bar) do { unsigned _sp = 0; while (cond) { __builtin_amdgcn_s_sleep(1); \
    if ((++_sp & 255u) == 0u) { if (xb_ld(&(bar)[XB_TMO])) break; if (_sp > XB_SPIN_CAP) { atomicAdd(&(bar)[XB_TMO], 1u); break; } } } } while (0)
struct XcdBarrier { unsigned* bar; unsigned x; volatile LAS unsigned* st; };
__device__ __forceinline__ XcdBarrier xcd_barrier_post(unsigned* bar, volatile LAS unsigned* st) {
    XcdBarrier b; b.bar = bar; b.x = xb_xcc_id(); b.st = st;
    if (threadIdx.x == 0) (void)xb_add(&bar[XB_XCNT(b.x)], 1u);
    return b;
}
__device__ __forceinline__ void xcd_barrier_complete(unsigned* bar, unsigned x, unsigned& nloc, unsigned& nx) {
    const unsigned G = gridDim.x * gridDim.y * gridDim.z;
    unsigned sum, cnt, mine, sp = 0u;
    for (;;) {
        sum = 0u; cnt = 0u; mine = 0u;
#pragma unroll
        for (unsigned j = 0; j < 16; ++j) { const unsigned c = xb_ld(&bar[XB_XCNT(j)]); sum += c; cnt += (c > 0u) ? 1u : 0u; mine = (j == x) ? c : mine; }
        if (sum == G) break;
        __builtin_amdgcn_s_sleep(1);
        if ((++sp & 255u) == 0u) { if (xb_ld(&bar[XB_TMO])) break; if (sp > XB_SPIN_CAP) { atomicAdd(&bar[XB_TMO], 1u); break; } }
    }
    nloc = mine > 0u ? mine : 1u; nx = cnt > 0u ? cnt : 1u;
}
__device__ __forceinline__ void xcd_barrier(const XcdBarrier& b) {
    asm volatile("s_waitcnt vmcnt(0)" ::: "memory");
    __syncthreads();
    if (threadIdx.x == 0) {
        unsigned* bar = b.bar;
        __builtin_amdgcn_s_waitcnt(0);
        unsigned nloc = b.st[0], nx = b.st[1];
        if (nloc == 0u) { xcd_barrier_complete(bar, b.x, nloc, nx); b.st[0] = nloc; b.st[1] = nx; }
        const unsigned old = xb_add(&bar[XB_XSUB(b.x)], 1u);
        const unsigned gen = old / nloc;
        if (old + 1u == (gen + 1u) * nloc) {
            __builtin_amdgcn_fence(__ATOMIC_RELEASE, "agent");
            asm volatile("s_waitcnt vmcnt(0)" ::: "memory");
            const unsigned og = xb_add(&bar[XB_TOP], 1u);
            const unsigned tg = og / nx;
            if (og + 1u == (tg + 1u) * nx) xb_add(&bar[XB_TOPGEN], 1u);
            else XB_SPIN(xb_ld(&bar[XB_TOPGEN]) == tg, bar);
            __builtin_amdgcn_fence(__ATOMIC_ACQUIRE, "agent");
            xb_add(&bar[XB_XGEN(b.x)], 1u);
            asm volatile("s_waitcnt vmcnt(0)" ::: "memory");
        } else {
            XB_SPIN(xb_ld(&bar[XB_XGEN(b.x)]) == gen, bar);
            __builtin_amdgcn_fence(__ATOMIC_ACQUIRE, "agent");
            asm volatile("s_waitcnt vmcnt(0)" ::: "memory");
        }
    }
    __syncthreads();
}

__device__ __forceinline__ void transpose_item_l(const float* W, int K, int N, bf16* WT, int row_off, LAS float* scr, int item, int lane) {
    const int nblk = N / 32, kb = item / nblk, nb = item % nblk, k0 = 64 * kb, n0 = 32 * nb;
#pragma unroll 8
    for (int i = 0; i < 32; ++i) { const int kk = 2 * i + (lane >> 5); scr[kk * 33 + (lane & 31)] = W[(size_t)(k0 + kk) * N + n0 + (lane & 31)]; }
    asm volatile("s_waitcnt lgkmcnt(0)" ::: "memory");
    const int c = lane & 7;
#pragma unroll
    for (int j = 0; j < 4; ++j) { const int n = (lane >> 3) + 8 * j; const LAS float* s = scr + (8 * c) * 33 + n;
        u32x4 o; o.x = pk2(s[0 * 33], s[1 * 33]); o.y = pk2(s[2 * 33], s[3 * 33]); o.z = pk2(s[4 * 33], s[5 * 33]); o.w = pk2(s[6 * 33], s[7 * 33]);
        *(u32x4*)(WT + (size_t)(row_off + n0 + n) * K + k0 + 8 * c) = o; }
    asm volatile("s_waitcnt lgkmcnt(0)" ::: "memory");
}

struct Args { const void* in[22]; float* out; unsigned char* ws; int ph_lo, ph_hi, li, pad; };

__global__ void __launch_bounds__(NWAVES * 64, 2) mk_fwd(Args args) {
    extern __shared__ __attribute__((aligned(16))) unsigned char lds_raw[];
    LAS unsigned char* lds = (LAS unsigned char*)lds_raw;
    volatile LAS unsigned* MISC = (volatile LAS unsigned*)(lds + MISC_OFF);
    LAS unsigned* gspill = (LAS unsigned*)(lds + GSPILL_OFF);
    const int tid = threadIdx.x, lane = tid & 63, wave = __builtin_amdgcn_readfirstlane(tid >> 6);
    const int G = gridDim.x, bx = blockIdx.x;
    unsigned char* ws = args.ws;
    unsigned* ctl = (unsigned*)(ws + WS_CTL);
    const float* x = (const float*)args.in[0]; const float* mem = (const float*)args.in[1]; const int* positions = (const int*)args.in[2];
    const float* g_mix = (const float*)args.in[3]; const float* w_in = (const float*)args.in[4]; const float* qn_a = (const float*)args.in[5]; const float* kn_a = (const float*)args.in[6];
    const float* g_mem = (const float*)args.in[9]; const float* w_mem_kv = (const float*)args.in[10];
    const float* qn_c = (const float*)args.in[11]; const float* kn_c = (const float*)args.in[12]; const float* w_out = (const float*)args.in[13];
    const float* w_gate = (const float*)args.in[19]; const float* w_up = (const float*)args.in[20]; const float* w_down = (const float*)args.in[21];
    float* out = args.out;
    PB pb; pb.QA = (bf16*)(ws + WS_QA); pb.KA = (bf16*)(ws + WS_KA); pb.VA = (bf16*)(ws + WS_VA); pb.QB = (bf16*)(ws + WS_QB); pb.KB = (bf16*)(ws + WS_KB);
    pb.VB = (bf16*)(ws + WS_VB); pb.GB = (bf16*)(ws + WS_GB); pb.QC = (bf16*)(ws + WS_QC); pb.KM = (bf16*)(ws + WS_KM); pb.VM = (bf16*)(ws + WS_VM);
    bf16* XN = (bf16*)(ws + WS_XN); bf16* WinT = (bf16*)(ws + WS_WINT); bf16* WoutT = (bf16*)(ws + WS_WOUTT); bf16* WguT = (bf16*)(ws + WS_WGUT); bf16* WdT = (bf16*)(ws + WS_WDT);
    bf16* CAT = (bf16*)(ws + WS_CAT);

    for (int u = tid; u < 128; u += NWAVES * 64) MISC[u] = 0u;
    __syncthreads();
    XcdBarrier bar = xcd_barrier_post(ctl + CW_BAR + args.li * XCD_BAR_WORDS, MISC + 8);
    const int lo = args.ph_lo, hi = args.ph_hi;
#define IN(k) (lo <= (k) && (k) < hi)
#define BOTH(k) (IN(k) && IN((k) + 1))

    if (IN(0)) {
        LAS float* scr = (LAS float*)(lds + RING_OFF + wave * 16384);
        const int gw = bx * NWAVES + wave, NGW = G * NWAVES;
        constexpr int I_IN = 16 * 88, I_KV = 16 * 16, I_O = 16 * 32, I_E = 256;
        constexpr int NITEMS = I_IN + I_KV + I_O + NE * 3 * I_E;
        for (int it = gw; it < NITEMS; it += NGW) {
            int r = it;
            if (r < I_IN) { transpose_item_l(w_in, D, INCOLS, WinT, 0, scr, r, lane); continue; } r -= I_IN;
            if (r < I_KV) { transpose_item_l(w_mem_kv, D, KVCOLS, WinT, INCOLS, scr, r, lane); continue; } r -= I_KV;
            if (r < I_O) { transpose_item_l(w_out, D, D, WoutT, 0, scr, r, lane); continue; } r -= I_O;
            const int e = r / (3 * I_E), q = r % (3 * I_E);
            if (q < I_E) transpose_item_l(w_gate + (size_t)e * D * DE, D, DE, WguT + (size_t)e * D * D, 0, scr, q, lane);
            else if (q < 2 * I_E) transpose_item_l(w_up + (size_t)e * D * DE, D, DE, WguT + (size_t)e * D * D, DE, scr, q - I_E, lane);
            else transpose_item_l(w_down + (size_t)e * DE * D, DE, D, WdT + (size_t)e * D * DE, 0, scr, q - 2 * I_E, lane);
        }
        for (int m = gw; m < T + MEMROWS; m += NGW) {
            if (m < T) rms_row_to_bf16(x + (size_t)m * D, g_mix, XN + (size_t)m * D, lane);
            else rms_row_to_bf16(mem + (size_t)(m - T) * D, g_mem, XN + (size_t)m * D, lane);
        }
        if (BOTH(0)) xcd_barrier(bar);
    }
    if (IN(1)) {
        pg8::ProjOrder S{G, bx, (const char*)XN, (const char*)WinT};
        pg8::EpiProj E{pb, positions, qn_a, kn_a, qn_c, kn_c};
        pg8::gemm_phase<pg8::EpiProj, pg8::ProjOrder, true, false>(lds + RING_OFF, D, 128u * 2048u, 32u * 2048u, gspill, S, E);
        if (BOTH(1)) xcd_barrier(bar);
    }
    if (IN(2)) {
        const int lane2 = (int)__builtin_amdgcn_mbcnt_hi(~0u, __builtin_amdgcn_mbcnt_lo(~0u, 0u));
        for (int u = bx * NWAVES + wave; u < NBATCH * BH * 64; u += G * NWAVES) nv_ret_unit(u, lane2, pb.QB, pb.KB, pb.VB, (float*)(ws + WS_RKV));
        if (BOTH(2)) xcd_barrier(bar);
    }
    if (IN(3)) { if (BOTH(3)) xcd_barrier(bar); }
    if (IN(4)) {
        const float* rel_bias = (const float*)args.in[7]; const float* ret_gn_g = (const float*)args.in[8];
        const int lane4 = (int)__builtin_amdgcn_mbcnt_hi(~0u, __builtin_amdgcn_mbcnt_lo(~0u, 0u));
        for (int id = bx * NWAVES * 64 + tid; id < T * 4; id += G * NWAVES * 64) nv_retnorm_item(id, (const float*)(ws + WS_RKV), pb.GB, ret_gn_g, CAT);
        for (int u = bx * NWAVES + wave; u < NBATCH * AH * NCHUNK; u += G * NWAVES) nv_attnA_unit(u, lane4, pb.QA, pb.KA, pb.VA, rel_bias, CAT);
        for (int u = bx * NWAVES + wave; u < NBATCH * CH * NCHUNK; u += G * NWAVES) nv_cross_unit(u, lane4, pb.QC, pb.KM, pb.VM, CAT);
        if (BOTH(4)) xcd_barrier(bar);
    }
    if (IN(5)) {
        pg8::PlainOrder S{G, bx, T / 256, D / 256, (const char*)CAT, (const char*)WoutT, 2048};
        pg8::EpiOutProj E{x, out};
        pg8::gemm_phase<pg8::EpiOutProj, pg8::PlainOrder, true, false>(lds + RING_OFF, D, 128u * 2048u, 128u * 2048u, gspill, S, E);
        if (BOTH(5)) xcd_barrier(bar);
    }
    if (IN(6)) {
        const float* g_ffn = (const float*)args.in[14]; const float* w_rg = (const float*)args.in[15]; const float* b_rg = (const float*)args.in[16];
        const float* w_re = (const float*)args.in[17]; const float* b_re = (const float*)args.in[18];
        bf16* HN = (bf16*)(ws + WS_HN); unsigned* cnt = ctl + CW_CNT;
        int* row_tok = (int*)(ws + WS_ROWTOK); float* row_w = (float*)(ws + WS_ROWW); int* toktab = (int*)(ws + WS_TOKTAB);
        constexpr int IMG_LO = 36864, LG_OFF = 73728, TAB_OFF = LG_OFF + 8 * 2304;
        LAS int* tokE = (LAS int*)(lds + TAB_OFF); LAS float* tokW = (LAS float*)(lds + TAB_OFF + 1024); LAS int* tokR = (LAS int*)(lds + TAB_OFF + 2048);
        LAS unsigned* hist = (LAS unsigned*)(lds + TAB_OFF + 3072); LAS unsigned* ebase = hist + 32;
        const int r16 = lane & 15, kq = lane >> 4;
        for (int unit = bx; unit < T / 128; unit += G) {
            const int tok0 = unit * 128 + wave * 16;
            const float* hrow = out + (size_t)(tok0 + r16) * D + 8 * kq;
            f32x4 acc[3]; acc[0] = (f32x4){0.f, 0.f, 0.f, 0.f}; acc[1] = acc[0]; acc[2] = acc[0];
            float ss = 0.f;
            if (tid < 64) hist[tid] = 0u;
            for (int kh = 0; kh < 2; ++kh) {
                __syncthreads();
                for (int idx = tid; idx < 36 * 512; idx += NWAVES * 64) {
                    const int n = idx >> 9, kk = idx & 511, k = kh * 512 + kk;
                    const float v = g_ffn[k] * (n < 4 ? w_rg[k * 4 + n] : w_re[k * 32 + (n - 4)]);
                    const bf16 vh = f2bf(v), vl = f2bf(v - bf2f(vh));
                    const int addr = n * 1024 + ((((kk >> 3) ^ (n & 15))) << 4) + (kk & 7) * 2;
                    *(LAS bf16*)(lds + addr) = vh; *(LAS bf16*)(lds + IMG_LO + addr) = vl;
                }
                __syncthreads();
#pragma unroll 2
                for (int s = 0; s < 16; ++s) {
                    const f32x4 v0 = *(const f32x4*)(hrow + kh * 512 + 32 * s), v1 = *(const f32x4*)(hrow + kh * 512 + 32 * s + 4);
                    ss += (v0.x * v0.x + v0.y * v0.y) + (v0.z * v0.z + v0.w * v0.w) + (v1.x * v1.x + v1.y * v1.y) + (v1.z * v1.z + v1.w * v1.w);
                    u32x4 ph, pl;
                    ph.x = pg8::cvt_pk_bf16(v0.x, v0.y); ph.y = pg8::cvt_pk_bf16(v0.z, v0.w); ph.z = pg8::cvt_pk_bf16(v1.x, v1.y); ph.w = pg8::cvt_pk_bf16(v1.z, v1.w);
                    pl.x = pg8::cvt_pk_bf16(v0.x - __uint_as_float(ph.x << 16), v0.y - __uint_as_float(ph.x & 0xffff0000u));
                    pl.y = pg8::cvt_pk_bf16(v0.z - __uint_as_float(ph.y << 16), v0.w - __uint_as_float(ph.y & 0xffff0000u));
                    pl.z = pg8::cvt_pk_bf16(v1.x - __uint_as_float(ph.z << 16), v1.y - __uint_as_float(ph.z & 0xffff0000u));
                    pl.w = pg8::cvt_pk_bf16(v1.z - __uint_as_float(ph.w << 16), v1.w - __uint_as_float(ph.w & 0xffff0000u));
                    const pg8::bf16x8 ah = __builtin_bit_cast(pg8::bf16x8, ph), al = __builtin_bit_cast(pg8::bf16x8, pl);
#pragma unroll
                    for (int nb = 0; nb < 3; ++nb) {
                        int n = 16 * nb + r16; n = n > 35 ? 35 : n;
                        const int addr = n * 1024 + (((4 * s + kq) ^ (n & 15)) << 4);
                        const pg8::bf16x8 bh = *(const LAS pg8::bf16x8*)(lds + addr), bl = *(const LAS pg8::bf16x8*)(lds + IMG_LO + addr);
                        acc[nb] = __builtin_amdgcn_mfma_f32_16x16x32_bf16(ah, bh, acc[nb], 0, 0, 0);
                        acc[nb] = __builtin_amdgcn_mfma_f32_16x16x32_bf16(al, bh, acc[nb], 0, 0, 0);
                        acc[nb] = __builtin_amdgcn_mfma_f32_16x16x32_bf16(ah, bl, acc[nb], 0, 0, 0);
                    }
                }
            }
            ss += __shfl_xor(ss, 16); ss += __shfl_xor(ss, 32);
            const float rr = 1.f / sqrtf(ss * (1.f / D) + EPS);
            LAS float* LG = (LAS float*)(lds + LG_OFF + wave * 2304);
#pragma unroll
            for (int i = 0; i < 4; ++i) { const float ri = __shfl(rr, 4 * kq + i);
#pragma unroll
                for (int nb = 0; nb < 3; ++nb) { const int n = 16 * nb + r16; if (n < 36) LG[(4 * kq + i) * 36 + n] = acc[nb][i] * ri; } }
            asm volatile("s_waitcnt lgkmcnt(0)" ::: "memory");
            if (lane < 16) {
                const LAS float* lg = LG + lane * 36;
                float gl[4];
#pragma unroll
                for (int g = 0; g < 4; ++g) gl[g] = lg[g] + b_rg[g];
                int gs = 0; float gm = gl[0];
#pragma unroll
                for (int g = 1; g < 4; ++g) if (gl[g] > gm) { gm = gl[g]; gs = g; }
                float gsum = 0.f;
#pragma unroll
                for (int g = 0; g < 4; ++g) gsum += __expf(gl[g] - gm);
                const float pg = 1.f / gsum;
                float el[8];
#pragma unroll
                for (int i = 0; i < 8; ++i) el[i] = lg[4 + gs * 8 + i] + b_re[gs * 8 + i];
                int i0 = 0; float m0 = el[0];
#pragma unroll
                for (int i = 1; i < 8; ++i) if (el[i] > m0) { m0 = el[i]; i0 = i; }
                int i1 = -1; float m1 = -3.0e38f;
#pragma unroll
                for (int i = 0; i < 8; ++i) if (i != i0 && el[i] > m1) { m1 = el[i]; i1 = i; }
                const float p1 = __expf(m1 - m0);
                const int tl = wave * 16 + lane;
                tokE[tl * 2] = gs * 8 + i0; tokE[tl * 2 + 1] = gs * 8 + i1; tokW[tl * 2] = pg / (1.f + p1); tokW[tl * 2 + 1] = pg * p1 / (1.f + p1);
            }
            for (int j = 0; j < 16; ++j) {
                const float rj = __shfl(rr, j);
                const f32x4* xr = (const f32x4*)(out + (size_t)(tok0 + j) * D) + lane; const f32x4* gr = (const f32x4*)g_ffn + lane;
                unsigned long long* o8 = (unsigned long long*)(HN + (size_t)(tok0 + j) * D) + lane;
#pragma unroll
                for (int q = 0; q < 4; ++q) { const f32x4 v = xr[64 * q] * rj, g = gr[64 * q];
                    o8[64 * q] = (unsigned long long)pg8::cvt_pk_bf16(v.x * g.x, v.y * g.y) | ((unsigned long long)pg8::cvt_pk_bf16(v.z * g.z, v.w * g.w) << 32); }
            }
            __syncthreads();
            if (tid < 128) { tokR[tid * 2] = (int)__hip_atomic_fetch_add(hist + tokE[tid * 2], 1u, __ATOMIC_RELAXED, __HIP_MEMORY_SCOPE_WORKGROUP);
                             tokR[tid * 2 + 1] = (int)__hip_atomic_fetch_add(hist + tokE[tid * 2 + 1], 1u, __ATOMIC_RELAXED, __HIP_MEMORY_SCOPE_WORKGROUP); }
            __syncthreads();
            if (tid < 32) { const unsigned hc = hist[tid]; ebase[tid] = hc ? atomicAdd(cnt + tid, hc) : 0u; }
            __syncthreads();
            if (tid < 128) {
                const int tok = unit * 128 + tid;
                const int e0 = tokE[tid * 2], e1 = tokE[tid * 2 + 1]; const int s0 = (int)ebase[e0] + tokR[tid * 2], s1 = (int)ebase[e1] + tokR[tid * 2 + 1];
                row_tok[(size_t)e0 * T + s0] = tok; row_w[(size_t)e0 * T + s0] = tokW[tid * 2];
                row_tok[(size_t)e1 * T + s1] = tok; row_w[(size_t)e1 * T + s1] = tokW[tid * 2 + 1];
                *(int4*)(toktab + tok * 4) = make_int4(e0, s0, e1, s1);
            }
        }
        if (BOTH(6)) xcd_barrier(bar);
    }
    LAS int* blkstart = (LAS int*)(lds + MOE_OFF); LAS int* blk2e = blkstart + 40;
    if (IN(7) || IN(8) || IN(9)) {
        const unsigned* cnt = ctl + CW_CNT;
        if (tid == 0) { int s = 0; for (int e = 0; e < NE; ++e) { blkstart[e] = s; s += (int)((cnt[e] + 255u) >> 8); } blkstart[NE] = s; }
        __syncthreads();
        const int nb = blkstart[NE];
        for (int b = tid; b < nb; b += NWAVES * 64) { int e = 0; while (blkstart[e + 1] <= b) ++e; blk2e[b] = e; }
        __syncthreads();
    }
    if (IN(7)) {
        pg8::MoeOrder S{G, bx, blkstart[NE] * 4, blkstart, blk2e, (const char*)(ws + WS_HN), 0, (const char*)WguT, (size_t)D * D * 2, (size_t)128 * 2048, (const int*)(ws + WS_ROWTOK), ctl + CW_CNT};
        pg8::EpiG1 E{(bf16*)(ws + WS_ACT)};
        pg8::gemm_phase<pg8::EpiG1, pg8::MoeOrder, true, true>(lds + RING_OFF, D, 0u, 512u * 2048u, gspill, S, E);
        if (BOTH(7)) xcd_barrier(bar);
    }
    if (IN(8)) {
        pg8::MoeOrder S{G, bx, blkstart[NE] * 4, blkstart, blk2e, (const char*)(ws + WS_ACT), (size_t)256 * 1024, (const char*)WdT, (size_t)D * DE * 2, (size_t)256 * 1024, (const int*)(ws + WS_ROWTOK), ctl + CW_CNT};
        pg8::EpiG2 E{(bf16*)(ws + WS_YB), (const float*)(ws + WS_ROWW), ctl + CW_CNT};
        pg8::gemm_phase<pg8::EpiG2, pg8::MoeOrder, true, false>(lds + RING_OFF, DE, 128u * 1024u, 128u * 1024u, gspill, S, E);
        if (BOTH(8)) xcd_barrier(bar);
    }
    if (IN(9)) {
        const bf16* YB = (const bf16*)(ws + WS_YB); const int* toktab = (const int*)(ws + WS_TOKTAB);
        const int lane = (int)__builtin_amdgcn_mbcnt_hi(~0u, __builtin_amdgcn_mbcnt_lo(~0u, 0u));
        for (int tok = bx * NWAVES + wave; tok < T; tok += G * NWAVES) {
            const int4 tt = *(const int4*)(toktab + tok * 4);
            const size_t p0 = (size_t)blkstart[tt.x] * 256 + tt.y, p1 = (size_t)blkstart[tt.z] * 256 + tt.w;
            f32x4* orow = (f32x4*)(out + (size_t)tok * D) + lane; const u32x2* y0 = (const u32x2*)(YB + p0 * D) + lane; const u32x2* y1 = (const u32x2*)(YB + p1 * D) + lane;
#pragma unroll
            for (int q = 0; q < 4; ++q) { f32x4 o = orow[64 * q]; const u32x2 a = y0[64 * q], b = y1[64 * q];
                o.x += __uint_as_float(a.x << 16) + __uint_as_float(b.x << 16); o.y += __uint_as_float(a.x & 0xffff0000u) + __uint_as_float(b.x & 0xffff0000u);
                o.z += __uint_as_float(a.y << 16) + __uint_as_float(b.y << 16); o.w += __uint_as_float(a.y & 0xffff0000u) + __uint_as_float(b.y & 0xffff0000u);
                orow[64 * q] = o; }
        }
    }
#undef IN
#undef BOTH
}

extern "C" void kernel_launch(void* const* d_in, const int* in_sizes, int n_in, void* d_out, int out_size, void* d_ws, size_t ws_size, hipStream_t stream) {
    if (n_in != 22 || out_size != T * D || ws_size < WS_END) { fprintf(stderr, "kernel_launch: unexpected sizes (n_in %d out %d ws %zu)\n", n_in, out_size, ws_size); return; }
    static int grid = 0;
    if (grid == 0) {
        int dev = 0, cus = 0;
        if (hipGetDevice(&dev) != hipSuccess || hipDeviceGetAttribute(&cus, hipDeviceAttributeMultiprocessorCount, dev) != hipSuccess) { grid = -1; return; }
        if (hipFuncSetAttribute((const void*)mk_fwd, hipFuncAttributeMaxDynamicSharedMemorySize, LDS_BYTES) != hipSuccess) { fprintf(stderr, "hipFuncSetAttribute failed\n"); grid = -1; return; }
        int per_cu = 0;
        if (hipOccupancyMaxActiveBlocksPerMultiprocessor(&per_cu, (const void*)mk_fwd, NWAVES * 64, LDS_BYTES) != hipSuccess || per_cu < 1) fprintf(stderr, "occupancy query: %d\n", per_cu);
        (void)hipGetLastError();
        grid = cus;
    }
    if (grid < 0) return;
    const float* x = (const float*)d_in[0];
    const float* rel_bias = (const float*)d_in[7]; const float* ret_gn_g = (const float*)d_in[8];
    const float* g_ffn = (const float*)d_in[14];
    const float* w_rg = (const float*)d_in[15]; const float* b_rg = (const float*)d_in[16]; const float* w_re = (const float*)d_in[17]; const float* b_re = (const float*)d_in[18];
    const float* w_gate = (const float*)d_in[19]; const float* w_up = (const float*)d_in[20]; const float* w_down = (const float*)d_in[21];
    unsigned char* ws = (unsigned char*)d_ws; float* out = (float*)d_out;
    (void)hipMemsetAsync(ws + WS_CTL, 0, CTL_BYTES, stream);
    unsigned* cnt = (unsigned*)(ws + WS_CTL) + CW_CNT;
    PB pb{}; pb.QA = (bf16*)(ws + WS_QA); pb.KA = (bf16*)(ws + WS_KA); pb.VA = (bf16*)(ws + WS_VA); pb.QB = (bf16*)(ws + WS_QB); pb.KB = (bf16*)(ws + WS_KB);
    pb.VB = (bf16*)(ws + WS_VB); pb.GB = (bf16*)(ws + WS_GB); pb.QC = (bf16*)(ws + WS_QC); pb.KM = (bf16*)(ws + WS_KM); pb.VM = (bf16*)(ws + WS_VM);
    bf16* CAT = (bf16*)(ws + WS_CAT); bf16* HN = (bf16*)(ws + WS_HN); bf16* ACT = (bf16*)(ws + WS_ACT); bf16* YB = (bf16*)(ws + WS_YB);
    float* RET = (float*)(ws + WS_RKV); int* row_tok = (int*)(ws + WS_ROWTOK); float* row_w = (float*)(ws + WS_ROWW); int* toktab = (int*)(ws + WS_TOKTAB);

    Args a{};
    for (int i = 0; i < 22; ++i) a.in[i] = d_in[i];
    a.out = out; a.ws = ws;
    int li = 0;
#define MK(lo_, hi_) do { a.ph_lo = (lo_); a.ph_hi = (hi_); a.li = li++; hipLaunchKernelGGL(mk_fwd, dim3(grid), dim3(NWAVES * 64), LDS_BYTES, stream, a); } while (0)
    MK(0, 10);
#undef MK
}
```

```cpp
#include <hip/hip_runtime.h>
#include <cstdio>
#include <cstdint>

typedef unsigned short bf16;
typedef float f32x4 __attribute__((ext_vector_type(4)));
typedef unsigned u32x4 __attribute__((ext_vector_type(4)));
typedef unsigned u32x2 __attribute__((ext_vector_type(2)));

constexpr int T = 32768, D = 1024, SEQ = 8192, NBATCH = 4, NMEM = 256, MEMROWS = NBATCH * NMEM;
constexpr int HD = 64, AH = 8, BH = 4, CH = 4;
constexpr int INCOLS = 2816, KVCOLS = 512;
constexpr int CHUNK = 64, NCHUNK = SEQ / CHUNK;
constexpr int NE = 32, DE = 512;
constexpr int MAXBLK = 288;
constexpr float EPS = 1e-6f;
constexpr float LOG2E = 1.4426950408889634f;
constexpr float QSCALE = 0.125f * LOG2E;

constexpr size_t MiB = 1u << 20;
constexpr size_t WS_CTL = 0, CTL_BYTES = 1 * MiB;
constexpr size_t WS_WINT = 2 * MiB;
constexpr size_t WS_WOUTT = 9 * MiB;
constexpr size_t WS_WGUT = 12 * MiB;
constexpr size_t WS_WDT = 76 * MiB;
constexpr size_t WS_XN = 108 * MiB;
constexpr size_t WS_ACT = 108 * MiB;
constexpr size_t WS_QA = 180 * MiB, WS_KA = 212 * MiB, WS_VA = 244 * MiB, WS_QB = 276 * MiB, WS_KB = 292 * MiB, WS_VB = 308 * MiB, WS_GB = 324 * MiB, WS_QC = 340 * MiB;
constexpr size_t WS_KM = 356 * MiB, WS_VM = 356 * MiB + 512 * 1024;
constexpr size_t WS_YB = 180 * MiB;
constexpr size_t WS_RKV = 357 * MiB;
constexpr size_t WS_CAT = 389 * MiB;
constexpr size_t WS_HN = 389 * MiB;
constexpr size_t WS_ROWTOK = 453 * MiB, WS_ROWW = 457 * MiB, WS_TOKTAB = 461 * MiB, WS_ST = 462 * MiB, WS_END = 478 * MiB;
constexpr int CW_CNT = 64;

struct PB { bf16 *QA, *KA, *VA, *QB, *KB, *VB, *GB, *QC, *KM, *VM; };

__device__ __forceinline__ float bf2f(bf16 v) { return __uint_as_float(((unsigned)v) << 16); }
__device__ __forceinline__ bf16 f2bf(float f) { unsigned u = __float_as_uint(f); return (bf16)((u + 0x7fffu + ((u >> 16) & 1u)) >> 16); }
__device__ __forceinline__ unsigned pk2(float lo, float hi) { return (unsigned)f2bf(lo) | ((unsigned)f2bf(hi) << 16); }
__device__ __forceinline__ float wave_sum(float v) {
#pragma unroll
    for (int o = 1; o < 64; o <<= 1) v += __shfl_xor(v, o);
    return v;
}
__device__ __forceinline__ float silu_f(float x) { return x / (1.f + __expf(-x)); }

__device__ __forceinline__ bf16* proj_ptr(const PB& pb, int row, int col) {
    if (col < 512) return pb.QA + (size_t)row * 512 + col;
    if (col < 1024) return pb.KA + (size_t)row * 512 + (col - 512);
    if (col < 1536) return pb.VA + (size_t)row * 512 + (col - 1024);
    if (col < 1792) return pb.QB + (size_t)row * 256 + (col - 1536);
    if (col < 2048) return pb.KB + (size_t)row * 256 + (col - 1792);
    if (col < 2304) return pb.VB + (size_t)row * 256 + (col - 2048);
    if (col < 2560) return pb.GB + (size_t)row * 256 + (col - 2304);
    if (col < 2816) return pb.QC + (size_t)row * 256 + (col - 2560);
    if (col < 3072) return pb.KM + (size_t)(row - T) * 256 + (col - 2816);
    return pb.VM + (size_t)(row - T) * 256 + (col - 3072);
}

__device__ __forceinline__ void transpose_item(const float* W, int K, int N, bf16* WT, int row_off, float* scr, int item, int lane) {
    const int nblk = N / 32, kb = item / nblk, nb = item % nblk, k0 = 64 * kb, n0 = 32 * nb;
#pragma unroll 8
    for (int i = 0; i < 32; ++i) { const int kk = 2 * i + (lane >> 5); scr[kk * 33 + (lane & 31)] = W[(size_t)(k0 + kk) * N + n0 + (lane & 31)]; }
    asm volatile("s_waitcnt lgkmcnt(0)" ::: "memory");
    const int c = lane & 7;
#pragma unroll
    for (int j = 0; j < 4; ++j) { const int n = (lane >> 3) + 8 * j; const float* s = scr + (8 * c) * 33 + n;
        u32x4 o; o.x = pk2(s[0 * 33], s[1 * 33]); o.y = pk2(s[2 * 33], s[3 * 33]); o.z = pk2(s[4 * 33], s[5 * 33]); o.w = pk2(s[6 * 33], s[7 * 33]);
        *(u32x4*)(WT + (size_t)(row_off + n0 + n) * K + k0 + 8 * c) = o; }
    asm volatile("s_waitcnt lgkmcnt(0)" ::: "memory");
}
__device__ __forceinline__ void rms_row_to_bf16(const float* xrow, const float* gain, bf16* orow, int lane) {
    const f32x4* xr = (const f32x4*)xrow + lane; const f32x4* gr = (const f32x4*)gain + lane;
    f32x4 v[4]; float s = 0.f;
#pragma unroll
    for (int j = 0; j < 4; ++j) { v[j] = xr[64 * j]; s += (v[j].x * v[j].x + v[j].y * v[j].y) + (v[j].z * v[j].z + v[j].w * v[j].w); }
    const float r = 1.f / sqrtf(wave_sum(s) * (1.f / D) + EPS);
    unsigned long long* o8 = (unsigned long long*)orow + lane;
#pragma unroll
    for (int j = 0; j < 4; ++j) { const f32x4 g = gr[64 * j];
        o8[64 * j] = (unsigned long long)pk2(v[j].x * r * g.x, v[j].y * r * g.y) | ((unsigned long long)pk2(v[j].z * r * g.z, v[j].w * r * g.w) << 32); }
}

struct P0Args { const float *x, *mem, *g_mix, *g_mem, *w_in, *w_mem_kv, *w_out, *w_gate, *w_up, *w_down; bf16 *XN, *WinT, *WoutT, *WguT, *WdT; };
__global__ void __launch_bounds__(512) k_prologue(P0Args a) {
    __shared__ float scr_all[8 * 64 * 33];
    const int lane = threadIdx.x & 63, wave = threadIdx.x >> 6;
    float* scr = scr_all + wave * 64 * 33;
    const int gw = blockIdx.x * 8 + wave, NGW = gridDim.x * 8;
    constexpr int I_IN = 16 * 88, I_KV = 16 * 16, I_O = 16 * 32, I_E = 256;
    constexpr int NITEMS = I_IN + I_KV + I_O + NE * 3 * I_E;
    for (int it = gw; it < NITEMS; it += NGW) {
        int r = it;
        if (r < I_IN) { transpose_item(a.w_in, D, INCOLS, a.WinT, 0, scr, r, lane); continue; } r -= I_IN;
        if (r < I_KV) { transpose_item(a.w_mem_kv, D, KVCOLS, a.WinT, INCOLS, scr, r, lane); continue; } r -= I_KV;
        if (r < I_O) { transpose_item(a.w_out, D, D, a.WoutT, 0, scr, r, lane); continue; } r -= I_O;
        const int e = r / (3 * I_E), q = r % (3 * I_E);
        if (q < I_E) transpose_item(a.w_gate + (size_t)e * D * DE, D, DE, a.WguT + (size_t)e * D * D, 0, scr, q, lane);
        else if (q < 2 * I_E) transpose_item(a.w_up + (size_t)e * D * DE, D, DE, a.WguT + (size_t)e * D * D, DE, scr, q - I_E, lane);
        else transpose_item(a.w_down + (size_t)e * DE * D, DE, D, a.WdT + (size_t)e * D * DE, 0, scr, q - 2 * I_E, lane);
    }
    for (int m = gw; m < T + MEMROWS; m += NGW) {
        if (m < T) rms_row_to_bf16(a.x + (size_t)m * D, a.g_mix, a.XN + (size_t)m * D, lane);
        else rms_row_to_bf16(a.mem + (size_t)(m - T) * D, a.g_mem, a.XN + (size_t)m * D, lane);
    }
}

template <bool DUAL, class RowMap, class Epi>
__device__ __forceinline__ void nv_gemm_tile(const bf16* A, int lda, const float* B, const float* B2, int ldb, int K, int row0, int col0, RowMap rm, Epi epi) {
    __shared__ float As[16][68];
    __shared__ float Bs[16][68];
    __shared__ float Bs2[DUAL ? 16 : 1][68];
    const int tid = threadIdx.x, tx = tid & 15, ty = tid >> 4;
    float acc[4][4], acc2[4][4];
#pragma unroll
    for (int i = 0; i < 4; ++i)
#pragma unroll
        for (int j = 0; j < 4; ++j) { acc[i][j] = 0.f; acc2[i][j] = 0.f; }
    const int ar = tid >> 2, akq = (tid & 3) * 4;
    const bf16* arow = A + (size_t)rm(row0 + ar) * lda + akq;
    const int bk = tid >> 4, bn = (tid & 15) * 4;
    for (int k0 = 0; k0 < K; k0 += 16) {
        const u32x2 av = *(const u32x2*)(arow + k0);
        As[akq + 0][ar] = __uint_as_float(av.x << 16); As[akq + 1][ar] = __uint_as_float(av.x & 0xffff0000u);
        As[akq + 2][ar] = __uint_as_float(av.y << 16); As[akq + 3][ar] = __uint_as_float(av.y & 0xffff0000u);
        const f32x4 bv = *(const f32x4*)(B + (size_t)(k0 + bk) * ldb + col0 + bn);
        Bs[bk][bn] = bv.x; Bs[bk][bn + 1] = bv.y; Bs[bk][bn + 2] = bv.z; Bs[bk][bn + 3] = bv.w;
        if (DUAL) { const f32x4 b2 = *(const f32x4*)(B2 + (size_t)(k0 + bk) * ldb + col0 + bn);
            Bs2[bk][bn] = b2.x; Bs2[bk][bn + 1] = b2.y; Bs2[bk][bn + 2] = b2.z; Bs2[bk][bn + 3] = b2.w; }
        __syncthreads();
#pragma unroll
        for (int k = 0; k < 16; ++k) {
            float a[4], b[4], c[4];
#pragma unroll
            for (int i = 0; i < 4; ++i) { a[i] = As[k][ty * 4 + i]; b[i] = Bs[k][tx * 4 + i]; c[i] = DUAL ? Bs2[k][tx * 4 + i] : 0.f; }
#pragma unroll
            for (int i = 0; i < 4; ++i)
#pragma unroll
                for (int j = 0; j < 4; ++j) { acc[i][j] += a[i] * b[j]; if (DUAL) acc2[i][j] += a[i] * c[j]; }
        }
        __syncthreads();
    }
#pragma unroll
    for (int i = 0; i < 4; ++i)
#pragma unroll
        for (int j = 0; j < 4; ++j) epi(row0 + ty * 4 + i, col0 + tx * 4 + j, acc[i][j], acc2[i][j]);
}
struct IdMap { __device__ __forceinline__ int operator()(int r) const { return r; } };

__global__ void __launch_bounds__(256) k_nv_inproj(const bf16* XN, const float* W, int ldb, int rowbase, int coloff, PB pb) {
    const int row0 = rowbase + blockIdx.y * 64, col0 = blockIdx.x * 64;
    auto epi = [&](int r, int c, float v, float) { *proj_ptr(pb, r, c + coloff) = f2bf(v); };
    nv_gemm_tile<false>(XN, D, W, nullptr, ldb, D, row0, col0, IdMap(), epi);
}
__global__ void __launch_bounds__(256) k_nv_outproj(const bf16* CAT, const float* W, const float* X, float* OUT) {
    const int row0 = blockIdx.y * 64, col0 = blockIdx.x * 64;
    auto epi = [&](int r, int c, float v, float) { OUT[(size_t)r * D + c] = X[(size_t)r * D + c] + v; };
    nv_gemm_tile<false>(CAT, D, W, nullptr, D, D, row0, col0, IdMap(), epi);
}

__global__ void __launch_bounds__(256) k_nv_postproc(PB pb, const int* positions, const float* qn_a, const float* kn_a, const float* qn_c, const float* kn_c) {
    const long id = (long)blockIdx.x * 256 + threadIdx.x;
    bf16* p; const float* gain = nullptr; float scale = 1.f; int mode; int row;
    if (id < (long)T * 32) {
        row = (int)(id >> 5); const int hi = (int)(id & 31);
        if (hi < 8) { p = pb.QA + (size_t)row * 512 + hi * 64; gain = qn_a; scale = QSCALE; mode = 0; }
        else if (hi < 16) { p = pb.KA + (size_t)row * 512 + (hi - 8) * 64; gain = kn_a; mode = 0; }
        else if (hi < 20) { p = pb.QB + (size_t)row * 256 + (hi - 16) * 64; mode = 1; }
        else if (hi < 24) { p = pb.KB + (size_t)row * 256 + (hi - 20) * 64; mode = 1; scale = 0.125f; }
        else if (hi < 28) { p = pb.GB + (size_t)row * 256 + (hi - 24) * 64; mode = 2; }
        else { p = pb.QC + (size_t)row * 256 + (hi - 28) * 64; gain = qn_c; scale = QSCALE; mode = 0; }
    } else {
        const long id2 = id - (long)T * 32; if (id2 >= MEMROWS * 4) return;
        row = (int)(id2 >> 2); p = pb.KM + (size_t)row * 256 + (id2 & 3) * 64; gain = kn_c; mode = 0;
    }
    if (mode == 0) {
        float ss = 0.f;
        for (int d = 0; d < 64; ++d) { const float v = bf2f(p[d]); ss += v * v; }
        const float r = 1.f / sqrtf(ss * (1.f / 64.f) + EPS);
        for (int d = 0; d < 64; ++d) p[d] = f2bf(bf2f(p[d]) * r * gain[d] * scale);
    } else if (mode == 1) {
        const float pos = (float)positions[row];
        for (int i = 0; i < 32; ++i) {
            const float inv = exp2f(-(float)i * (13.287712379549449f / 32.f));
            float rev = pos * inv * 0.15915494309189535f; rev -= floorf(rev);
            const float sn = __builtin_amdgcn_sinf(rev), cs = __builtin_amdgcn_cosf(rev);
            const float t1 = bf2f(p[i]), t2 = bf2f(p[i + 32]);
            p[i] = f2bf((t1 * cs - t2 * sn) * scale); p[i + 32] = f2bf((t1 * sn + t2 * cs) * scale);
        }
    } else {
        for (int d = 0; d < 64; ++d) p[d] = f2bf(silu_f(bf2f(p[d])));
    }
}

__device__ __forceinline__ void nv_attnA_unit(int u, int lane_, const bf16* QA, const bf16* KA, const bf16* VA, const float* rel_bias, bf16* CAT) {
    const int c = u % NCHUNK, h = (u / NCHUNK) % AH, b = u / (NCHUNK * AH);
    const int i = lane_; const size_t qrow = (size_t)b * SEQ + c * CHUNK + i;
    float q[64];
#pragma unroll
    for (int d8 = 0; d8 < 8; ++d8) { const u32x4 v = *(const u32x4*)(QA + qrow * 512 + h * 64 + d8 * 8);
        q[d8 * 8 + 0] = __uint_as_float(v.x << 16); q[d8 * 8 + 1] = __uint_as_float(v.x & 0xffff0000u); q[d8 * 8 + 2] = __uint_as_float(v.y << 16); q[d8 * 8 + 3] = __uint_as_float(v.y & 0xffff0000u);
        q[d8 * 8 + 4] = __uint_as_float(v.z << 16); q[d8 * 8 + 5] = __uint_as_float(v.z & 0xffff0000u); q[d8 * 8 + 6] = __uint_as_float(v.w << 16); q[d8 * 8 + 7] = __uint_as_float(v.w & 0xffff0000u); }
    const float* bias = rel_bias + h * 192;
    float m = -3.0e38f;
    for (int pass = 0; pass < 2; ++pass) {
        float l = 0.f; float o[64];
#pragma unroll
        for (int d = 0; d < 64; ++d) o[d] = 0.f;
        for (int j = 0; j < 9; ++j) {
            const int kc = c - 8 + j; if (kc < 0) continue;
            for (int kk = 0; kk < 64; ++kk) {
                const size_t krow = (size_t)b * SEQ + kc * CHUNK + kk;
                const bf16* kp = KA + krow * 512 + h * 64;
                float s = 0.f;
#pragma unroll
                for (int d8 = 0; d8 < 8; ++d8) { const u32x4 v = *(const u32x4*)(kp + d8 * 8);
                    s += q[d8 * 8 + 0] * __uint_as_float(v.x << 16) + q[d8 * 8 + 1] * __uint_as_float(v.x & 0xffff0000u) + q[d8 * 8 + 2] * __uint_as_float(v.y << 16) + q[d8 * 8 + 3] * __uint_as_float(v.y & 0xffff0000u)
                       + q[d8 * 8 + 4] * __uint_as_float(v.z << 16) + q[d8 * 8 + 5] * __uint_as_float(v.z & 0xffff0000u) + q[d8 * 8 + 6] * __uint_as_float(v.w << 16) + q[d8 * 8 + 7] * __uint_as_float(v.w & 0xffff0000u); }
                int rel = (8 - j) * 64 + i - kk; rel = rel < -63 ? -63 : (rel > 128 ? 128 : rel);
                s += bias[rel + 63] * LOG2E;
                if (pass == 0) { m = fmaxf(m, s); }
                else {
                    const float p = exp2f(s - m); l += p;
                    const bf16* vp = VA + krow * 512 + h * 64;
#pragma unroll
                    for (int d8 = 0; d8 < 8; ++d8) { const u32x4 v = *(const u32x4*)(vp + d8 * 8);
                        o[d8 * 8 + 0] += p * __uint_as_float(v.x << 16); o[d8 * 8 + 1] += p * __uint_as_float(v.x & 0xffff0000u); o[d8 * 8 + 2] += p * __uint_as_float(v.y << 16); o[d8 * 8 + 3] += p * __uint_as_float(v.y & 0xffff0000u);
                        o[d8 * 8 + 4] += p * __uint_as_float(v.z << 16); o[d8 * 8 + 5] += p * __uint_as_float(v.z & 0xffff0000u); o[d8 * 8 + 6] += p * __uint_as_float(v.w << 16); o[d8 * 8 + 7] += p * __uint_as_float(v.w & 0xffff0000u); }
                }
            }
        }
        if (pass == 1) {
            const float il = 1.f / l; bf16* op = CAT + qrow * D + h * 64;
#pragma unroll
            for (int d = 0; d < 64; d += 2) *(unsigned*)(op + d) = pk2(o[d] * il, o[d + 1] * il);
        }
    }
}
__device__ __forceinline__ void nv_cross_unit(int u, int lane_, const bf16* QC, const bf16* KM, const bf16* VM, bf16* CAT) {
    const int c = u % NCHUNK, h = (u / NCHUNK) % CH, b = u / (NCHUNK * CH);
    const int i = lane_; const size_t qrow = (size_t)b * SEQ + c * CHUNK + i;
    float q[64];
#pragma unroll
    for (int d8 = 0; d8 < 8; ++d8) { const u32x4 v = *(const u32x4*)(QC + qrow * 256 + h * 64 + d8 * 8);
        q[d8 * 8 + 0] = __uint_as_float(v.x << 16); q[d8 * 8 + 1] = __uint_as_float(v.x & 0xffff0000u); q[d8 * 8 + 2] = __uint_as_float(v.y << 16); q[d8 * 8 + 3] = __uint_as_float(v.y & 0xffff0000u);
        q[d8 * 8 + 4] = __uint_as_float(v.z << 16); q[d8 * 8 + 5] = __uint_as_float(v.z & 0xffff0000u); q[d8 * 8 + 6] = __uint_as_float(v.w << 16); q[d8 * 8 + 7] = __uint_as_float(v.w & 0xffff0000u); }
    float m = -3.0e38f;
    for (int pass = 0; pass < 2; ++pass) {
        float l = 0.f; float o[64];
#pragma unroll
        for (int d = 0; d < 64; ++d) o[d] = 0.f;
        for (int kk = 0; kk < NMEM; ++kk) {
            const size_t krow = (size_t)b * NMEM + kk;
            const bf16* kp = KM + krow * 256 + h * 64;
            float s = 0.f;
#pragma unroll
            for (int d8 = 0; d8 < 8; ++d8) { const u32x4 v = *(const u32x4*)(kp + d8 * 8);
                s += q[d8 * 8 + 0] * __uint_as_float(v.x << 16) + q[d8 * 8 + 1] * __uint_as_float(v.x & 0xffff0000u) + q[d8 * 8 + 2] * __uint_as_float(v.y << 16) + q[d8 * 8 + 3] * __uint_as_float(v.y & 0xffff0000u)
                   + q[d8 * 8 + 4] * __uint_as_float(v.z << 16) + q[d8 * 8 + 5] * __uint_as_float(v.z & 0xffff0000u) + q[d8 * 8 + 6] * __uint_as_float(v.w << 16) + q[d8 * 8 + 7] * __uint_as_float(v.w & 0xffff0000u); }
            if (pass == 0) { m = fmaxf(m, s); }
            else {
                const float p = exp2f(s - m); l += p;
                const bf16* vp = VM + krow * 256 + h * 64;
#pragma unroll
                for (int d8 = 0; d8 < 8; ++d8) { const u32x4 v = *(const u32x4*)(vp + d8 * 8);
                    o[d8 * 8 + 0] += p * __uint_as_float(v.x << 16); o[d8 * 8 + 1] += p * __uint_as_float(v.x & 0xffff0000u); o[d8 * 8 + 2] += p * __uint_as_float(v.y << 16); o[d8 * 8 + 3] += p * __uint_as_float(v.y & 0xffff0000u);
                    o[d8 * 8 + 4] += p * __uint_as_float(v.z << 16); o[d8 * 8 + 5] += p * __uint_as_float(v.z & 0xffff0000u); o[d8 * 8 + 6] += p * __uint_as_float(v.w << 16); o[d8 * 8 + 7] += p * __uint_as_float(v.w & 0xffff0000u); }
            }
        }
        if (pass == 1) {
            const float il = 1.f / l; bf16* op = CAT + qrow * D + 768 + h * 64;
#pragma unroll
            for (int d = 0; d < 64; d += 2) *(unsigned*)(op + d) = pk2(o[d] * il, o[d + 1] * il);
        }
    }
}
__device__ __forceinline__ void nv_ret_unit(int u, int lane_, const bf16* QB, const bf16* KB, const bf16* VB, float* RET) {
    const int e = u & 63, h = (u >> 6) & 3, b = u >> 8; const int d = lane_;
    const float gamma = 1.f - exp2f(-5.f - (float)h);
    float S = 0.f;
    for (int n = 0; n < SEQ; ++n) {
        const size_t row = (size_t)b * SEQ + n;
        const float kd = bf2f(KB[row * 256 + h * 64 + d]), qd = bf2f(QB[row * 256 + h * 64 + d]), ve = bf2f(VB[row * 256 + h * 64 + e]);
        S = gamma * S + kd * ve;
        const float o = wave_sum(qd * S);
        if (d == 0) RET[row * 256 + h * 64 + e] = o;
    }
}
__device__ __forceinline__ void nv_retnorm_item(int id, const float* RET, const bf16* GB, const float* gn_g, bf16* CAT) {
    const int row = id >> 2, h = id & 3;
    const float* r = RET + (size_t)row * 256 + h * 64;
    float mu = 0.f; for (int d = 0; d < 64; ++d) mu += r[d]; mu *= (1.f / 64.f);
    float var = 0.f; for (int d = 0; d < 64; ++d) { const float t = r[d] - mu; var += t * t; } var *= (1.f / 64.f);
    const float rs = 1.f / sqrtf(var + EPS);
    for (int d = 0; d < 64; ++d) { const float y = (r[d] - mu) * rs * gn_g[h * 64 + d];
        CAT[(size_t)row * D + 512 + h * 64 + d] = f2bf(bf2f(GB[(size_t)row * 256 + h * 64 + d]) * y); }
}

__global__ void __launch_bounds__(256) k_nv_router(const float* H, const float* g_ffn, const float* w_rg, const float* b_rg, const float* w_re, const float* b_re,
                                                   bf16* HN, unsigned* cnt, int* row_tok, float* row_w, int* toktab) {
    const int lane = threadIdx.x & 63, tok = blockIdx.x * 4 + (threadIdx.x >> 6);
    const float* hrow = H + (size_t)tok * D;
    float ss = 0.f;
#pragma unroll
    for (int j = 0; j < 16; ++j) { const float v = hrow[lane + 64 * j]; ss += v * v; }
    const float r = 1.f / sqrtf(wave_sum(ss) * (1.f / D) + EPS);
    float acc[36];
#pragma unroll
    for (int q = 0; q < 36; ++q) acc[q] = 0.f;
#pragma unroll 2
    for (int j = 0; j < 16; ++j) {
        const int k = lane + 64 * j; const float hn = hrow[k] * r * g_ffn[k];
        HN[(size_t)tok * D + k] = f2bf(hn);
        const f32x4 wg = *(const f32x4*)(w_rg + (size_t)k * 4);
        acc[0] += hn * wg.x; acc[1] += hn * wg.y; acc[2] += hn * wg.z; acc[3] += hn * wg.w;
#pragma unroll
        for (int q = 0; q < 8; ++q) { const f32x4 we = *(const f32x4*)(w_re + (size_t)k * 32 + 4 * q);
            acc[4 + 4 * q] += hn * we.x; acc[5 + 4 * q] += hn * we.y; acc[6 + 4 * q] += hn * we.z; acc[7 + 4 * q] += hn * we.w; }
    }
#pragma unroll
    for (int q = 0; q < 36; ++q) acc[q] = wave_sum(acc[q]);
    float gl[4];
#pragma unroll
    for (int g = 0; g < 4; ++g) gl[g] = acc[g] + b_rg[g];
    int gs = 0; float gm = gl[0];
#pragma unroll
    for (int g = 1; g < 4; ++g) if (gl[g] > gm) { gm = gl[g]; gs = g; }
    float gsum = 0.f;
#pragma unroll
    for (int g = 0; g < 4; ++g) gsum += __expf(gl[g] - gm);
    const float pg = 1.f / gsum;
    float el[8];
#pragma unroll
    for (int i = 0; i < 8; ++i) { const float k0 = gs == 0 ? 1.f : 0.f, k1 = gs == 1 ? 1.f : 0.f, k2 = gs == 2 ? 1.f : 0.f, k3 = gs == 3 ? 1.f : 0.f;
        el[i] = k0 * acc[4 + i] + k1 * acc[12 + i] + k2 * acc[20 + i] + k3 * acc[28 + i] + b_re[gs * 8 + i]; }
    int i0 = 0; float m0 = el[0];
#pragma unroll
    for (int i = 1; i < 8; ++i) if (el[i] > m0) { m0 = el[i]; i0 = i; }
    int i1 = -1; float m1 = -3.0e38f;
#pragma unroll
    for (int i = 0; i < 8; ++i) if (i != i0 && el[i] > m1) { m1 = el[i]; i1 = i; }
    const float p1 = __expf(m1 - m0);
    const float w0 = pg / (1.f + p1), w1 = pg * p1 / (1.f + p1);
    if (lane == 0) {
        const int e0 = gs * 8 + i0, e1 = gs * 8 + i1;
        const unsigned s0 = atomicAdd(&cnt[e0], 1u), s1 = atomicAdd(&cnt[e1], 1u);
        row_tok[(size_t)e0 * T + s0] = tok; row_w[(size_t)e0 * T + s0] = w0;
        row_tok[(size_t)e1 * T + s1] = tok; row_w[(size_t)e1 * T + s1] = w1;
        toktab[tok * 4 + 0] = e0; toktab[tok * 4 + 1] = (int)s0; toktab[tok * 4 + 2] = e1; toktab[tok * 4 + 3] = (int)s1;
    }
}

__device__ __forceinline__ void moe_blkstart(const unsigned* cnt, int* blkstart  ) {
    int s = 0;
    for (int e = 0; e < NE; ++e) { blkstart[e] = s; s += (int)((cnt[e] + 255u) >> 8); }
    blkstart[NE] = s;
}
struct GatherMap { const int* tok; unsigned n; int base; __device__ __forceinline__ int operator()(int r) const { const unsigned s = (unsigned)(r - base); return s < n ? tok[s] : 0; } };

__global__ void __launch_bounds__(256) k_nv_g1(const bf16* HN, const float* w_gate, const float* w_up, const unsigned* cnt, const int* row_tok, bf16* ACT) {
    __shared__ int bs[33];
    if (threadIdx.x == 0) moe_blkstart(cnt, bs);
    __syncthreads();
    const int sb = blockIdx.x, bidx = sb >> 2; if (bidx >= bs[NE]) return;
    int e = 0; while (bs[e + 1] <= bidx) ++e;
    const int rb = bidx - bs[e]; const int slot0 = rb * 256 + (sb & 3) * 64;
    const int prow0 = bidx * 256 + (sb & 3) * 64;
    GatherMap gm{row_tok + (size_t)e * T, cnt[e], prow0 - slot0};
    auto epi = [&](int r, int c, float g, float u) { ACT[(size_t)r * DE + c] = f2bf(silu_f(g) * u); };
    nv_gemm_tile<true>(HN, D, w_gate + (size_t)e * D * DE, w_up + (size_t)e * D * DE, DE, D, prow0, blockIdx.y * 64, gm, epi);
}
__global__ void __launch_bounds__(256) k_nv_g2(const bf16* ACT, const float* w_down, const unsigned* cnt, const float* row_w, bf16* YB) {
    __shared__ int bs[33];
    if (threadIdx.x == 0) moe_blkstart(cnt, bs);
    __syncthreads();
    const int sb = blockIdx.x, bidx = sb >> 2; if (bidx >= bs[NE]) return;
    int e = 0; while (bs[e + 1] <= bidx) ++e;
    const int rb = bidx - bs[e]; const int prow0 = bidx * 256 + (sb & 3) * 64; const int sbase = prow0 - (rb * 256 + (sb & 3) * 64);
    const float* wl = row_w + (size_t)e * T; const unsigned n = cnt[e];
    auto epi = [&](int r, int c, float v, float) { const unsigned s = (unsigned)(r - sbase); const float w = s < n ? wl[s] : 0.f; YB[(size_t)r * D + c] = f2bf(w * v); };
    nv_gemm_tile<false>(ACT, DE, w_down + (size_t)e * DE * D, nullptr, D, DE, prow0, blockIdx.y * 64, IdMap(), epi);
}
__global__ void __launch_bounds__(256) k_combine(float* OUT, const bf16* YB, const unsigned* cnt, const int* toktab) {
    __shared__ int bs[33];
    if (threadIdx.x == 0) moe_blkstart(cnt, bs);
    __syncthreads();
    const int tok = blockIdx.x; const int c = threadIdx.x * 4;
    const int e0 = toktab[tok * 4], s0 = toktab[tok * 4 + 1], e1 = toktab[tok * 4 + 2], s1 = toktab[tok * 4 + 3];
    const size_t p0 = (size_t)bs[e0] * 256 + s0, p1 = (size_t)bs[e1] * 256 + s1;
    f32x4 o = *(f32x4*)(OUT + (size_t)tok * D + c);
    const u32x2 a = *(const u32x2*)(YB + p0 * D + c), b = *(const u32x2*)(YB + p1 * D + c);
    o.x += __uint_as_float(a.x << 16) + __uint_as_float(b.x << 16); o.y += __uint_as_float(a.x & 0xffff0000u) + __uint_as_float(b.x & 0xffff0000u);
    o.z += __uint_as_float(a.y << 16) + __uint_as_float(b.y << 16); o.w += __uint_as_float(a.y & 0xffff0000u) + __uint_as_float(b.y & 0xffff0000u);
    *(f32x4*)(OUT + (size_t)tok * D + c) = o;
}

__global__ void __launch_bounds__(64) k_nv_attnA(const bf16* QA, const bf16* KA, const bf16* VA, const float* rel_bias, bf16* CAT) { nv_attnA_unit(blockIdx.x, threadIdx.x, QA, KA, VA, rel_bias, CAT); }
__global__ void __launch_bounds__(64) k_nv_cross(const bf16* QC, const bf16* KM, const bf16* VM, bf16* CAT) { nv_cross_unit(blockIdx.x, threadIdx.x, QC, KM, VM, CAT); }
__global__ void __launch_bounds__(64) k_nv_ret(const bf16* QB, const bf16* KB, const bf16* VB, float* RET) { nv_ret_unit(blockIdx.x, threadIdx.x, QB, KB, VB, RET); }
__global__ void __launch_bounds__(256) k_nv_retnorm(const float* RET, const bf16* GB, const float* gn_g, bf16* CAT) { nv_retnorm_item(blockIdx.x * 256 + threadIdx.x, RET, GB, gn_g, CAT); }
namespace pg8 {
#define PG8_LAS __attribute__((address_space(3)))
typedef short bf16x8 __attribute__((ext_vector_type(8)));
constexpr int BM = 256, BK = 64, HALF = 128, HTB = HALF * BK * 2, STAGE_BYTES = 8 * HTB, NXCD = 8, WGM = 8;

__host__ __device__ __forceinline__ int lds_byte(int r, int c) { const int st = (r >> 4) * 2 + (c >> 5), rr = r & 15, cc = c & 31, ob = rr * 64 + cc * 2; return st * 1024 + (ob ^ (((ob >> 9) & 1) << 5)); }
__host__ __device__ __forceinline__ void stage_rc(int b, int& R, int& C) { const int st = b / 1024, sb = b % 1024, swz = sb ^ (((sb >> 9) & 1) << 5); R = (st >> 1) * 16 + swz / 64; C = (st & 1) * 32 + (swz % 64) / 2; }
__host__ __device__ __forceinline__ int perm32(int rho) { const int n = rho >> 4, i = rho & 15; return 8 * (i >> 2) + 4 * n + (i & 3); }

struct Unit { int pm, pn; const char* a; const char* b; int e, rb; };

__device__ __forceinline__ void static_map(int L, int nM, int nN, int& pm, int& pn) {
    const int nwg = nM * nN; int wgid = L;
    { const int q = nwg / NXCD, r = nwg % NXCD, xcd = wgid % NXCD, off = wgid / NXCD; wgid = (xcd < r ? xcd * (q + 1) : r * (q + 1) + (xcd - r) * q) + off; }
    const int nig = WGM * nN, gid = wgid / nig, fm = gid * WGM, gsz = (nM - fm) < WGM ? (nM - fm) : WGM;
    pm = fm + ((wgid % nig) % gsz); pn = (wgid % nig) / gsz;
}

__device__ __forceinline__ unsigned cvt_pk_bf16(float lo, float hi) { unsigned r; asm volatile("v_cvt_pk_bf16_f32 %0, %1, %2" : "=v"(r) : "v"(lo), "v"(hi)); return r; }

template <class Epi, class Sched, bool ALIGN_EPI, bool GATHER>
__device__ __forceinline__ void gemm_phase(PG8_LAS unsigned char* lds, const int K, const unsigned hstepA, const unsigned hstepB, PG8_LAS unsigned* gspill, const Sched& S, const Epi& E) {
    int tid_ = threadIdx.x; asm volatile("" : "+v"(tid_));
    const int tid = tid_, wid = __builtin_amdgcn_readfirstlane(tid >> 6), lane = tid & 63, wr = wid >> 2, wc = wid & 3, fr = lane & 15, fq = lane >> 4;
    const int nt = K / BK;
    unsigned vA[2][2], voffB[2];
#pragma unroll
    for (int i = 0; i < 2; ++i) { int R, C; stage_rc(tid * 16 + i * 8192, R, C);
        const int Rb = Epi::BMAP == 0 ? R : (Epi::BMAP == 1 ? ((R & ~31) + perm32(R & 31)) : (2 * (R & ~31) + perm32(R & 31)));
        voffB[i] = (unsigned)(Rb * K + C) * 2u; vA[0][i] = (unsigned)(R * K + C) * 2u; vA[1][i] = vA[0][i] + hstepA; }
    const size_t kstep = (size_t)(BK * 2);
    const unsigned ldsw = (unsigned)wid * 1024u;
    const int aoff = lds_byte(wr * 64 + fr, fq * 8), boff = lds_byte(wc * 32 + fr, fq * 8);
#define PG8_SA(b, h) (((b) * 2 + (h)) * HTB)
#define PG8_SB(b, h) ((4 + (b) * 2 + (h)) * HTB)
#define PG8_STAGE_B(bufoff, gbase) do { _Pragma("unroll") for (int _i = 0; _i < 2; ++_i) \
        __builtin_amdgcn_global_load_lds((const unsigned*)((const char*)(gbase) + voffB[_i]), (PG8_LAS unsigned*)(lds + (bufoff) + ldsw + _i * 8192), 16, 0, 0); } while (0)
#define PG8_STAGE_A(bufoff, gbase, h) do { _Pragma("unroll") for (int _i = 0; _i < 2; ++_i) \
        __builtin_amdgcn_global_load_lds((const unsigned*)((const char*)(gbase) + vA[h][_i]), (PG8_LAS unsigned*)(lds + (bufoff) + ldsw + _i * 8192), 16, 0, 0); } while (0)
#define PG8_LDA(dst, b, h) do { _Pragma("unroll") for (int m = 0; m < 4; ++m) _Pragma("unroll") for (int k = 0; k < 2; ++k) dst[m][k] = *(const PG8_LAS bf16x8*)(lds + PG8_SA(b, h) + aoff + m * 2048 + k * 1024); } while (0)
#define PG8_LDB(dst, b, h) do { _Pragma("unroll") for (int n = 0; n < 2; ++n) _Pragma("unroll") for (int k = 0; k < 2; ++k) dst[n][k] = *(const PG8_LAS bf16x8*)(lds + PG8_SB(b, h) + boff + n * 2048 + k * 1024); } while (0)
#define PG8_MMA(ai, bj, At, Bt) do { __builtin_amdgcn_s_setprio(1); _Pragma("unroll") for (int m = 0; m < 4; ++m) _Pragma("unroll") for (int n = 0; n < 2; ++n) _Pragma("unroll") for (int k = 0; k < 2; ++k) \
        acc[ai][bj][m][n] = __builtin_amdgcn_mfma_f32_16x16x32_bf16(Bt[n][k], At[m][k], acc[ai][bj][m][n], 0, 0, 0); __builtin_amdgcn_s_setprio(0); } while (0)
#define PG8_WAIT_V(n) asm volatile("s_waitcnt vmcnt(" #n ")" ::: "memory")
#define PG8_WAIT_L(n) asm volatile("s_waitcnt lgkmcnt(" #n ")" ::: "memory")
#define PG8_BAR __builtin_amdgcn_s_barrier()
#define PG8_SCHED __builtin_amdgcn_sched_barrier(0)
    Unit cur, nxt; int ui = 0;
    if (!S.next(0, cur)) return;
    if constexpr (GATHER) {
#pragma unroll
        for (int i = 0; i < 2; ++i) { int R, C; stage_rc(tid * 16 + i * 8192, R, C);
#pragma unroll
            for (int h = 0; h < 2; ++h) vA[h][i] = (unsigned)S.arow(cur, h * HALF + R) * (unsigned)(K * 2) + (unsigned)(C * 2); }
    }
    f32x4 acc[2][2][4][2];
#pragma unroll
    for (int a = 0; a < 2; ++a)
#pragma unroll
        for (int b = 0; b < 2; ++b)
#pragma unroll
            for (int m = 0; m < 4; ++m)
#pragma unroll
                for (int n = 0; n < 2; ++n) acc[a][b][m][n] = (f32x4){0.f, 0.f, 0.f, 0.f};
    bf16x8 At[4][2], B0[2][2], B1[2][2];
    const char* cA = cur.a; const char* cB = cur.b;
    PG8_STAGE_B(PG8_SB(0, 0), cB); PG8_STAGE_B(PG8_SB(0, 1), cB + hstepB); PG8_STAGE_A(PG8_SA(0, 0), cA, 0); PG8_STAGE_A(PG8_SA(0, 1), cA, 1);
    if (wr == 1) PG8_BAR;
    PG8_WAIT_V(2); PG8_BAR;
    PG8_STAGE_B(PG8_SB(1, 0), cB + kstep); PG8_STAGE_A(PG8_SA(1, 0), cA + kstep, 0); PG8_STAGE_B(PG8_SB(1, 1), cB + hstepB + kstep);
    PG8_WAIT_V(6); PG8_BAR;
    for (;;) {
        const bool has_next = S.next(ui + 1, nxt);
        const char* nA = has_next ? nxt.a : cA; const char* nB = has_next ? nxt.b : cB;
        if constexpr (GATHER) {
            if (has_next) {
                unsigned o[4];
#pragma unroll
                for (int i = 0; i < 2; ++i) { int R, C; stage_rc(tid * 16 + i * 8192, R, C);
#pragma unroll
                    for (int h = 0; h < 2; ++h) o[h * 2 + i] = (unsigned)S.arow(nxt, h * HALF + R) * (unsigned)(K * 2) + (unsigned)(C * 2); }
                *(PG8_LAS u32x4*)(gspill + tid * 4) = (u32x4){o[0], o[1], o[2], o[3]};
            }
        }
        for (int t = 0; t < nt; t += 2) {
            const bool last = (t == nt - 2);
            const char* a1 = cA + (size_t)(t + 1) * kstep;
            const char* a2 = last ? nA : cA + (size_t)(t + 2) * kstep; const char* b2 = last ? nB : cB + (size_t)(t + 2) * kstep;
            const char* a3 = a2 + kstep; const char* b3 = b2 + kstep;
            PG8_LDB(B0, 0, 0); PG8_LDB(B1, 0, 1); PG8_SCHED; PG8_LDA(At, 0, 0); PG8_STAGE_A(PG8_SA(1, 1), a1, 1);
            if constexpr (GATHER) { if (last && has_next) { const u32x4 o = *(const PG8_LAS u32x4*)(gspill + tid * 4); vA[0][0] = o.x; vA[0][1] = o.y; vA[1][0] = o.z; vA[1][1] = o.w; } }
            PG8_WAIT_V(8); PG8_WAIT_L(0); PG8_BAR; PG8_MMA(0, 0, At, B0); PG8_MMA(0, 1, At, B1); PG8_BAR; PG8_SCHED;
            PG8_LDA(At, 0, 1); PG8_STAGE_B(PG8_SB(0, 0), b2); PG8_STAGE_B(PG8_SB(0, 1), b2 + hstepB); PG8_STAGE_A(PG8_SA(0, 0), a2, 0);
            PG8_WAIT_V(8); PG8_WAIT_L(0); PG8_BAR; PG8_MMA(1, 0, At, B0); PG8_MMA(1, 1, At, B1); PG8_BAR; PG8_SCHED;
            PG8_LDB(B0, 1, 0); PG8_LDB(B1, 1, 1); PG8_SCHED; PG8_LDA(At, 1, 0); PG8_STAGE_A(PG8_SA(0, 1), a2, 1);
            PG8_WAIT_V(8); PG8_WAIT_L(0); PG8_BAR; PG8_MMA(0, 0, At, B0); PG8_MMA(0, 1, At, B1); PG8_BAR; PG8_SCHED;
            PG8_LDA(At, 1, 1); PG8_STAGE_B(PG8_SB(1, 0), b3); PG8_STAGE_B(PG8_SB(1, 1), b3 + hstepB); PG8_STAGE_A(PG8_SA(1, 0), a3, 0);
            PG8_WAIT_V(8); PG8_WAIT_L(0); PG8_BAR; PG8_MMA(1, 0, At, B0); PG8_MMA(1, 1, At, B1); PG8_BAR; PG8_SCHED;
        }
        if constexpr (ALIGN_EPI) { if (wr == 0) PG8_BAR; }
        E(acc, cur, wr, wc, fr, fq);
        if (!has_next) break;
#pragma unroll
        for (int a = 0; a < 2; ++a)
#pragma unroll
            for (int b = 0; b < 2; ++b)
#pragma unroll
                for (int m = 0; m < 4; ++m)
#pragma unroll
                    for (int n = 0; n < 2; ++n) acc[a][b][m][n] = (f32x4){0.f, 0.f, 0.f, 0.f};
        cur = nxt; cA = nA; cB = nB; ++ui;
        if constexpr (ALIGN_EPI) { if (wr == 1) PG8_BAR; }
    }
    PG8_WAIT_V(0);
    if constexpr (!ALIGN_EPI) { if (wr == 0) PG8_BAR; }
    PG8_BAR;
#undef PG8_SA
#undef PG8_SB
#undef PG8_STAGE_A
#undef PG8_STAGE_B
#undef PG8_LDA
#undef PG8_LDB
#undef PG8_MMA
#undef PG8_WAIT_V
#undef PG8_WAIT_L
#undef PG8_BAR
#undef PG8_SCHED
}

struct ProjOrder {
    int G, c; const char* A; const char* Bt;
    __device__ __forceinline__ bool next(int i, Unit& u) const {
        const int L = i * G + c; if (L >= 1416) return false;
        int pm, pn;
        if (L < 1408) static_map(L, 128, 11, pm, pn); else { const int j = L - 1408; pm = 128 + (j >> 1); pn = 11 + (j & 1); }
        u.pm = pm; u.pn = pn; u.a = A + (size_t)pm * (256 * 2048); u.b = Bt + (size_t)pn * (256 * 2048); u.e = 0; u.rb = 0; return true;
    }
    __device__ __forceinline__ int arow(const Unit&, int) const { return 0; }
};
struct PlainOrder {
    int G, c, nM, nN; const char* A; const char* Bt; int ldbytes;
    __device__ __forceinline__ bool next(int i, Unit& u) const {
        const int L = i * G + c; if (L >= nM * nN) return false;
        int pm, pn; static_map(L, nM, nN, pm, pn);
        u.pm = pm; u.pn = pn; u.a = A + (size_t)pm * 256 * ldbytes; u.b = Bt + (size_t)pn * 256 * ldbytes; u.e = 0; u.rb = 0; return true;
    }
    __device__ __forceinline__ int arow(const Unit&, int) const { return 0; }
};

struct MoeOrder {
    int G, c, nunits; const PG8_LAS int* blkstart; const PG8_LAS int* blk2e;
    const char* Abase; size_t aBlk; const char* Bbase; size_t bExp, bTile; const int* row_tok; const unsigned* cnt;
    __device__ __forceinline__ bool next(int i, Unit& u) const {
        const int L = i * G + c; if (L >= nunits) return false;
        const int bidx = L >> 2, pn = L & 3;
        const int e = __builtin_amdgcn_readfirstlane(blk2e[bidx]); const int rb = bidx - __builtin_amdgcn_readfirstlane(blkstart[e]);
        u.pm = bidx; u.pn = pn; u.e = e; u.rb = rb; u.a = Abase + (size_t)bidx * aBlk; u.b = Bbase + (size_t)e * bExp + (size_t)pn * bTile; return true;
    }
    __device__ __forceinline__ int arow(const Unit& u, int r) const { const unsigned s = (unsigned)(u.rb * 256 + r); return s < cnt[u.e] ? row_tok[(size_t)u.e * T + s] : 0; }
};

struct EpiProj {
    static constexpr int BMAP = 2;
    PB pb; const int* positions; const float *qn_a, *kn_a, *qn_c, *kn_c;
    __device__ __forceinline__ void operator()(const f32x4 (&acc)[2][2][4][2], const Unit& u, int wr, int wc, int fr, int fq) const {
        const int pn = u.pn;
        bf16* dst; int ld, colbase = 0, mode = 3; const float* gain = nullptr; float scale = 1.f; int rowoff = 0;
        if (pn < 2) { dst = pb.QA; ld = 512; colbase = pn * 256; mode = 0; gain = qn_a; scale = QSCALE; }
        else if (pn < 4) { dst = pb.KA; ld = 512; colbase = (pn - 2) * 256; mode = 0; gain = kn_a; }
        else if (pn < 6) { dst = pb.VA; ld = 512; colbase = (pn - 4) * 256; }
        else if (pn == 6) { dst = pb.QB; ld = 256; mode = 1; }
        else if (pn == 7) { dst = pb.KB; ld = 256; mode = 1; scale = 0.125f; }
        else if (pn == 8) { dst = pb.VB; ld = 256; }
        else if (pn == 9) { dst = pb.GB; ld = 256; mode = 2; }
        else if (pn == 10) { dst = pb.QC; ld = 256; mode = 0; gain = qn_c; scale = QSCALE; }
        else if (pn == 11) { dst = pb.KM; ld = 256; mode = 0; gain = kn_c; rowoff = T; }
        else { dst = pb.VM; ld = 256; rowoff = T; }
        const int row0 = u.pm * BM + wr * 64 + fr - rowoff;
        bf16* base = dst + colbase + wc * 64 + 8 * fq;
        if (mode == 0) {
            f32x4 g[2][2];
#pragma unroll
            for (int bj = 0; bj < 2; ++bj)
#pragma unroll
                for (int n = 0; n < 2; ++n) g[bj][n] = *(const f32x4*)(gain + 32 * bj + 8 * fq + 4 * n) * scale;
#pragma unroll
            for (int ai = 0; ai < 2; ++ai)
#pragma unroll
                for (int m = 0; m < 4; ++m) {
                    float ss = 0.f;
#pragma unroll
                    for (int bj = 0; bj < 2; ++bj)
#pragma unroll
                        for (int n = 0; n < 2; ++n) { const f32x4 v = acc[ai][bj][m][n]; ss += (v.x * v.x + v.y * v.y) + (v.z * v.z + v.w * v.w); }
                    ss += __shfl_xor(ss, 16); ss += __shfl_xor(ss, 32);
                    const float r = 1.f / sqrtf(ss * (1.f / 64.f) + EPS);
                    bf16* rowp = base + (size_t)(row0 + ai * HALF + m * 16) * ld;
#pragma unroll
                    for (int bj = 0; bj < 2; ++bj) { const f32x4 v0 = acc[ai][bj][m][0] * g[bj][0] * r, v1 = acc[ai][bj][m][1] * g[bj][1] * r;
                        u32x4 w; w.x = cvt_pk_bf16(v0.x, v0.y); w.y = cvt_pk_bf16(v0.z, v0.w); w.z = cvt_pk_bf16(v1.x, v1.y); w.w = cvt_pk_bf16(v1.z, v1.w);
                        *(u32x4*)(rowp + 32 * bj) = w; }
                }
        } else if (mode == 1) {
            const float lg1 = log2f(1.f - exp2f(-5.f - (float)wc)); const float lgam = pn == 6 ? lg1 : -lg1;
            float inv[2][4];
#pragma unroll
            for (int n = 0; n < 2; ++n)
#pragma unroll
                for (int i = 0; i < 4; ++i) inv[n][i] = exp2f(-(float)(8 * fq + 4 * n + i) * (13.287712379549449f / 32.f)) * 0.15915494309189535f;
#pragma unroll
            for (int ai = 0; ai < 2; ++ai)
#pragma unroll
                for (int m = 0; m < 4; ++m) {
                    const int row = row0 + ai * HALF + m * 16; const float pos = (float)positions[row];
                    const float rsc = exp2f((float)(row & 63) * lgam) * scale;
                    f32x4 o0[2], o1[2];
#pragma unroll
                    for (int n = 0; n < 2; ++n)
#pragma unroll
                        for (int i = 0; i < 4; ++i) { float rev = pos * inv[n][i]; rev -= floorf(rev);
                            const float sn = __builtin_amdgcn_sinf(rev), cs = __builtin_amdgcn_cosf(rev);
                            const float t1 = acc[ai][0][m][n][i], t2 = acc[ai][1][m][n][i];
                            o0[n][i] = (t1 * cs - t2 * sn) * rsc; o1[n][i] = (t1 * sn + t2 * cs) * rsc; }
                    bf16* rowp = base + (size_t)row * ld;
                    u32x4 w; w.x = cvt_pk_bf16(o0[0].x, o0[0].y); w.y = cvt_pk_bf16(o0[0].z, o0[0].w); w.z = cvt_pk_bf16(o0[1].x, o0[1].y); w.w = cvt_pk_bf16(o0[1].z, o0[1].w);
                    *(u32x4*)(rowp) = w;
                    w.x = cvt_pk_bf16(o1[0].x, o1[0].y); w.y = cvt_pk_bf16(o1[0].z, o1[0].w); w.z = cvt_pk_bf16(o1[1].x, o1[1].y); w.w = cvt_pk_bf16(o1[1].z, o1[1].w);
                    *(u32x4*)(rowp + 32) = w;
                }
        } else {
#pragma unroll
            for (int ai = 0; ai < 2; ++ai)
#pragma unroll
                for (int m = 0; m < 4; ++m) {
                    bf16* rowp = base + (size_t)(row0 + ai * HALF + m * 16) * ld;
#pragma unroll
                    for (int bj = 0; bj < 2; ++bj) { f32x4 v0 = acc[ai][bj][m][0], v1 = acc[ai][bj][m][1];
                        if (mode == 2) {
#pragma unroll
                            for (int i = 0; i < 4; ++i) { v0[i] = v0[i] / (1.f + __expf(-v0[i])); v1[i] = v1[i] / (1.f + __expf(-v1[i])); } }
                        u32x4 w; w.x = cvt_pk_bf16(v0.x, v0.y); w.y = cvt_pk_bf16(v0.z, v0.w); w.z = cvt_pk_bf16(v1.x, v1.y); w.w = cvt_pk_bf16(v1.z, v1.w);
                        *(u32x4*)(rowp + 32 * bj) = w; }
                }
        }
    }
};
struct EpiOutProj {
    static constexpr int BMAP = 0;
    const float* X; float* OUT;
    __device__ __forceinline__ void operator()(const f32x4 (&acc)[2][2][4][2], const Unit& u, int wr, int wc, int fr, int fq) const {
        const int row0 = u.pm * BM + wr * 64 + fr, col0 = u.pn * BM + wc * 32 + 4 * fq;
#pragma unroll
        for (int ai = 0; ai < 2; ++ai)
#pragma unroll
            for (int m = 0; m < 4; ++m) { const size_t off = (size_t)(row0 + ai * HALF + m * 16) * D + col0;
#pragma unroll
                for (int bj = 0; bj < 2; ++bj)
#pragma unroll
                    for (int n = 0; n < 2; ++n) *(f32x4*)(OUT + off + bj * HALF + n * 16) = *(const f32x4*)(X + off + bj * HALF + n * 16) + acc[ai][bj][m][n]; }
    }
};
struct EpiG1 {
    static constexpr int BMAP = 1;
    bf16* ACT;
    __device__ __forceinline__ void operator()(const f32x4 (&acc)[2][2][4][2], const Unit& u, int wr, int wc, int fr, int fq) const {
        const int row0 = u.pm * BM + wr * 64 + fr; bf16* base = ACT + u.pn * 128 + wc * 32 + 8 * fq;
#pragma unroll
        for (int ai = 0; ai < 2; ++ai)
#pragma unroll
            for (int m = 0; m < 4; ++m) {
                f32x4 o[2];
#pragma unroll
                for (int n = 0; n < 2; ++n)
#pragma unroll
                    for (int i = 0; i < 4; ++i) { const float g = acc[ai][0][m][n][i]; o[n][i] = g / (1.f + __expf(-g)) * acc[ai][1][m][n][i]; }
                u32x4 w; w.x = cvt_pk_bf16(o[0].x, o[0].y); w.y = cvt_pk_bf16(o[0].z, o[0].w); w.z = cvt_pk_bf16(o[1].x, o[1].y); w.w = cvt_pk_bf16(o[1].z, o[1].w);
                *(u32x4*)(base + (size_t)(row0 + ai * HALF + m * 16) * DE) = w;
            }
    }
};
struct EpiG2 {
    static constexpr int BMAP = 1;
    bf16* YB; const float* row_w; const unsigned* cnt;
    __device__ __forceinline__ void operator()(const f32x4 (&acc)[2][2][4][2], const Unit& u, int wr, int wc, int fr, int fq) const {
        const int r0 = wr * 64 + fr; const unsigned n = cnt[u.e]; const float* wl = row_w + (size_t)u.e * T + u.rb * 256;
        bf16* base = YB + (size_t)u.pm * BM * D + u.pn * BM + wc * 32 + 8 * fq;
#pragma unroll
        for (int ai = 0; ai < 2; ++ai)
#pragma unroll
            for (int m = 0; m < 4; ++m) {
                const int r = r0 + ai * HALF + m * 16; const float w = (unsigned)(u.rb * 256 + r) < n ? wl[r] : 0.f;
                bf16* rowp = base + (size_t)r * D;
#pragma unroll
                for (int bj = 0; bj < 2; ++bj) { const f32x4 v0 = acc[ai][bj][m][0] * w, v1 = acc[ai][bj][m][1] * w;
                    u32x4 q; q.x = cvt_pk_bf16(v0.x, v0.y); q.y = cvt_pk_bf16(v0.z, v0.w); q.z = cvt_pk_bf16(v1.x, v1.y); q.w = cvt_pk_bf16(v1.z, v1.w);
                    *(u32x4*)(rowp + bj * HALF) = q; }
            }
    }
};
}
namespace att {
typedef float f32x16 __attribute__((ext_vector_type(16)));
typedef float f32x2v __attribute__((ext_vector_type(2)));
typedef __bf16 bf16x2v __attribute__((ext_vector_type(2)));
typedef short s16x4 __attribute__((ext_vector_type(4)));
typedef short v4i16_t __attribute__((ext_vector_type(4)));
using pg8::bf16x8;
#define ATT_LAS __attribute__((address_space(3)))
__device__ __forceinline__ int crow(int r, int hi) { return (r & 3) + 8 * (r >> 2) + 4 * hi; }
__device__ __forceinline__ unsigned cvtpk(float lo, float hi) { f32x2v v = {lo, hi}; bf16x2v b = __builtin_convertvector(v, bf16x2v); return __builtin_bit_cast(unsigned, b); }
__device__ __forceinline__ int koff(int key, int ch) { return key * 128 + 16 * (ch ^ ((key >> 1) & 7)); }
__device__ __forceinline__ int voff(int row, int ch) { return 1024 * (row >> 3) + 512 * (ch >> 2) + 64 * (row & 7) + 16 * ((ch & 3) ^ ((row >> 2) & 3)); }
__device__ __forceinline__ s16x4 vtr(const ATT_LAS unsigned char* p) { return __builtin_bit_cast(s16x4, __builtin_amdgcn_ds_read_tr16_b64_v4i16((ATT_LAS v4i16_t*)p)); }
__device__ __forceinline__ bf16x8 pack8(const f32x16& x, int s) {
    u32x4 p; p.x = cvtpk(x[8 * s], x[8 * s + 1]); p.y = cvtpk(x[8 * s + 2], x[8 * s + 3]); p.z = cvtpk(x[8 * s + 4], x[8 * s + 5]); p.w = cvtpk(x[8 * s + 6], x[8 * s + 7]);
    return __builtin_bit_cast(bf16x8, p);
}
__device__ __forceinline__ void dma_src(int tid, int ld, int& ksrc, int& vsrc) {
    const int sl = tid; const int key = sl >> 3, kch = (sl & 7) ^ ((key >> 1) & 7);
    ksrc = key * ld + kch * 8;
    const int row = 8 * (sl >> 6) + ((sl >> 2) & 7), vch = 4 * ((sl >> 5) & 1) + ((sl & 3) ^ ((row >> 2) & 3));
    vsrc = row * ld + vch * 8;
}

template <int MODE>
__device__ __forceinline__ void attn_unit(ATT_LAS unsigned char* lds, const bf16* Qg, int ldq, const bf16* Kg, const bf16* Vg, int ldkv, bf16* Og, int ldo,
                                          int tile0, int t_first, int t_count, const ATT_LAS float* tbl, float negM0) {
    int tid_ = threadIdx.x; asm volatile("" : "+v"(tid_));
    const int tid = tid_, lane = tid & 63, r32 = lane & 31, hi = lane >> 5; const int wid = __builtin_amdgcn_readfirstlane(tid >> 6);
    int ksrc, vsrc; dma_src(tid, ldkv, ksrc, vsrc);
    const unsigned ldsw = (unsigned)wid * 1024u;
#define ATT_DMA(tt, b) do { __builtin_amdgcn_global_load_lds((const unsigned*)(Kg + (size_t)(tile0 + (tt)) * 64 * ldkv + ksrc), (ATT_LAS unsigned*)(lds + (b) * 16384 + ldsw), 16, 0, 0); \
                            __builtin_amdgcn_global_load_lds((const unsigned*)(Vg + (size_t)(tile0 + (tt)) * 64 * ldkv + vsrc), (ATT_LAS unsigned*)(lds + (b) * 16384 + 8192 + ldsw), 16, 0, 0); } while (0)
    __builtin_amdgcn_s_barrier();
    ATT_DMA(t_first, 0);
    bf16x8 qf[4];
    { const bf16* qp = Qg + (size_t)(wid * 32 + r32) * ldq + hi * 8;
#pragma unroll
      for (int s = 0; s < 4; ++s) qf[s] = *(const bf16x8*)(qp + 16 * s); }
    f32x16 o[2];
#pragma unroll
    for (int r = 0; r < 16; ++r) { o[0][r] = 0.f; o[1][r] = 0.f; }
    float lsum = 0.f;
    const int cql = wid >> 1, iq = 32 * (wid & 1) + r32;
    const int q4 = (lane & 15) >> 2, p4 = lane & 3, blk = (lane >> 4) & 1;
    int kofs[4], vofs[2];
#pragma unroll
    for (int s = 0; s < 4; ++s) kofs[s] = koff(r32, 2 * s + hi);
    vofs[0] = voff(4 * hi + q4, 2 * blk + (p4 >> 1)) + 8 * (p4 & 1); vofs[1] = voff(8 + 4 * hi + q4, 2 * blk + (p4 >> 1)) + 8 * (p4 & 1);
#define ATT_STEP(B, it_) do { const int it = (it_); const int tt = t_first + it; \
        asm volatile("s_waitcnt vmcnt(0)" ::: "memory"); __builtin_amdgcn_s_barrier(); asm volatile("" ::: "memory"); \
        if (it + 1 < t_count) ATT_DMA(tt + 1, 1 - (B)); \
        const int jb = MODE == 0 ? tt - cql : 0; \
        if (MODE == 1 || (jb >= 0 && jb <= 8)) { \
            const ATT_LAS unsigned char* Kt = lds + (B) * 16384; const ATT_LAS unsigned char* Vt = Kt + 8192; \
            f32x16 p0, p1; \
            if (MODE == 0 && jb >= 6) { \
                const int base = (8 - jb) * 64 + iq + 63; \
                _Pragma("unroll") for (int r = 0; r < 16; ++r) { const int kk = crow(r, hi); int i0 = base - kk, i1 = base - kk - 32; i0 = i0 > 191 ? 191 : i0; i1 = i1 > 191 ? 191 : i1; p0[r] = tbl[i0]; p1[r] = tbl[i1]; } \
            } else { \
                _Pragma("unroll") for (int r = 0; r < 16; ++r) { p0[r] = negM0; p1[r] = negM0; } \
            } \
            _Pragma("unroll") for (int s = 0; s < 4; ++s) { \
                const bf16x8 k0 = *(const ATT_LAS bf16x8*)(Kt + kofs[s]), k1 = *(const ATT_LAS bf16x8*)(Kt + 4096 + kofs[s]); \
                p0 = __builtin_amdgcn_mfma_f32_32x32x16_bf16(k0, qf[s], p0, 0, 0, 0); \
                p1 = __builtin_amdgcn_mfma_f32_32x32x16_bf16(k1, qf[s], p1, 0, 0, 0); \
            } \
            float sa = 0.f, sb = 0.f; \
            _Pragma("unroll") for (int r = 0; r < 16; ++r) { p0[r] = __builtin_amdgcn_exp2f(p0[r]); p1[r] = __builtin_amdgcn_exp2f(p1[r]); sa += p0[r]; sb += p1[r]; } \
            lsum += sa + sb; \
            bf16x8 pa[4]; pa[0] = pack8(p0, 0); pa[1] = pack8(p0, 1); pa[2] = pack8(p1, 0); pa[3] = pack8(p1, 1); \
            _Pragma("unroll") for (int c = 0; c < 2; ++c) \
                _Pragma("unroll") for (int s = 0; s < 4; ++s) { \
                    const s16x4 lo = vtr(Vt + vofs[0] + 2048 * s + 512 * c); \
                    const s16x4 hh = vtr(Vt + vofs[1] + 2048 * s + 512 * c); \
                    const bf16x8 vf = {lo[0], lo[1], lo[2], lo[3], hh[0], hh[1], hh[2], hh[3]}; \
                    o[c] = __builtin_amdgcn_mfma_f32_32x32x16_bf16(vf, pa[s], o[c], 0, 0, 0); \
                } \
        } } while (0)
#pragma unroll 1
    for (int it2 = 0; it2 < t_count; it2 += 2) {
        ATT_STEP(0, it2);
        if (it2 + 1 < t_count) ATT_STEP(1, it2 + 1);
    }
#undef ATT_STEP
    lsum += __shfl_xor(lsum, 32);
    const float il = 1.f / lsum;
    bf16* op = Og + (size_t)(wid * 32 + r32) * ldo + 4 * hi;
#pragma unroll
    for (int c = 0; c < 2; ++c)
#pragma unroll
        for (int g = 0; g < 4; ++g) { u32x2 w; w.x = cvtpk(o[c][4 * g] * il, o[c][4 * g + 1] * il); w.y = cvtpk(o[c][4 * g + 2] * il, o[c][4 * g + 3] * il);
            *(u32x2*)(op + 32 * c + 8 * g) = w; }
#undef ATT_DMA
}
}
namespace ret {
using namespace att;
__device__ __forceinline__ void kv_unit(ATT_LAS unsigned char* wl, const bf16* Kc, const bf16* Vc, float* KVo, float g63, int lane) {
    const int r32 = lane & 31, hi = lane >> 5, q4 = (lane & 15) >> 2, p4 = lane & 3, blk = (lane >> 4) & 1;
#pragma unroll
    for (int j = 0; j < 8; ++j) { const int sl = 64 * j + lane; const int row = 8 * (sl >> 6) + ((sl >> 2) & 7), ch = 4 * ((sl >> 5) & 1) + ((sl & 3) ^ ((row >> 2) & 3));
        __builtin_amdgcn_global_load_lds((const unsigned*)(Kc + row * 256 + ch * 8), (ATT_LAS unsigned*)(wl + j * 1024), 16, 0, 0);
        __builtin_amdgcn_global_load_lds((const unsigned*)(Vc + row * 256 + ch * 8), (ATT_LAS unsigned*)(wl + 8192 + j * 1024), 16, 0, 0); }
    asm volatile("s_waitcnt vmcnt(0)" ::: "memory");
    int vofs[2];
    vofs[0] = voff(8 * hi + q4, 2 * blk + (p4 >> 1)) + 8 * (p4 & 1); vofs[1] = voff(8 * hi + 4 + q4, 2 * blk + (p4 >> 1)) + 8 * (p4 & 1);
    f32x16 acc[2][2];
#pragma unroll
    for (int a = 0; a < 2; ++a)
#pragma unroll
        for (int b = 0; b < 2; ++b)
#pragma unroll
            for (int r = 0; r < 16; ++r) acc[a][b][r] = 0.f;
#pragma unroll
    for (int s = 0; s < 4; ++s) {
        bf16x8 vf[2], kf[2];
#pragma unroll
        for (int c = 0; c < 2; ++c) {
            const s16x4 vl = vtr(wl + 8192 + vofs[0] + 2048 * s + 512 * c), vh = vtr(wl + 8192 + vofs[1] + 2048 * s + 512 * c);
            const s16x4 kl = vtr(wl + vofs[0] + 2048 * s + 512 * c), kh = vtr(wl + vofs[1] + 2048 * s + 512 * c);
            vf[c] = (bf16x8){vl[0], vl[1], vl[2], vl[3], vh[0], vh[1], vh[2], vh[3]}; kf[c] = (bf16x8){kl[0], kl[1], kl[2], kl[3], kh[0], kh[1], kh[2], kh[3]};
        }
#pragma unroll
        for (int eb = 0; eb < 2; ++eb)
#pragma unroll
            for (int db = 0; db < 2; ++db) acc[eb][db] = __builtin_amdgcn_mfma_f32_32x32x16_bf16(vf[eb], kf[db], acc[eb][db], 0, 0, 0);
    }
#pragma unroll
    for (int eb = 0; eb < 2; ++eb)
#pragma unroll
        for (int db = 0; db < 2; ++db)
#pragma unroll
            for (int r = 0; r < 16; ++r) KVo[(32 * eb + crow(r, hi)) * 64 + 32 * db + r32] = acc[eb][db][r] * g63;
    asm volatile("s_waitcnt lgkmcnt(0)" ::: "memory");
}

__device__ __forceinline__ void ret_unit(ATT_LAS unsigned char* lds, const bf16* Qg, const bf16* Kg, const bf16* Vg, const bf16* Gg, const bf16* STg, const float* gn, bf16* Og) {
    int tid_ = threadIdx.x; asm volatile("" : "+v"(tid_));
    const int tid = tid_, lane = tid & 63, r32 = lane & 31, hi = lane >> 5; const int wid = __builtin_amdgcn_readfirstlane(tid >> 6);
    const int cl = wid >> 1, qh = wid & 1;
    int ksrc, vsrc; dma_src(tid, 256, ksrc, vsrc);
    const unsigned ldsw = (unsigned)wid * 1024u;
    __builtin_amdgcn_s_barrier();
#pragma unroll
    for (int c4 = 0; c4 < 4; ++c4) {
        __builtin_amdgcn_global_load_lds((const unsigned*)(Kg + (size_t)c4 * 64 * 256 + ksrc), (ATT_LAS unsigned*)(lds + c4 * 8192 + ldsw), 16, 0, 0);
        __builtin_amdgcn_global_load_lds((const unsigned*)(Vg + (size_t)c4 * 64 * 256 + vsrc), (ATT_LAS unsigned*)(lds + 32768 + c4 * 8192 + ldsw), 16, 0, 0); }
    const int qrow = cl * 64 + qh * 32 + r32;
    bf16x8 qf[4];
    { const bf16* qp = Qg + (size_t)qrow * 256 + hi * 8;
#pragma unroll
      for (int s = 0; s < 4; ++s) qf[s] = *(const bf16x8*)(qp + 16 * s); }
    bf16x8 sf[2][4];
    { const bf16* sp = STg + (size_t)cl * 4096 + r32 * 64 + hi * 8;
#pragma unroll
      for (int c = 0; c < 2; ++c)
#pragma unroll
          for (int s = 0; s < 4; ++s) sf[c][s] = *(const bf16x8*)(sp + c * 2048 + 16 * s); }
    const int q4 = (lane & 15) >> 2, p4 = lane & 3, blk = (lane >> 4) & 1;
    int kofs[4], vofs[2];
#pragma unroll
    for (int s = 0; s < 4; ++s) kofs[s] = koff(r32, 2 * s + hi);
    vofs[0] = voff(4 * hi + q4, 2 * blk + (p4 >> 1)) + 8 * (p4 & 1); vofs[1] = voff(8 + 4 * hi + q4, 2 * blk + (p4 >> 1)) + 8 * (p4 & 1);
    asm volatile("s_waitcnt vmcnt(0)" ::: "memory"); __builtin_amdgcn_s_barrier(); asm volatile("" ::: "memory");
    const ATT_LAS unsigned char* Kt = lds + cl * 8192; const ATT_LAS unsigned char* Vt = lds + 32768 + cl * 8192;
    f32x16 p0, p1, o[2];
#pragma unroll
    for (int r = 0; r < 16; ++r) { p0[r] = 0.f; p1[r] = 0.f; o[0][r] = 0.f; o[1][r] = 0.f; }
#pragma unroll
    for (int c = 0; c < 2; ++c)
#pragma unroll
        for (int s = 0; s < 4; ++s) o[c] = __builtin_amdgcn_mfma_f32_32x32x16_bf16(sf[c][s], qf[s], o[c], 0, 0, 0);
#pragma unroll
    for (int s = 0; s < 4; ++s) p0 = __builtin_amdgcn_mfma_f32_32x32x16_bf16(*(const ATT_LAS bf16x8*)(Kt + kofs[s]), qf[s], p0, 0, 0, 0);
    if (qh) {
#pragma unroll
        for (int s = 0; s < 4; ++s) p1 = __builtin_amdgcn_mfma_f32_32x32x16_bf16(*(const ATT_LAS bf16x8*)(Kt + 4096 + kofs[s]), qf[s], p1, 0, 0, 0);
#pragma unroll
        for (int r = 0; r < 16; ++r) p1[r] = crow(r, hi) <= r32 ? p1[r] : 0.f;
    } else {
#pragma unroll
        for (int r = 0; r < 16; ++r) p0[r] = crow(r, hi) <= r32 ? p0[r] : 0.f;
    }
    {
        bf16x8 pa[4]; pa[0] = pack8(p0, 0); pa[1] = pack8(p0, 1); pa[2] = pack8(p1, 0); pa[3] = pack8(p1, 1);
#pragma unroll
        for (int c = 0; c < 2; ++c)
#pragma unroll
            for (int s = 0; s < 4; ++s) {
                if (s < 2 || qh) {
                    const s16x4 lo = vtr(Vt + vofs[0] + 2048 * s + 512 * c), hh = vtr(Vt + vofs[1] + 2048 * s + 512 * c);
                    const bf16x8 vf = {lo[0], lo[1], lo[2], lo[3], hh[0], hh[1], hh[2], hh[3]};
                    o[c] = __builtin_amdgcn_mfma_f32_32x32x16_bf16(vf, pa[s], o[c], 0, 0, 0);
                }
            }
    }
    float sm = 0.f;
#pragma unroll
    for (int r = 0; r < 16; ++r) sm += o[0][r] + o[1][r];
    sm += __shfl_xor(sm, 32);
    const float mu = sm * (1.f / 64.f);
    float sv = 0.f;
#pragma unroll
    for (int r = 0; r < 16; ++r) { const float a = o[0][r] - mu, b = o[1][r] - mu; sv += a * a + b * b; }
    sv += __shfl_xor(sv, 32);
    const float rs = 1.f / sqrtf(sv * (1.f / 64.f) + EPS);
    const bf16* gp = Gg + (size_t)qrow * 256 + 4 * hi; bf16* op = Og + (size_t)qrow * D + 4 * hi;
#pragma unroll
    for (int c = 0; c < 2; ++c)
#pragma unroll
        for (int g = 0; g < 4; ++g) {
            const f32x4 gv = *(const f32x4*)(gn + 32 * c + 8 * g + 4 * hi); const u32x2 gb = *(const u32x2*)(gp + 32 * c + 8 * g);
            const float y0 = (o[c][4 * g] - mu) * rs * gv.x * __uint_as_float(gb.x << 16), y1 = (o[c][4 * g + 1] - mu) * rs * gv.y * __uint_as_float(gb.x & 0xffff0000u);
            const float y2 = (o[c][4 * g + 2] - mu) * rs * gv.z * __uint_as_float(gb.y << 16), y3 = (o[c][4 * g + 3] - mu) * rs * gv.w * __uint_as_float(gb.y & 0xffff0000u);
            u32x2 w; w.x = cvtpk(y0, y1); w.y = cvtpk(y2, y3);
            *(u32x2*)(op + 32 * c + 8 * g) = w;
        }
}
}
constexpr int NWAVES = 8;
constexpr int RING_OFF = 0, RING_BYTES = 131072, SCRATCH_BYTES = 147456;
constexpr int GSPILL_OFF = SCRATCH_BYTES;
constexpr int MOE_OFF = GSPILL_OFF + 8192;
constexpr int MISC_OFF = MOE_OFF + 2048;
constexpr int LDS_BYTES = 163840;
static_assert(MISC_OFF + 512 <= LDS_BYTES, "LDS map");
constexpr int CW_BAR = 4096;

#define GAS __attribute__((address_space(1)))
#define LAS __attribute__((address_space(3)))
#define XB_TMO      128
#define XB_XCNT(j)  (256  + 64 * (j))
#define XB_XSUB(j)  (1280 + 64 * (j))
#define XB_XGEN(j)  (2304 + 64 * (j))
#define XB_TOP      3328
#define XB_TOPGEN   3392
#define XCD_BAR_WORDS 3456
#define XB_SPIN_CAP (1u << 18)
__device__ __forceinline__ unsigned xb_ld(unsigned* p)              { return __hip_atomic_load(p, __ATOMIC_RELAXED, __HIP_MEMORY_SCOPE_AGENT); }
__device__ __forceinline__ unsigned xb_add(unsigned* p, unsigned v) { return __hip_atomic_fetch_add(p, v, __ATOMIC_RELAXED, __HIP_MEMORY_SCOPE_AGENT); }
__device__ __forceinline__ unsigned xb_xcc_id() { return (unsigned)__builtin_amdgcn_s_getreg((3 << 11) | 20) & 0xFu; }
#define XB_SPIN(cond, bar) do { unsigned _sp = 0; while (cond) { __builtin_amdgcn_s_sleep(1); \
    if ((++_sp & 255u) == 0u) { if (xb_ld(&(bar)[XB_TMO])) break; if (_sp > XB_SPIN_CAP) { atomicAdd(&(bar)[XB_TMO], 1u); break; } } } } while (0)
struct XcdBarrier { unsigned* bar; unsigned x; volatile LAS unsigned* st; };
__device__ __forceinline__ XcdBarrier xcd_barrier_post(unsigned* bar, volatile LAS unsigned* st) {
    XcdBarrier b; b.bar = bar; b.x = xb_xcc_id(); b.st = st;
    if (threadIdx.x == 0) (void)xb_add(&bar[XB_XCNT(b.x)], 1u);
    return b;
}
__device__ __forceinline__ void xcd_barrier_complete(unsigned* bar, unsigned x, unsigned& nloc, unsigned& nx) {
    const unsigned G = gridDim.x * gridDim.y * gridDim.z;
    unsigned sum, cnt, mine, sp = 0u;
    for (;;) {
        sum = 0u; cnt = 0u; mine = 0u;
#pragma unroll
        for (unsigned j = 0; j < 16; ++j) { const unsigned c = xb_ld(&bar[XB_XCNT(j)]); sum += c; cnt += (c > 0u) ? 1u : 0u; mine = (j == x) ? c : mine; }
        if (sum == G) break;
        __builtin_amdgcn_s_sleep(1);
        if ((++sp & 255u) == 0u) { if (xb_ld(&bar[XB_TMO])) break; if (sp > XB_SPIN_CAP) { atomicAdd(&bar[XB_TMO], 1u); break; } }
    }
    nloc = mine > 0u ? mine : 1u; nx = cnt > 0u ? cnt : 1u;
}
__device__ __forceinline__ void xcd_barrier(const XcdBarrier& b) {
    asm volatile("s_waitcnt vmcnt(0)" ::: "memory");
    __syncthreads();
    if (threadIdx.x == 0) {
        unsigned* bar = b.bar;
        __builtin_amdgcn_s_waitcnt(0);
        unsigned nloc = b.st[0], nx = b.st[1];
        if (nloc == 0u) { xcd_barrier_complete(bar, b.x, nloc, nx); b.st[0] = nloc; b.st[1] = nx; }
        const unsigned old = xb_add(&bar[XB_XSUB(b.x)], 1u);
        const unsigned gen = old / nloc;
        if (old + 1u == (gen + 1u) * nloc) {
            __builtin_amdgcn_fence(__ATOMIC_RELEASE, "agent");
            asm volatile("s_waitcnt vmcnt(0)" ::: "memory");
            const unsigned og = xb_add(&bar[XB_TOP], 1u);
            const unsigned tg = og / nx;
            if (og + 1u == (tg + 1u) * nx) xb_add(&bar[XB_TOPGEN], 1u);
            else XB_SPIN(xb_ld(&bar[XB_TOPGEN]) == tg, bar);
            __builtin_amdgcn_fence(__ATOMIC_ACQUIRE, "agent");
            xb_add(&bar[XB_XGEN(b.x)], 1u);
            asm volatile("s_waitcnt vmcnt(0)" ::: "memory");
        } else {
            XB_SPIN(xb_ld(&bar[XB_XGEN(b.x)]) == gen, bar);
            __builtin_amdgcn_fence(__ATOMIC_ACQUIRE, "agent");
            asm volatile("s_waitcnt vmcnt(0)" ::: "memory");
        }
    }
    __syncthreads();
}

__device__ __forceinline__ void transpose_item_l(const float* W, int K, int N, bf16* WT, int row_off, LAS float* scr, int item, int lane) {
    const int nblk = N / 32, kb = item / nblk, nb = item % nblk, k0 = 64 * kb, n0 = 32 * nb;
#pragma unroll 8
    for (int i = 0; i < 32; ++i) { const int kk = 2 * i + (lane >> 5); scr[kk * 33 + (lane & 31)] = W[(size_t)(k0 + kk) * N + n0 + (lane & 31)]; }
    asm volatile("s_waitcnt lgkmcnt(0)" ::: "memory");
    const int c = lane & 7;
#pragma unroll
    for (int j = 0; j < 4; ++j) { const int n = (lane >> 3) + 8 * j; const LAS float* s = scr + (8 * c) * 33 + n;
        u32x4 o; o.x = pk2(s[0 * 33], s[1 * 33]); o.y = pk2(s[2 * 33], s[3 * 33]); o.z = pk2(s[4 * 33], s[5 * 33]); o.w = pk2(s[6 * 33], s[7 * 33]);
        *(u32x4*)(WT + (size_t)(row_off + n0 + n) * K + k0 + 8 * c) = o; }
    asm volatile("s_waitcnt lgkmcnt(0)" ::: "memory");
}

struct Args { const void* in[22]; float* out; unsigned char* ws; int ph_lo, ph_hi, li, pad; };

__global__ void __launch_bounds__(NWAVES * 64, 2) mk_fwd(Args args) {
    extern __shared__ __attribute__((aligned(16))) unsigned char lds_raw[];
    LAS unsigned char* lds = (LAS unsigned char*)lds_raw;
    volatile LAS unsigned* MISC = (volatile LAS unsigned*)(lds + MISC_OFF);
    LAS unsigned* gspill = (LAS unsigned*)(lds + GSPILL_OFF);
#define PHASE_IDS() int tid_ = threadIdx.x; asm volatile("" : "+v"(tid_)); const int tid = tid_, lane = tid & 63, wave = __builtin_amdgcn_readfirstlane(tid >> 6); (void)lane; (void)wave
    const int G = gridDim.x, bx = blockIdx.x;
    unsigned char* ws = args.ws;
    unsigned* ctl = (unsigned*)(ws + WS_CTL);
    const float* x = (const float*)args.in[0]; const float* mem = (const float*)args.in[1]; const int* positions = (const int*)args.in[2];
    const float* g_mix = (const float*)args.in[3]; const float* w_in = (const float*)args.in[4]; const float* qn_a = (const float*)args.in[5]; const float* kn_a = (const float*)args.in[6];
    const float* g_mem = (const float*)args.in[9]; const float* w_mem_kv = (const float*)args.in[10];
    const float* qn_c = (const float*)args.in[11]; const float* kn_c = (const float*)args.in[12]; const float* w_out = (const float*)args.in[13];
    const float* w_gate = (const float*)args.in[19]; const float* w_up = (const float*)args.in[20]; const float* w_down = (const float*)args.in[21];
    float* out = args.out;
    PB pb; pb.QA = (bf16*)(ws + WS_QA); pb.KA = (bf16*)(ws + WS_KA); pb.VA = (bf16*)(ws + WS_VA); pb.QB = (bf16*)(ws + WS_QB); pb.KB = (bf16*)(ws + WS_KB);
    pb.VB = (bf16*)(ws + WS_VB); pb.GB = (bf16*)(ws + WS_GB); pb.QC = (bf16*)(ws + WS_QC); pb.KM = (bf16*)(ws + WS_KM); pb.VM = (bf16*)(ws + WS_VM);
    bf16* XN = (bf16*)(ws + WS_XN); bf16* WinT = (bf16*)(ws + WS_WINT); bf16* WoutT = (bf16*)(ws + WS_WOUTT); bf16* WguT = (bf16*)(ws + WS_WGUT); bf16* WdT = (bf16*)(ws + WS_WDT);
    bf16* CAT = (bf16*)(ws + WS_CAT);

    { PHASE_IDS(); for (int u = tid; u < 128; u += NWAVES * 64) MISC[u] = 0u; }
    __syncthreads();
    XcdBarrier bar = xcd_barrier_post(ctl + CW_BAR + args.li * XCD_BAR_WORDS, MISC + 8);
    const int lo = args.ph_lo, hi = args.ph_hi;
#define IN(k) (lo <= (k) && (k) < hi)
#define BOTH(k) (IN(k) && IN((k) + 1))

    if (IN(0)) {
        PHASE_IDS();
        LAS float* scr = (LAS float*)(lds + RING_OFF + wave * 16384);
        const int gw = bx * NWAVES + wave, NGW = G * NWAVES;
        constexpr int I_IN = 16 * 88, I_KV = 16 * 16, I_O = 16 * 32, I_E = 256;
        constexpr int NITEMS = I_IN + I_KV + I_O + NE * 3 * I_E;
        for (int it = gw; it < NITEMS; it += NGW) {
            int r = it;
            if (r < I_IN) { transpose_item_l(w_in, D, INCOLS, WinT, 0, scr, r, lane); continue; } r -= I_IN;
            if (r < I_KV) { transpose_item_l(w_mem_kv, D, KVCOLS, WinT, INCOLS, scr, r, lane); continue; } r -= I_KV;
            if (r < I_O) { transpose_item_l(w_out, D, D, WoutT, 0, scr, r, lane); continue; } r -= I_O;
            const int e = r / (3 * I_E), q = r % (3 * I_E);
            if (q < I_E) transpose_item_l(w_gate + (size_t)e * D * DE, D, DE, WguT + (size_t)e * D * D, 0, scr, q, lane);
            else if (q < 2 * I_E) transpose_item_l(w_up + (size_t)e * D * DE, D, DE, WguT + (size_t)e * D * D, DE, scr, q - I_E, lane);
            else transpose_item_l(w_down + (size_t)e * DE * D, DE, D, WdT + (size_t)e * D * DE, 0, scr, q - 2 * I_E, lane);
        }
        for (int m = gw; m < T + MEMROWS; m += NGW) {
            if (m < T) rms_row_to_bf16(x + (size_t)m * D, g_mix, XN + (size_t)m * D, lane);
            else rms_row_to_bf16(mem + (size_t)(m - T) * D, g_mem, XN + (size_t)m * D, lane);
        }
        if (BOTH(0)) xcd_barrier(bar);
    }
    if (IN(1)) {
        pg8::ProjOrder S{G, bx, (const char*)XN, (const char*)WinT};
        pg8::EpiProj E{pb, positions, qn_a, kn_a, qn_c, kn_c};
        pg8::gemm_phase<pg8::EpiProj, pg8::ProjOrder, true, false>(lds + RING_OFF, D, 128u * 2048u, 32u * 2048u, gspill, S, E);
        if (BOTH(1)) xcd_barrier(bar);
    }
    if (IN(2)) {
        PHASE_IDS();
        float* KV = (float*)(ws + WS_RKV);
        for (int u = bx * NWAVES + wave; u < NBATCH * BH * NCHUNK; u += G * NWAVES) {
            const int bh = u >> 7, c = u & 127, b = bh >> 2, h = bh & 3; const size_t r0 = (size_t)b * SEQ + (size_t)c * 64;
            const float g63 = exp2f(63.f * log2f(1.f - exp2f(-5.f - (float)h)));
            ret::kv_unit(lds + wave * 16384, pb.KB + r0 * 256 + h * 64, pb.VB + r0 * 256 + h * 64, KV + (size_t)u * 4096, g63, lane);
        }
        if (BOTH(2)) xcd_barrier(bar);
    }
    if (IN(3)) {
        PHASE_IDS();
        const float* KV = (const float*)(ws + WS_RKV); bf16* ST = (bf16*)(ws + WS_ST);
        for (int p = bx * NWAVES + wave; p < 2048; p += G * NWAVES) {
            const int hf = lane >> 5, el = p * 32 + (lane & 31), bh = el >> 12, ed = el & 4095, h = bh & 3;
            const float gam = 1.f - exp2f(-5.f - (float)h), g64 = exp2f(64.f * log2f(gam));
            const float* src = KV + (size_t)(bh * 128 + hf * 64) * 4096 + ed;
            float kv[64];
#pragma unroll
            for (int j = 0; j < 64; ++j) kv[j] = src[(size_t)j * 4096];
            float L = 0.f;
#pragma unroll
            for (int j = 0; j < 64; ++j) L = g64 * L + kv[j];
            const float S64 = __shfl(L, lane & 31);
            float st = hf ? S64 : 0.f;
            bf16* dst = ST + (size_t)(bh * 128 + hf * 64) * 4096 + ed;
#pragma unroll
            for (int j = 0; j < 64; ++j) { dst[(size_t)j * 4096] = f2bf(gam * st); st = g64 * st + kv[j]; }
        }
        if (BOTH(3)) xcd_barrier(bar);
    }
    if (IN(4)) {
        PHASE_IDS();
        const float* rel_bias = (const float*)args.in[7]; const float* ret_gn_g = (const float*)args.in[8];
        LAS float* tbl = (LAS float*)(lds + 65536); LAS float* mvals = tbl + 8 * 192;
        {
            const int l4 = tid & 63;
            float gq = fabsf(qn_a[l4]), gk = fabsf(kn_a[l4]), cq = fabsf(qn_c[l4]), ck = fabsf(kn_c[l4]);
            float mb = -3.0e38f;
            for (int i = l4; i < 192; i += 64) mb = fmaxf(mb, rel_bias[wave * 192 + i]);
#pragma unroll
            for (int o = 1; o < 64; o <<= 1) { gq = fmaxf(gq, __shfl_xor(gq, o)); gk = fmaxf(gk, __shfl_xor(gk, o)); cq = fmaxf(cq, __shfl_xor(cq, o)); ck = fmaxf(ck, __shfl_xor(ck, o)); mb = fmaxf(mb, __shfl_xor(mb, o)); }
            const float M0 = 8.f * LOG2E * gq * gk + fmaxf(mb, 0.f) * LOG2E + 1.f;
            for (int i = l4; i < 192; i += 64) tbl[wave * 192 + i] = rel_bias[wave * 192 + i] * LOG2E - M0;
            if (tid == 0) mvals[0] = -(8.f * LOG2E * cq * ck + 1.f);
        }
        __syncthreads();
        const float negM0c = mvals[0];
        for (int u = bx; u < NBATCH * AH * 32; u += G) {
            const int b = u >> 8, h = (u >> 5) & 7, g = u & 31;
            const int t_first = 8 - 4 * g > 0 ? 8 - 4 * g : 0;
            const size_t q0 = (size_t)b * SEQ + (size_t)g * 256, s0 = (size_t)b * SEQ;
            att::attn_unit<0>(lds, pb.QA + q0 * 512 + h * 64, 512, pb.KA + s0 * 512 + h * 64, pb.VA + s0 * 512 + h * 64, 512, CAT + q0 * D + h * 64, D,
                              4 * g - 8, t_first, 12 - t_first, tbl + h * 192, tbl[h * 192 + 191]);
        }
        for (int u = bx; u < NBATCH * BH * 32; u += G) {
            const int b = u >> 7, h = (u >> 5) & 3, g = u & 31;
            const size_t r0 = (size_t)b * SEQ + (size_t)g * 256;
            ret::ret_unit(lds, pb.QB + r0 * 256 + h * 64, pb.KB + r0 * 256 + h * 64, pb.VB + r0 * 256 + h * 64, pb.GB + r0 * 256 + h * 64,
                          (const bf16*)(ws + WS_ST) + (size_t)((b * 4 + h) * 128 + 4 * g) * 4096, ret_gn_g + h * 64, CAT + r0 * D + 512 + h * 64);
        }
        for (int u = bx; u < NBATCH * CH * 32; u += G) {
            const int b = u >> 7, h = (u >> 5) & 3, g = u & 31;
            const size_t q0 = (size_t)b * SEQ + (size_t)g * 256, m0 = (size_t)b * NMEM;
            att::attn_unit<1>(lds, pb.QC + q0 * 256 + h * 64, 256, pb.KM + m0 * 256 + h * 64, pb.VM + m0 * 256 + h * 64, 256, CAT + q0 * D + 768 + h * 64, D,
                              0, 0, 4, tbl, negM0c);
        }
        if (BOTH(4)) xcd_barrier(bar);
    }
    if (IN(5)) {
        pg8::PlainOrder S{G, bx, T / 256, D / 256, (const char*)CAT, (const char*)WoutT, 2048};
        pg8::EpiOutProj E{x, out};
        pg8::gemm_phase<pg8::EpiOutProj, pg8::PlainOrder, true, false>(lds + RING_OFF, D, 128u * 2048u, 128u * 2048u, gspill, S, E);
        if (BOTH(5)) xcd_barrier(bar);
    }
    if (IN(6)) {
        PHASE_IDS();
        const float* g_ffn = (const float*)args.in[14]; const float* w_rg = (const float*)args.in[15]; const float* b_rg = (const float*)args.in[16];
        const float* w_re = (const float*)args.in[17]; const float* b_re = (const float*)args.in[18];
        bf16* HN = (bf16*)(ws + WS_HN); unsigned* cnt = ctl + CW_CNT;
        int* row_tok = (int*)(ws + WS_ROWTOK); float* row_w = (float*)(ws + WS_ROWW); int* toktab = (int*)(ws + WS_TOKTAB);
        constexpr int IMG_LO = 36864, LG_OFF = 73728, TAB_OFF = LG_OFF + 8 * 2304;
        LAS int* tokE = (LAS int*)(lds + TAB_OFF); LAS float* tokW = (LAS float*)(lds + TAB_OFF + 1024); LAS int* tokR = (LAS int*)(lds + TAB_OFF + 2048);
        LAS unsigned* hist = (LAS unsigned*)(lds + TAB_OFF + 3072); LAS unsigned* ebase = hist + 32;
        const int r16 = lane & 15, kq = lane >> 4;
        for (int unit = bx; unit < T / 128; unit += G) {
            const int tok0 = unit * 128 + wave * 16;
            const float* hrow = out + (size_t)(tok0 + r16) * D + 8 * kq;
            f32x4 acc[3]; acc[0] = (f32x4){0.f, 0.f, 0.f, 0.f}; acc[1] = acc[0]; acc[2] = acc[0];
            float ss = 0.f;
            if (tid < 64) hist[tid] = 0u;
            for (int kh = 0; kh < 2; ++kh) {
                __syncthreads();
                for (int idx = tid; idx < 36 * 512; idx += NWAVES * 64) {
                    const int n = idx >> 9, kk = idx & 511, k = kh * 512 + kk;
                    const float v = g_ffn[k] * (n < 4 ? w_rg[k * 4 + n] : w_re[k * 32 + (n - 4)]);
                    const bf16 vh = f2bf(v), vl = f2bf(v - bf2f(vh));
                    const int addr = n * 1024 + ((((kk >> 3) ^ (n & 15))) << 4) + (kk & 7) * 2;
                    *(LAS bf16*)(lds + addr) = vh; *(LAS bf16*)(lds + IMG_LO + addr) = vl;
                }
                __syncthreads();
#pragma unroll 2
                for (int s = 0; s < 16; ++s) {
                    const f32x4 v0 = *(const f32x4*)(hrow + kh * 512 + 32 * s), v1 = *(const f32x4*)(hrow + kh * 512 + 32 * s + 4);
                    ss += (v0.x * v0.x + v0.y * v0.y) + (v0.z * v0.z + v0.w * v0.w) + (v1.x * v1.x + v1.y * v1.y) + (v1.z * v1.z + v1.w * v1.w);
                    u32x4 ph, pl;
                    ph.x = pg8::cvt_pk_bf16(v0.x, v0.y); ph.y = pg8::cvt_pk_bf16(v0.z, v0.w); ph.z = pg8::cvt_pk_bf16(v1.x, v1.y); ph.w = pg8::cvt_pk_bf16(v1.z, v1.w);
                    pl.x = pg8::cvt_pk_bf16(v0.x - __uint_as_float(ph.x << 16), v0.y - __uint_as_float(ph.x & 0xffff0000u));
                    pl.y = pg8::cvt_pk_bf16(v0.z - __uint_as_float(ph.y << 16), v0.w - __uint_as_float(ph.y & 0xffff0000u));
                    pl.z = pg8::cvt_pk_bf16(v1.x - __uint_as_float(ph.z << 16), v1.y - __uint_as_float(ph.z & 0xffff0000u));
                    pl.w = pg8::cvt_pk_bf16(v1.z - __uint_as_float(ph.w << 16), v1.w - __uint_as_float(ph.w & 0xffff0000u));
                    const pg8::bf16x8 ah = __builtin_bit_cast(pg8::bf16x8, ph), al = __builtin_bit_cast(pg8::bf16x8, pl);
#pragma unroll
                    for (int nb = 0; nb < 3; ++nb) {
                        int n = 16 * nb + r16; n = n > 35 ? 35 : n;
                        const int addr = n * 1024 + (((4 * s + kq) ^ (n & 15)) << 4);
                        const pg8::bf16x8 bh = *(const LAS pg8::bf16x8*)(lds + addr), bl = *(const LAS pg8::bf16x8*)(lds + IMG_LO + addr);
                        acc[nb] = __builtin_amdgcn_mfma_f32_16x16x32_bf16(ah, bh, acc[nb], 0, 0, 0);
                        acc[nb] = __builtin_amdgcn_mfma_f32_16x16x32_bf16(al, bh, acc[nb], 0, 0, 0);
                        acc[nb] = __builtin_amdgcn_mfma_f32_16x16x32_bf16(ah, bl, acc[nb], 0, 0, 0);
                    }
                }
            }
            ss += __shfl_xor(ss, 16); ss += __shfl_xor(ss, 32);
            const float rr = 1.f / sqrtf(ss * (1.f / D) + EPS);
            LAS float* LG = (LAS float*)(lds + LG_OFF + wave * 2304);
#pragma unroll
            for (int i = 0; i < 4; ++i) { const float ri = __shfl(rr, 4 * kq + i);
#pragma unroll
                for (int nb = 0; nb < 3; ++nb) { const int n = 16 * nb + r16; if (n < 36) LG[(4 * kq + i) * 36 + n] = acc[nb][i] * ri; } }
            asm volatile("s_waitcnt lgkmcnt(0)" ::: "memory");
            if (lane < 16) {
                const LAS float* lg = LG + lane * 36;
                float gl[4];
#pragma unroll
                for (int g = 0; g < 4; ++g) gl[g] = lg[g] + b_rg[g];
                int gs = 0; float gm = gl[0];
#pragma unroll
                for (int g = 1; g < 4; ++g) if (gl[g] > gm) { gm = gl[g]; gs = g; }
                float gsum = 0.f;
#pragma unroll
                for (int g = 0; g < 4; ++g) gsum += __expf(gl[g] - gm);
                const float pg = 1.f / gsum;
                float el[8];
#pragma unroll
                for (int i = 0; i < 8; ++i) el[i] = lg[4 + gs * 8 + i] + b_re[gs * 8 + i];
                int i0 = 0; float m0 = el[0];
#pragma unroll
                for (int i = 1; i < 8; ++i) if (el[i] > m0) { m0 = el[i]; i0 = i; }
                int i1 = -1; float m1 = -3.0e38f;
#pragma unroll
                for (int i = 0; i < 8; ++i) if (i != i0 && el[i] > m1) { m1 = el[i]; i1 = i; }
                const float p1 = __expf(m1 - m0);
                const int tl = wave * 16 + lane;
                tokE[tl * 2] = gs * 8 + i0; tokE[tl * 2 + 1] = gs * 8 + i1; tokW[tl * 2] = pg / (1.f + p1); tokW[tl * 2 + 1] = pg * p1 / (1.f + p1);
            }
            for (int j = 0; j < 16; ++j) {
                const float rj = __shfl(rr, j);
                const f32x4* xr = (const f32x4*)(out + (size_t)(tok0 + j) * D) + lane; const f32x4* gr = (const f32x4*)g_ffn + lane;
                unsigned long long* o8 = (unsigned long long*)(HN + (size_t)(tok0 + j) * D) + lane;
#pragma unroll
                for (int q = 0; q < 4; ++q) { const f32x4 v = xr[64 * q] * rj, g = gr[64 * q];
                    o8[64 * q] = (unsigned long long)pg8::cvt_pk_bf16(v.x * g.x, v.y * g.y) | ((unsigned long long)pg8::cvt_pk_bf16(v.z * g.z, v.w * g.w) << 32); }
            }
            __syncthreads();
            if (tid < 128) { tokR[tid * 2] = (int)__hip_atomic_fetch_add(hist + tokE[tid * 2], 1u, __ATOMIC_RELAXED, __HIP_MEMORY_SCOPE_WORKGROUP);
                             tokR[tid * 2 + 1] = (int)__hip_atomic_fetch_add(hist + tokE[tid * 2 + 1], 1u, __ATOMIC_RELAXED, __HIP_MEMORY_SCOPE_WORKGROUP); }
            __syncthreads();
            if (tid < 32) { const unsigned hc = hist[tid]; ebase[tid] = hc ? atomicAdd(cnt + tid, hc) : 0u; }
            __syncthreads();
            if (tid < 128) {
                const int tok = unit * 128 + tid;
                const int e0 = tokE[tid * 2], e1 = tokE[tid * 2 + 1]; const int s0 = (int)ebase[e0] + tokR[tid * 2], s1 = (int)ebase[e1] + tokR[tid * 2 + 1];
                row_tok[(size_t)e0 * T + s0] = tok; row_w[(size_t)e0 * T + s0] = tokW[tid * 2];
                row_tok[(size_t)e1 * T + s1] = tok; row_w[(size_t)e1 * T + s1] = tokW[tid * 2 + 1];
                *(int4*)(toktab + tok * 4) = make_int4(e0, s0, e1, s1);
            }
        }
        if (BOTH(6)) xcd_barrier(bar);
    }
    LAS int* blkstart = (LAS int*)(lds + MOE_OFF); LAS int* blk2e = blkstart + 40;
    if (IN(7) || IN(8) || IN(9)) {
        PHASE_IDS();
        const unsigned* cnt = ctl + CW_CNT;
        if (tid == 0) { int s = 0; for (int e = 0; e < NE; ++e) { blkstart[e] = s; s += (int)((cnt[e] + 255u) >> 8); } blkstart[NE] = s; }
        __syncthreads();
        const int nb = blkstart[NE];
        for (int b = tid; b < nb; b += NWAVES * 64) { int e = 0; while (blkstart[e + 1] <= b) ++e; blk2e[b] = e; }
        __syncthreads();
    }
    if (IN(7)) {
        pg8::MoeOrder S{G, bx, blkstart[NE] * 4, blkstart, blk2e, (const char*)(ws + WS_HN), 0, (const char*)WguT, (size_t)D * D * 2, (size_t)128 * 2048, (const int*)(ws + WS_ROWTOK), ctl + CW_CNT};
        pg8::EpiG1 E{(bf16*)(ws + WS_ACT)};
        pg8::gemm_phase<pg8::EpiG1, pg8::MoeOrder, true, true>(lds + RING_OFF, D, 0u, 512u * 2048u, gspill, S, E);
        if (BOTH(7)) xcd_barrier(bar);
    }
    if (IN(8)) {
        pg8::MoeOrder S{G, bx, blkstart[NE] * 4, blkstart, blk2e, (const char*)(ws + WS_ACT), (size_t)256 * 1024, (const char*)WdT, (size_t)D * DE * 2, (size_t)256 * 1024, (const int*)(ws + WS_ROWTOK), ctl + CW_CNT};
        pg8::EpiG2 E{(bf16*)(ws + WS_YB), (const float*)(ws + WS_ROWW), ctl + CW_CNT};
        pg8::gemm_phase<pg8::EpiG2, pg8::MoeOrder, true, false>(lds + RING_OFF, DE, 128u * 1024u, 128u * 1024u, gspill, S, E);
        if (BOTH(8)) xcd_barrier(bar);
    }
    if (IN(9)) {
        const bf16* YB = (const bf16*)(ws + WS_YB); const int* toktab = (const int*)(ws + WS_TOKTAB);
        PHASE_IDS();
        for (int tok = bx * NWAVES + wave; tok < T; tok += G * NWAVES) {
            const int4 tt = *(const int4*)(toktab + tok * 4);
            const size_t p0 = (size_t)blkstart[tt.x] * 256 + tt.y, p1 = (size_t)blkstart[tt.z] * 256 + tt.w;
            f32x4* orow = (f32x4*)(out + (size_t)tok * D) + lane; const u32x2* y0 = (const u32x2*)(YB + p0 * D) + lane; const u32x2* y1 = (const u32x2*)(YB + p1 * D) + lane;
#pragma unroll
            for (int q = 0; q < 4; ++q) { f32x4 o = orow[64 * q]; const u32x2 a = y0[64 * q], b = y1[64 * q];
                o.x += __uint_as_float(a.x << 16) + __uint_as_float(b.x << 16); o.y += __uint_as_float(a.x & 0xffff0000u) + __uint_as_float(b.x & 0xffff0000u);
                o.z += __uint_as_float(a.y << 16) + __uint_as_float(b.y << 16); o.w += __uint_as_float(a.y & 0xffff0000u) + __uint_as_float(b.y & 0xffff0000u);
                orow[64 * q] = o; }
        }
    }
#undef IN
#undef BOTH
}

extern "C" void kernel_launch(void* const* d_in, const int* in_sizes, int n_in, void* d_out, int out_size, void* d_ws, size_t ws_size, hipStream_t stream) {
    if (n_in != 22 || out_size != T * D || ws_size < WS_END) { fprintf(stderr, "kernel_launch: unexpected sizes (n_in %d out %d ws %zu)\n", n_in, out_size, ws_size); return; }
    static int grid = 0;
    if (grid == 0) {
        int dev = 0, cus = 0;
        if (hipGetDevice(&dev) != hipSuccess || hipDeviceGetAttribute(&cus, hipDeviceAttributeMultiprocessorCount, dev) != hipSuccess) { grid = -1; return; }
        if (hipFuncSetAttribute((const void*)mk_fwd, hipFuncAttributeMaxDynamicSharedMemorySize, LDS_BYTES) != hipSuccess) { fprintf(stderr, "hipFuncSetAttribute failed\n"); grid = -1; return; }
        int per_cu = 0;
        if (hipOccupancyMaxActiveBlocksPerMultiprocessor(&per_cu, (const void*)mk_fwd, NWAVES * 64, LDS_BYTES) != hipSuccess || per_cu < 1) fprintf(stderr, "occupancy query: %d\n", per_cu);
        (void)hipGetLastError();
        grid = cus;
    }
    if (grid < 0) return;
    const float* x = (const float*)d_in[0];
    const float* rel_bias = (const float*)d_in[7]; const float* ret_gn_g = (const float*)d_in[8];
    const float* g_ffn = (const float*)d_in[14];
    const float* w_rg = (const float*)d_in[15]; const float* b_rg = (const float*)d_in[16]; const float* w_re = (const float*)d_in[17]; const float* b_re = (const float*)d_in[18];
    const float* w_gate = (const float*)d_in[19]; const float* w_up = (const float*)d_in[20]; const float* w_down = (const float*)d_in[21];
    unsigned char* ws = (unsigned char*)d_ws; float* out = (float*)d_out;
    (void)hipMemsetAsync(ws + WS_CTL, 0, CTL_BYTES, stream);
    unsigned* cnt = (unsigned*)(ws + WS_CTL) + CW_CNT;
    PB pb{}; pb.QA = (bf16*)(ws + WS_QA); pb.KA = (bf16*)(ws + WS_KA); pb.VA = (bf16*)(ws + WS_VA); pb.QB = (bf16*)(ws + WS_QB); pb.KB = (bf16*)(ws + WS_KB);
    pb.VB = (bf16*)(ws + WS_VB); pb.GB = (bf16*)(ws + WS_GB); pb.QC = (bf16*)(ws + WS_QC); pb.KM = (bf16*)(ws + WS_KM); pb.VM = (bf16*)(ws + WS_VM);
    bf16* CAT = (bf16*)(ws + WS_CAT); bf16* HN = (bf16*)(ws + WS_HN); bf16* ACT = (bf16*)(ws + WS_ACT); bf16* YB = (bf16*)(ws + WS_YB);
    float* RET = (float*)(ws + WS_RKV); int* row_tok = (int*)(ws + WS_ROWTOK); float* row_w = (float*)(ws + WS_ROWW); int* toktab = (int*)(ws + WS_TOKTAB);

    Args a{};
    for (int i = 0; i < 22; ++i) a.in[i] = d_in[i];
    a.out = out; a.ws = ws;
    int li = 0;
#define MK(lo_, hi_) do { a.ph_lo = (lo_); a.ph_hi = (hi_); a.li = li++; hipLaunchKernelGGL(mk_fwd, dim3(grid), dim3(NWAVES * 64), LDS_BYTES, stream, a); } while (0)
    MK(0, 10);
#undef MK
}
```

```cpp
#include <hip/hip_runtime.h>
#include <cstdio>
#include <cstdint>

typedef unsigned short bf16;
typedef float f32x4 __attribute__((ext_vector_type(4)));
typedef unsigned u32x4 __attribute__((ext_vector_type(4)));
typedef unsigned u32x2 __attribute__((ext_vector_type(2)));

constexpr int T = 32768, D = 1024, SEQ = 8192, NBATCH = 4, NMEM = 256, MEMROWS = NBATCH * NMEM;
constexpr int HD = 64, AH = 8, BH = 4, CH = 4;
constexpr int INCOLS = 2816, KVCOLS = 512;
constexpr int CHUNK = 64, NCHUNK = SEQ / CHUNK;
constexpr int NE = 32, DE = 512;
constexpr int MAXBLK = 288;
constexpr float EPS = 1e-6f;
constexpr float LOG2E = 1.4426950408889634f;
constexpr float QSCALE = 0.125f * LOG2E;

constexpr size_t MiB = 1u << 20;
constexpr size_t WS_CTL = 0, CTL_BYTES = 1 * MiB;
constexpr size_t WS_WINT = 2 * MiB;
constexpr size_t WS_WOUTT = 9 * MiB;
constexpr size_t WS_WGUT = 12 * MiB;
constexpr size_t WS_WDT = 76 * MiB;
constexpr size_t WS_XN = 108 * MiB;
constexpr size_t WS_ACT = 108 * MiB;
constexpr size_t WS_QA = 180 * MiB, WS_KA = 212 * MiB, WS_VA = 244 * MiB, WS_QB = 276 * MiB, WS_KB = 292 * MiB, WS_VB = 308 * MiB, WS_GB = 324 * MiB, WS_QC = 340 * MiB;
constexpr size_t WS_KM = 356 * MiB, WS_VM = 356 * MiB + 512 * 1024;
constexpr size_t WS_YB = 180 * MiB;
constexpr size_t WS_RKV = 357 * MiB;
constexpr size_t WS_CAT = 389 * MiB;
constexpr size_t WS_HB = 324 * MiB;
constexpr size_t WS_ROWTOK = 453 * MiB, WS_ROWW = 457 * MiB, WS_TOKTAB = 461 * MiB, WS_ST = 462 * MiB, WS_ROWR = 478 * MiB, WS_END = 482 * MiB;
constexpr int CW_CNT = 64;

struct PB { bf16 *QA, *KA, *VA, *QB, *KB, *VB, *GB, *QC, *KM, *VM; };

__device__ __forceinline__ float bf2f(bf16 v) { return __uint_as_float(((unsigned)v) << 16); }
__device__ __forceinline__ bf16 f2bf(float f) { unsigned u = __float_as_uint(f); return (bf16)((u + 0x7fffu + ((u >> 16) & 1u)) >> 16); }
__device__ __forceinline__ unsigned pk2(float lo, float hi) { return (unsigned)f2bf(lo) | ((unsigned)f2bf(hi) << 16); }
__device__ __forceinline__ float wave_sum(float v) {
#pragma unroll
    for (int o = 1; o < 64; o <<= 1) v += __shfl_xor(v, o);
    return v;
}
__device__ __forceinline__ float silu_f(float x) { return x / (1.f + __expf(-x)); }

__device__ __forceinline__ bf16* proj_ptr(const PB& pb, int row, int col) {
    if (col < 512) return pb.QA + (size_t)row * 512 + col;
    if (col < 1024) return pb.KA + (size_t)row * 512 + (col - 512);
    if (col < 1536) return pb.VA + (size_t)row * 512 + (col - 1024);
    if (col < 1792) return pb.QB + (size_t)row * 256 + (col - 1536);
    if (col < 2048) return pb.KB + (size_t)row * 256 + (col - 1792);
    if (col < 2304) return pb.VB + (size_t)row * 256 + (col - 2048);
    if (col < 2560) return pb.GB + (size_t)row * 256 + (col - 2304);
    if (col < 2816) return pb.QC + (size_t)row * 256 + (col - 2560);
    if (col < 3072) return pb.KM + (size_t)(row - T) * 256 + (col - 2816);
    return pb.VM + (size_t)(row - T) * 256 + (col - 3072);
}

__device__ __forceinline__ void transpose_item(const float* W, int K, int N, bf16* WT, int row_off, float* scr, int item, int lane) {
    const int nblk = N / 32, kb = item / nblk, nb = item % nblk, k0 = 64 * kb, n0 = 32 * nb;
#pragma unroll 8
    for (int i = 0; i < 32; ++i) { const int kk = 2 * i + (lane >> 5); scr[kk * 33 + (lane & 31)] = W[(size_t)(k0 + kk) * N + n0 + (lane & 31)]; }
    asm volatile("s_waitcnt lgkmcnt(0)" ::: "memory");
    const int c = lane & 7;
#pragma unroll
    for (int j = 0; j < 4; ++j) { const int n = (lane >> 3) + 8 * j; const float* s = scr + (8 * c) * 33 + n;
        u32x4 o; o.x = pk2(s[0 * 33], s[1 * 33]); o.y = pk2(s[2 * 33], s[3 * 33]); o.z = pk2(s[4 * 33], s[5 * 33]); o.w = pk2(s[6 * 33], s[7 * 33]);
        *(u32x4*)(WT + (size_t)(row_off + n0 + n) * K + k0 + 8 * c) = o; }
    asm volatile("s_waitcnt lgkmcnt(0)" ::: "memory");
}
__device__ __forceinline__ void rms_row_to_bf16(const float* xrow, const float* gain, bf16* orow, int lane) {
    const f32x4* xr = (const f32x4*)xrow + lane; const f32x4* gr = (const f32x4*)gain + lane;
    f32x4 v[4]; float s = 0.f;
#pragma unroll
    for (int j = 0; j < 4; ++j) { v[j] = xr[64 * j]; s += (v[j].x * v[j].x + v[j].y * v[j].y) + (v[j].z * v[j].z + v[j].w * v[j].w); }
    const float r = 1.f / sqrtf(wave_sum(s) * (1.f / D) + EPS);
    unsigned long long* o8 = (unsigned long long*)orow + lane;
#pragma unroll
    for (int j = 0; j < 4; ++j) { const f32x4 g = gr[64 * j];
        o8[64 * j] = (unsigned long long)pk2(v[j].x * r * g.x, v[j].y * r * g.y) | ((unsigned long long)pk2(v[j].z * r * g.z, v[j].w * r * g.w) << 32); }
}

struct P0Args { const float *x, *mem, *g_mix, *g_mem, *w_in, *w_mem_kv, *w_out, *w_gate, *w_up, *w_down; bf16 *XN, *WinT, *WoutT, *WguT, *WdT; };
__global__ void __launch_bounds__(512) k_prologue(P0Args a) {
    __shared__ float scr_all[8 * 64 * 33];
    const int lane = threadIdx.x & 63, wave = threadIdx.x >> 6;
    float* scr = scr_all + wave * 64 * 33;
    const int gw = blockIdx.x * 8 + wave, NGW = gridDim.x * 8;
    constexpr int I_IN = 16 * 88, I_KV = 16 * 16, I_O = 16 * 32, I_E = 256;
    constexpr int NITEMS = I_IN + I_KV + I_O + NE * 3 * I_E;
    for (int it = gw; it < NITEMS; it += NGW) {
        int r = it;
        if (r < I_IN) { transpose_item(a.w_in, D, INCOLS, a.WinT, 0, scr, r, lane); continue; } r -= I_IN;
        if (r < I_KV) { transpose_item(a.w_mem_kv, D, KVCOLS, a.WinT, INCOLS, scr, r, lane); continue; } r -= I_KV;
        if (r < I_O) { transpose_item(a.w_out, D, D, a.WoutT, 0, scr, r, lane); continue; } r -= I_O;
        const int e = r / (3 * I_E), q = r % (3 * I_E);
        if (q < I_E) transpose_item(a.w_gate + (size_t)e * D * DE, D, DE, a.WguT + (size_t)e * D * D, 0, scr, q, lane);
        else if (q < 2 * I_E) transpose_item(a.w_up + (size_t)e * D * DE, D, DE, a.WguT + (size_t)e * D * D, DE, scr, q - I_E, lane);
        else transpose_item(a.w_down + (size_t)e * DE * D, DE, D, a.WdT + (size_t)e * D * DE, 0, scr, q - 2 * I_E, lane);
    }
    for (int m = gw; m < T + MEMROWS; m += NGW) {
        if (m < T) rms_row_to_bf16(a.x + (size_t)m * D, a.g_mix, a.XN + (size_t)m * D, lane);
        else rms_row_to_bf16(a.mem + (size_t)(m - T) * D, a.g_mem, a.XN + (size_t)m * D, lane);
    }
}

template <bool DUAL, class RowMap, class Epi>
__device__ __forceinline__ void nv_gemm_tile(const bf16* A, int lda, const float* B, const float* B2, int ldb, int K, int row0, int col0, RowMap rm, Epi epi) {
    __shared__ float As[16][68];
    __shared__ float Bs[16][68];
    __shared__ float Bs2[DUAL ? 16 : 1][68];
    const int tid = threadIdx.x, tx = tid & 15, ty = tid >> 4;
    float acc[4][4], acc2[4][4];
#pragma unroll
    for (int i = 0; i < 4; ++i)
#pragma unroll
        for (int j = 0; j < 4; ++j) { acc[i][j] = 0.f; acc2[i][j] = 0.f; }
    const int ar = tid >> 2, akq = (tid & 3) * 4;
    const bf16* arow = A + (size_t)rm(row0 + ar) * lda + akq;
    const int bk = tid >> 4, bn = (tid & 15) * 4;
    for (int k0 = 0; k0 < K; k0 += 16) {
        const u32x2 av = *(const u32x2*)(arow + k0);
        As[akq + 0][ar] = __uint_as_float(av.x << 16); As[akq + 1][ar] = __uint_as_float(av.x & 0xffff0000u);
        As[akq + 2][ar] = __uint_as_float(av.y << 16); As[akq + 3][ar] = __uint_as_float(av.y & 0xffff0000u);
        const f32x4 bv = *(const f32x4*)(B + (size_t)(k0 + bk) * ldb + col0 + bn);
        Bs[bk][bn] = bv.x; Bs[bk][bn + 1] = bv.y; Bs[bk][bn + 2] = bv.z; Bs[bk][bn + 3] = bv.w;
        if (DUAL) { const f32x4 b2 = *(const f32x4*)(B2 + (size_t)(k0 + bk) * ldb + col0 + bn);
            Bs2[bk][bn] = b2.x; Bs2[bk][bn + 1] = b2.y; Bs2[bk][bn + 2] = b2.z; Bs2[bk][bn + 3] = b2.w; }
        __syncthreads();
#pragma unroll
        for (int k = 0; k < 16; ++k) {
            float a[4], b[4], c[4];
#pragma unroll
            for (int i = 0; i < 4; ++i) { a[i] = As[k][ty * 4 + i]; b[i] = Bs[k][tx * 4 + i]; c[i] = DUAL ? Bs2[k][tx * 4 + i] : 0.f; }
#pragma unroll
            for (int i = 0; i < 4; ++i)
#pragma unroll
                for (int j = 0; j < 4; ++j) { acc[i][j] += a[i] * b[j]; if (DUAL) acc2[i][j] += a[i] * c[j]; }
        }
        __syncthreads();
    }
#pragma unroll
    for (int i = 0; i < 4; ++i)
#pragma unroll
        for (int j = 0; j < 4; ++j) epi(row0 + ty * 4 + i, col0 + tx * 4 + j, acc[i][j], acc2[i][j]);
}
struct IdMap { __device__ __forceinline__ int operator()(int r) const { return r; } };

__global__ void __launch_bounds__(256) k_nv_inproj(const bf16* XN, const float* W, int ldb, int rowbase, int coloff, PB pb) {
    const int row0 = rowbase + blockIdx.y * 64, col0 = blockIdx.x * 64;
    auto epi = [&](int r, int c, float v, float) { *proj_ptr(pb, r, c + coloff) = f2bf(v); };
    nv_gemm_tile<false>(XN, D, W, nullptr, ldb, D, row0, col0, IdMap(), epi);
}
__global__ void __launch_bounds__(256) k_nv_outproj(const bf16* CAT, const float* W, const float* X, float* OUT) {
    const int row0 = blockIdx.y * 64, col0 = blockIdx.x * 64;
    auto epi = [&](int r, int c, float v, float) { OUT[(size_t)r * D + c] = X[(size_t)r * D + c] + v; };
    nv_gemm_tile<false>(CAT, D, W, nullptr, D, D, row0, col0, IdMap(), epi);
}

__global__ void __launch_bounds__(256) k_nv_postproc(PB pb, const int* positions, const float* qn_a, const float* kn_a, const float* qn_c, const float* kn_c) {
    const long id = (long)blockIdx.x * 256 + threadIdx.x;
    bf16* p; const float* gain = nullptr; float scale = 1.f; int mode; int row;
    if (id < (long)T * 32) {
        row = (int)(id >> 5); const int hi = (int)(id & 31);
        if (hi < 8) { p = pb.QA + (size_t)row * 512 + hi * 64; gain = qn_a; scale = QSCALE; mode = 0; }
        else if (hi < 16) { p = pb.KA + (size_t)row * 512 + (hi - 8) * 64; gain = kn_a; mode = 0; }
        else if (hi < 20) { p = pb.QB + (size_t)row * 256 + (hi - 16) * 64; mode = 1; }
        else if (hi < 24) { p = pb.KB + (size_t)row * 256 + (hi - 20) * 64; mode = 1; scale = 0.125f; }
        else if (hi < 28) { p = pb.GB + (size_t)row * 256 + (hi - 24) * 64; mode = 2; }
        else { p = pb.QC + (size_t)row * 256 + (hi - 28) * 64; gain = qn_c; scale = QSCALE; mode = 0; }
    } else {
        const long id2 = id - (long)T * 32; if (id2 >= MEMROWS * 4) return;
        row = (int)(id2 >> 2); p = pb.KM + (size_t)row * 256 + (id2 & 3) * 64; gain = kn_c; mode = 0;
    }
    if (mode == 0) {
        float ss = 0.f;
        for (int d = 0; d < 64; ++d) { const float v = bf2f(p[d]); ss += v * v; }
        const float r = 1.f / sqrtf(ss * (1.f / 64.f) + EPS);
        for (int d = 0; d < 64; ++d) p[d] = f2bf(bf2f(p[d]) * r * gain[d] * scale);
    } else if (mode == 1) {
        const float pos = (float)positions[row];
        for (int i = 0; i < 32; ++i) {
            const float inv = exp2f(-(float)i * (13.287712379549449f / 32.f));
            float rev = pos * inv * 0.15915494309189535f; rev -= floorf(rev);
            const float sn = __builtin_amdgcn_sinf(rev), cs = __builtin_amdgcn_cosf(rev);
            const float t1 = bf2f(p[i]), t2 = bf2f(p[i + 32]);
            p[i] = f2bf((t1 * cs - t2 * sn) * scale); p[i + 32] = f2bf((t1 * sn + t2 * cs) * scale);
        }
    } else {
        for (int d = 0; d < 64; ++d) p[d] = f2bf(silu_f(bf2f(p[d])));
    }
}

__device__ __forceinline__ void nv_attnA_unit(int u, int lane_, const bf16* QA, const bf16* KA, const bf16* VA, const float* rel_bias, bf16* CAT) {
    const int c = u % NCHUNK, h = (u / NCHUNK) % AH, b = u / (NCHUNK * AH);
    const int i = lane_; const size_t qrow = (size_t)b * SEQ + c * CHUNK + i;
    float q[64];
#pragma unroll
    for (int d8 = 0; d8 < 8; ++d8) { const u32x4 v = *(const u32x4*)(QA + qrow * 512 + h * 64 + d8 * 8);
        q[d8 * 8 + 0] = __uint_as_float(v.x << 16); q[d8 * 8 + 1] = __uint_as_float(v.x & 0xffff0000u); q[d8 * 8 + 2] = __uint_as_float(v.y << 16); q[d8 * 8 + 3] = __uint_as_float(v.y & 0xffff0000u);
        q[d8 * 8 + 4] = __uint_as_float(v.z << 16); q[d8 * 8 + 5] = __uint_as_float(v.z & 0xffff0000u); q[d8 * 8 + 6] = __uint_as_float(v.w << 16); q[d8 * 8 + 7] = __uint_as_float(v.w & 0xffff0000u); }
    const float* bias = rel_bias + h * 192;
    float m = -3.0e38f;
    for (int pass = 0; pass < 2; ++pass) {
        float l = 0.f; float o[64];
#pragma unroll
        for (int d = 0; d < 64; ++d) o[d] = 0.f;
        for (int j = 0; j < 9; ++j) {
            const int kc = c - 8 + j; if (kc < 0) continue;
            for (int kk = 0; kk < 64; ++kk) {
                const size_t krow = (size_t)b * SEQ + kc * CHUNK + kk;
                const bf16* kp = KA + krow * 512 + h * 64;
                float s = 0.f;
#pragma unroll
                for (int d8 = 0; d8 < 8; ++d8) { const u32x4 v = *(const u32x4*)(kp + d8 * 8);
                    s += q[d8 * 8 + 0] * __uint_as_float(v.x << 16) + q[d8 * 8 + 1] * __uint_as_float(v.x & 0xffff0000u) + q[d8 * 8 + 2] * __uint_as_float(v.y << 16) + q[d8 * 8 + 3] * __uint_as_float(v.y & 0xffff0000u)
                       + q[d8 * 8 + 4] * __uint_as_float(v.z << 16) + q[d8 * 8 + 5] * __uint_as_float(v.z & 0xffff0000u) + q[d8 * 8 + 6] * __uint_as_float(v.w << 16) + q[d8 * 8 + 7] * __uint_as_float(v.w & 0xffff0000u); }
                int rel = (8 - j) * 64 + i - kk; rel = rel < -63 ? -63 : (rel > 128 ? 128 : rel);
                s += bias[rel + 63] * LOG2E;
                if (pass == 0) { m = fmaxf(m, s); }
                else {
                    const float p = exp2f(s - m); l += p;
                    const bf16* vp = VA + krow * 512 + h * 64;
#pragma unroll
                    for (int d8 = 0; d8 < 8; ++d8) { const u32x4 v = *(const u32x4*)(vp + d8 * 8);
                        o[d8 * 8 + 0] += p * __uint_as_float(v.x << 16); o[d8 * 8 + 1] += p * __uint_as_float(v.x & 0xffff0000u); o[d8 * 8 + 2] += p * __uint_as_float(v.y << 16); o[d8 * 8 + 3] += p * __uint_as_float(v.y & 0xffff0000u);
                        o[d8 * 8 + 4] += p * __uint_as_float(v.z << 16); o[d8 * 8 + 5] += p * __uint_as_float(v.z & 0xffff0000u); o[d8 * 8 + 6] += p * __uint_as_float(v.w << 16); o[d8 * 8 + 7] += p * __uint_as_float(v.w & 0xffff0000u); }
                }
            }
        }
        if (pass == 1) {
            const float il = 1.f / l; bf16* op = CAT + qrow * D + h * 64;
#pragma unroll
            for (int d = 0; d < 64; d += 2) *(unsigned*)(op + d) = pk2(o[d] * il, o[d + 1] * il);
        }
    }
}
__device__ __forceinline__ void nv_cross_unit(int u, int lane_, const bf16* QC, const bf16* KM, const bf16* VM, bf16* CAT) {
    const int c = u % NCHUNK, h = (u / NCHUNK) % CH, b = u / (NCHUNK * CH);
    const int i = lane_; const size_t qrow = (size_t)b * SEQ + c * CHUNK + i;
    float q[64];
#pragma unroll
    for (int d8 = 0; d8 < 8; ++d8) { const u32x4 v = *(const u32x4*)(QC + qrow * 256 + h * 64 + d8 * 8);
        q[d8 * 8 + 0] = __uint_as_float(v.x << 16); q[d8 * 8 + 1] = __uint_as_float(v.x & 0xffff0000u); q[d8 * 8 + 2] = __uint_as_float(v.y << 16); q[d8 * 8 + 3] = __uint_as_float(v.y & 0xffff0000u);
        q[d8 * 8 + 4] = __uint_as_float(v.z << 16); q[d8 * 8 + 5] = __uint_as_float(v.z & 0xffff0000u); q[d8 * 8 + 6] = __uint_as_float(v.w << 16); q[d8 * 8 + 7] = __uint_as_float(v.w & 0xffff0000u); }
    float m = -3.0e38f;
    for (int pass = 0; pass < 2; ++pass) {
        float l = 0.f; float o[64];
#pragma unroll
        for (int d = 0; d < 64; ++d) o[d] = 0.f;
        for (int kk = 0; kk < NMEM; ++kk) {
            const size_t krow = (size_t)b * NMEM + kk;
            const bf16* kp = KM + krow * 256 + h * 64;
            float s = 0.f;
#pragma unroll
            for (int d8 = 0; d8 < 8; ++d8) { const u32x4 v = *(const u32x4*)(kp + d8 * 8);
                s += q[d8 * 8 + 0] * __uint_as_float(v.x << 16) + q[d8 * 8 + 1] * __uint_as_float(v.x & 0xffff0000u) + q[d8 * 8 + 2] * __uint_as_float(v.y << 16) + q[d8 * 8 + 3] * __uint_as_float(v.y & 0xffff0000u)
                   + q[d8 * 8 + 4] * __uint_as_float(v.z << 16) + q[d8 * 8 + 5] * __uint_as_float(v.z & 0xffff0000u) + q[d8 * 8 + 6] * __uint_as_float(v.w << 16) + q[d8 * 8 + 7] * __uint_as_float(v.w & 0xffff0000u); }
            if (pass == 0) { m = fmaxf(m, s); }
            else {
                const float p = exp2f(s - m); l += p;
                const bf16* vp = VM + krow * 256 + h * 64;
#pragma unroll
                for (int d8 = 0; d8 < 8; ++d8) { const u32x4 v = *(const u32x4*)(vp + d8 * 8);
                    o[d8 * 8 + 0] += p * __uint_as_float(v.x << 16); o[d8 * 8 + 1] += p * __uint_as_float(v.x & 0xffff0000u); o[d8 * 8 + 2] += p * __uint_as_float(v.y << 16); o[d8 * 8 + 3] += p * __uint_as_float(v.y & 0xffff0000u);
                    o[d8 * 8 + 4] += p * __uint_as_float(v.z << 16); o[d8 * 8 + 5] += p * __uint_as_float(v.z & 0xffff0000u); o[d8 * 8 + 6] += p * __uint_as_float(v.w << 16); o[d8 * 8 + 7] += p * __uint_as_float(v.w & 0xffff0000u); }
            }
        }
        if (pass == 1) {
            const float il = 1.f / l; bf16* op = CAT + qrow * D + 768 + h * 64;
#pragma unroll
            for (int d = 0; d < 64; d += 2) *(unsigned*)(op + d) = pk2(o[d] * il, o[d + 1] * il);
        }
    }
}
__device__ __forceinline__ void nv_ret_unit(int u, int lane_, const bf16* QB, const bf16* KB, const bf16* VB, float* RET) {
    const int e = u & 63, h = (u >> 6) & 3, b = u >> 8; const int d = lane_;
    const float gamma = 1.f - exp2f(-5.f - (float)h);
    float S = 0.f;
    for (int n = 0; n < SEQ; ++n) {
        const size_t row = (size_t)b * SEQ + n;
        const float kd = bf2f(KB[row * 256 + h * 64 + d]), qd = bf2f(QB[row * 256 + h * 64 + d]), ve = bf2f(VB[row * 256 + h * 64 + e]);
        S = gamma * S + kd * ve;
        const float o = wave_sum(qd * S);
        if (d == 0) RET[row * 256 + h * 64 + e] = o;
    }
}
__device__ __forceinline__ void nv_retnorm_item(int id, const float* RET, const bf16* GB, const float* gn_g, bf16* CAT) {
    const int row = id >> 2, h = id & 3;
    const float* r = RET + (size_t)row * 256 + h * 64;
    float mu = 0.f; for (int d = 0; d < 64; ++d) mu += r[d]; mu *= (1.f / 64.f);
    float var = 0.f; for (int d = 0; d < 64; ++d) { const float t = r[d] - mu; var += t * t; } var *= (1.f / 64.f);
    const float rs = 1.f / sqrtf(var + EPS);
    for (int d = 0; d < 64; ++d) { const float y = (r[d] - mu) * rs * gn_g[h * 64 + d];
        CAT[(size_t)row * D + 512 + h * 64 + d] = f2bf(bf2f(GB[(size_t)row * 256 + h * 64 + d]) * y); }
}

__global__ void __launch_bounds__(256) k_nv_router(const float* H, const float* g_ffn, const float* w_rg, const float* b_rg, const float* w_re, const float* b_re,
                                                   bf16* HN, unsigned* cnt, int* row_tok, float* row_w, int* toktab) {
    const int lane = threadIdx.x & 63, tok = blockIdx.x * 4 + (threadIdx.x >> 6);
    const float* hrow = H + (size_t)tok * D;
    float ss = 0.f;
#pragma unroll
    for (int j = 0; j < 16; ++j) { const float v = hrow[lane + 64 * j]; ss += v * v; }
    const float r = 1.f / sqrtf(wave_sum(ss) * (1.f / D) + EPS);
    float acc[36];
#pragma unroll
    for (int q = 0; q < 36; ++q) acc[q] = 0.f;
#pragma unroll 2
    for (int j = 0; j < 16; ++j) {
        const int k = lane + 64 * j; const float hn = hrow[k] * r * g_ffn[k];
        HN[(size_t)tok * D + k] = f2bf(hn);
        const f32x4 wg = *(const f32x4*)(w_rg + (size_t)k * 4);
        acc[0] += hn * wg.x; acc[1] += hn * wg.y; acc[2] += hn * wg.z; acc[3] += hn * wg.w;
#pragma unroll
        for (int q = 0; q < 8; ++q) { const f32x4 we = *(const f32x4*)(w_re + (size_t)k * 32 + 4 * q);
            acc[4 + 4 * q] += hn * we.x; acc[5 + 4 * q] += hn * we.y; acc[6 + 4 * q] += hn * we.z; acc[7 + 4 * q] += hn * we.w; }
    }
#pragma unroll
    for (int q = 0; q < 36; ++q) acc[q] = wave_sum(acc[q]);
    float gl[4];
#pragma unroll
    for (int g = 0; g < 4; ++g) gl[g] = acc[g] + b_rg[g];
    int gs = 0; float gm = gl[0];
#pragma unroll
    for (int g = 1; g < 4; ++g) if (gl[g] > gm) { gm = gl[g]; gs = g; }
    float gsum = 0.f;
#pragma unroll
    for (int g = 0; g < 4; ++g) gsum += __expf(gl[g] - gm);
    const float pg = 1.f / gsum;
    float el[8];
#pragma unroll
    for (int i = 0; i < 8; ++i) { const float k0 = gs == 0 ? 1.f : 0.f, k1 = gs == 1 ? 1.f : 0.f, k2 = gs == 2 ? 1.f : 0.f, k3 = gs == 3 ? 1.f : 0.f;
        el[i] = k0 * acc[4 + i] + k1 * acc[12 + i] + k2 * acc[20 + i] + k3 * acc[28 + i] + b_re[gs * 8 + i]; }
    int i0 = 0; float m0 = el[0];
#pragma unroll
    for (int i = 1; i < 8; ++i) if (el[i] > m0) { m0 = el[i]; i0 = i; }
    int i1 = -1; float m1 = -3.0e38f;
#pragma unroll
    for (int i = 0; i < 8; ++i) if (i != i0 && el[i] > m1) { m1 = el[i]; i1 = i; }
    const float p1 = __expf(m1 - m0);
    const float w0 = pg / (1.f + p1), w1 = pg * p1 / (1.f + p1);
    if (lane == 0) {
        const int e0 = gs * 8 + i0, e1 = gs * 8 + i1;
        const unsigned s0 = atomicAdd(&cnt[e0], 1u), s1 = atomicAdd(&cnt[e1], 1u);
        row_tok[(size_t)e0 * T + s0] = tok; row_w[(size_t)e0 * T + s0] = w0;
        row_tok[(size_t)e1 * T + s1] = tok; row_w[(size_t)e1 * T + s1] = w1;
        toktab[tok * 4 + 0] = e0; toktab[tok * 4 + 1] = (int)s0; toktab[tok * 4 + 2] = e1; toktab[tok * 4 + 3] = (int)s1;
    }
}

__device__ __forceinline__ void moe_blkstart(const unsigned* cnt, int* blkstart  ) {
    int s = 0;
    for (int e = 0; e < NE; ++e) { blkstart[e] = s; s += (int)((cnt[e] + 255u) >> 8); }
    blkstart[NE] = s;
}
struct GatherMap { const int* tok; unsigned n; int base; __device__ __forceinline__ int operator()(int r) const { const unsigned s = (unsigned)(r - base); return s < n ? tok[s] : 0; } };

__global__ void __launch_bounds__(256) k_nv_g1(const bf16* HN, const float* w_gate, const float* w_up, const unsigned* cnt, const int* row_tok, bf16* ACT) {
    __shared__ int bs[33];
    if (threadIdx.x == 0) moe_blkstart(cnt, bs);
    __syncthreads();
    const int sb = blockIdx.x, bidx = sb >> 2; if (bidx >= bs[NE]) return;
    int e = 0; while (bs[e + 1] <= bidx) ++e;
    const int rb = bidx - bs[e]; const int slot0 = rb * 256 + (sb & 3) * 64;
    const int prow0 = bidx * 256 + (sb & 3) * 64;
    GatherMap gm{row_tok + (size_t)e * T, cnt[e], prow0 - slot0};
    auto epi = [&](int r, int c, float g, float u) { ACT[(size_t)r * DE + c] = f2bf(silu_f(g) * u); };
    nv_gemm_tile<true>(HN, D, w_gate + (size_t)e * D * DE, w_up + (size_t)e * D * DE, DE, D, prow0, blockIdx.y * 64, gm, epi);
}
__global__ void __launch_bounds__(256) k_nv_g2(const bf16* ACT, const float* w_down, const unsigned* cnt, const float* row_w, bf16* YB) {
    __shared__ int bs[33];
    if (threadIdx.x == 0) moe_blkstart(cnt, bs);
    __syncthreads();
    const int sb = blockIdx.x, bidx = sb >> 2; if (bidx >= bs[NE]) return;
    int e = 0; while (bs[e + 1] <= bidx) ++e;
    const int rb = bidx - bs[e]; const int prow0 = bidx * 256 + (sb & 3) * 64; const int sbase = prow0 - (rb * 256 + (sb & 3) * 64);
    const float* wl = row_w + (size_t)e * T; const unsigned n = cnt[e];
    auto epi = [&](int r, int c, float v, float) { const unsigned s = (unsigned)(r - sbase); const float w = s < n ? wl[s] : 0.f; YB[(size_t)r * D + c] = f2bf(w * v); };
    nv_gemm_tile<false>(ACT, DE, w_down + (size_t)e * DE * D, nullptr, D, DE, prow0, blockIdx.y * 64, IdMap(), epi);
}
__global__ void __launch_bounds__(256) k_combine(float* OUT, const bf16* YB, const unsigned* cnt, const int* toktab) {
    __shared__ int bs[33];
    if (threadIdx.x == 0) moe_blkstart(cnt, bs);
    __syncthreads();
    const int tok = blockIdx.x; const int c = threadIdx.x * 4;
    const int e0 = toktab[tok * 4], s0 = toktab[tok * 4 + 1], e1 = toktab[tok * 4 + 2], s1 = toktab[tok * 4 + 3];
    const size_t p0 = (size_t)bs[e0] * 256 + s0, p1 = (size_t)bs[e1] * 256 + s1;
    f32x4 o = *(f32x4*)(OUT + (size_t)tok * D + c);
    const u32x2 a = *(const u32x2*)(YB + p0 * D + c), b = *(const u32x2*)(YB + p1 * D + c);
    o.x += __uint_as_float(a.x << 16) + __uint_as_float(b.x << 16); o.y += __uint_as_float(a.x & 0xffff0000u) + __uint_as_float(b.x & 0xffff0000u);
    o.z += __uint_as_float(a.y << 16) + __uint_as_float(b.y << 16); o.w += __uint_as_float(a.y & 0xffff0000u) + __uint_as_float(b.y & 0xffff0000u);
    *(f32x4*)(OUT + (size_t)tok * D + c) = o;
}

__global__ void __launch_bounds__(64) k_nv_attnA(const bf16* QA, const bf16* KA, const bf16* VA, const float* rel_bias, bf16* CAT) { nv_attnA_unit(blockIdx.x, threadIdx.x, QA, KA, VA, rel_bias, CAT); }
__global__ void __launch_bounds__(64) k_nv_cross(const bf16* QC, const bf16* KM, const bf16* VM, bf16* CAT) { nv_cross_unit(blockIdx.x, threadIdx.x, QC, KM, VM, CAT); }
__global__ void __launch_bounds__(64) k_nv_ret(const bf16* QB, const bf16* KB, const bf16* VB, float* RET) { nv_ret_unit(blockIdx.x, threadIdx.x, QB, KB, VB, RET); }
__global__ void __launch_bounds__(256) k_nv_retnorm(const float* RET, const bf16* GB, const float* gn_g, bf16* CAT) { nv_retnorm_item(blockIdx.x * 256 + threadIdx.x, RET, GB, gn_g, CAT); }
namespace pg8 {
#define PG8_LAS __attribute__((address_space(3)))
typedef short bf16x8 __attribute__((ext_vector_type(8)));
constexpr int BM = 256, BK = 64, HALF = 128, HTB = HALF * BK * 2, STAGE_BYTES = 8 * HTB, NXCD = 8, WGM = 8;

__host__ __device__ __forceinline__ int lds_byte(int r, int c) { const int st = (r >> 4) * 2 + (c >> 5), rr = r & 15, cc = c & 31, ob = rr * 64 + cc * 2; return st * 1024 + (ob ^ (((ob >> 9) & 1) << 5)); }
__host__ __device__ __forceinline__ void stage_rc(int b, int& R, int& C) { const int st = b / 1024, sb = b % 1024, swz = sb ^ (((sb >> 9) & 1) << 5); R = (st >> 1) * 16 + swz / 64; C = (st & 1) * 32 + (swz % 64) / 2; }
__host__ __device__ __forceinline__ int perm32(int rho) { const int n = rho >> 4, i = rho & 15; return 8 * (i >> 2) + 4 * n + (i & 3); }

struct Unit { int pm, pn; const char* a; const char* b; int e, rb; };

__device__ __forceinline__ void static_map(int L, int nM, int nN, int& pm, int& pn) {
    const int nwg = nM * nN; int wgid = L;
    { const int q = nwg / NXCD, r = nwg % NXCD, xcd = wgid % NXCD, off = wgid / NXCD; wgid = (xcd < r ? xcd * (q + 1) : r * (q + 1) + (xcd - r) * q) + off; }
    const int nig = WGM * nN, gid = wgid / nig, fm = gid * WGM, gsz = (nM - fm) < WGM ? (nM - fm) : WGM;
    pm = fm + ((wgid % nig) % gsz); pn = (wgid % nig) / gsz;
}

__device__ __forceinline__ unsigned cvt_pk_bf16(float lo, float hi) { unsigned r; asm volatile("v_cvt_pk_bf16_f32 %0, %1, %2" : "=v"(r) : "v"(lo), "v"(hi)); return r; }

template <class Epi, class Sched, bool ALIGN_EPI, bool GATHER>
__device__ __forceinline__ void gemm_phase(PG8_LAS unsigned char* lds, const int K, const unsigned hstepA, const unsigned hstepB, PG8_LAS unsigned* gspill, const Sched& S, const Epi& E) {
    int tid_ = threadIdx.x; asm volatile("" : "+v"(tid_));
    const int tid = tid_, wid = __builtin_amdgcn_readfirstlane(tid >> 6), lane = tid & 63, wr = wid >> 2, wc = wid & 3, fr = lane & 15, fq = lane >> 4;
    const int nt = K / BK;
    unsigned vA[2][2], voffB[2];
#pragma unroll
    for (int i = 0; i < 2; ++i) { int R, C; stage_rc(tid * 16 + i * 8192, R, C);
        const int Rb = Epi::BMAP == 0 ? R : (Epi::BMAP == 1 ? ((R & ~31) + perm32(R & 31)) : (2 * (R & ~31) + perm32(R & 31)));
        voffB[i] = (unsigned)(Rb * K + C) * 2u; vA[0][i] = (unsigned)(R * K + C) * 2u; vA[1][i] = vA[0][i] + hstepA; }
    const size_t kstep = (size_t)(BK * 2);
    const unsigned ldsw = (unsigned)wid * 1024u;
    const int aoff = lds_byte(wr * 64 + fr, fq * 8), boff = lds_byte(wc * 32 + fr, fq * 8);
#define PG8_SA(b, h) (((b) * 2 + (h)) * HTB)
#define PG8_SB(b, h) ((4 + (b) * 2 + (h)) * HTB)
#define PG8_STAGE_B(bufoff, gbase) do { _Pragma("unroll") for (int _i = 0; _i < 2; ++_i) \
        __builtin_amdgcn_global_load_lds((const unsigned*)((const char*)(gbase) + voffB[_i]), (PG8_LAS unsigned*)(lds + (bufoff) + ldsw + _i * 8192), 16, 0, 0); } while (0)
#define PG8_STAGE_A(bufoff, gbase, h) do { _Pragma("unroll") for (int _i = 0; _i < 2; ++_i) \
        __builtin_amdgcn_global_load_lds((const unsigned*)((const char*)(gbase) + vA[h][_i]), (PG8_LAS unsigned*)(lds + (bufoff) + ldsw + _i * 8192), 16, 0, 0); } while (0)
#define PG8_LDA(dst, b, h) do { _Pragma("unroll") for (int m = 0; m < 4; ++m) _Pragma("unroll") for (int k = 0; k < 2; ++k) dst[m][k] = *(const PG8_LAS bf16x8*)(lds + PG8_SA(b, h) + aoff + m * 2048 + k * 1024); } while (0)
#define PG8_LDB(dst, b, h) do { _Pragma("unroll") for (int n = 0; n < 2; ++n) _Pragma("unroll") for (int k = 0; k < 2; ++k) dst[n][k] = *(const PG8_LAS bf16x8*)(lds + PG8_SB(b, h) + boff + n * 2048 + k * 1024); } while (0)
#define PG8_MMA(ai, bj, At, Bt) do { __builtin_amdgcn_s_setprio(1); _Pragma("unroll") for (int m = 0; m < 4; ++m) _Pragma("unroll") for (int n = 0; n < 2; ++n) _Pragma("unroll") for (int k = 0; k < 2; ++k) \
        acc[ai][bj][m][n] = __builtin_amdgcn_mfma_f32_16x16x32_bf16(Bt[n][k], At[m][k], acc[ai][bj][m][n], 0, 0, 0); __builtin_amdgcn_s_setprio(0); } while (0)
#define PG8_WAIT_V(n) asm volatile("s_waitcnt vmcnt(" #n ")" ::: "memory")
#define PG8_WAIT_L(n) asm volatile("s_waitcnt lgkmcnt(" #n ")" ::: "memory")
#define PG8_BAR __builtin_amdgcn_s_barrier()
#define PG8_SCHED __builtin_amdgcn_sched_barrier(0)
    Unit cur, nxt; int ui = 0;
    if (!S.next(0, cur)) return;
    if constexpr (GATHER) {
#pragma unroll
        for (int i = 0; i < 2; ++i) { int R, C; stage_rc(tid * 16 + i * 8192, R, C);
#pragma unroll
            for (int h = 0; h < 2; ++h) vA[h][i] = (unsigned)S.arow(cur, h * HALF + R) * (unsigned)(K * 2) + (unsigned)(C * 2); }
    }
    f32x4 acc[2][2][4][2];
#pragma unroll
    for (int a = 0; a < 2; ++a)
#pragma unroll
        for (int b = 0; b < 2; ++b)
#pragma unroll
            for (int m = 0; m < 4; ++m)
#pragma unroll
                for (int n = 0; n < 2; ++n) acc[a][b][m][n] = (f32x4){0.f, 0.f, 0.f, 0.f};
    bf16x8 At[4][2], B0[2][2], B1[2][2];
    const char* cA = cur.a; const char* cB = cur.b;
    PG8_STAGE_B(PG8_SB(0, 0), cB); PG8_STAGE_B(PG8_SB(0, 1), cB + hstepB); PG8_STAGE_A(PG8_SA(0, 0), cA, 0); PG8_STAGE_A(PG8_SA(0, 1), cA, 1);
    if (wr == 1) PG8_BAR;
    PG8_WAIT_V(2); PG8_BAR;
    PG8_STAGE_B(PG8_SB(1, 0), cB + kstep); PG8_STAGE_A(PG8_SA(1, 0), cA + kstep, 0); PG8_STAGE_B(PG8_SB(1, 1), cB + hstepB + kstep);
    PG8_WAIT_V(6); PG8_BAR;
    for (;;) {
        const bool has_next = S.next(ui + 1, nxt);
        const char* nA = has_next ? nxt.a : cA; const char* nB = has_next ? nxt.b : cB;
        if constexpr (GATHER) {
            if (has_next) {
                unsigned o[4];
#pragma unroll
                for (int i = 0; i < 2; ++i) { int R, C; stage_rc(tid * 16 + i * 8192, R, C);
#pragma unroll
                    for (int h = 0; h < 2; ++h) o[h * 2 + i] = (unsigned)S.arow(nxt, h * HALF + R) * (unsigned)(K * 2) + (unsigned)(C * 2); }
                *(PG8_LAS u32x4*)(gspill + tid * 4) = (u32x4){o[0], o[1], o[2], o[3]};
            }
        }
        for (int t = 0; t < nt; t += 2) {
            const bool last = (t == nt - 2);
            const char* a1 = cA + (size_t)(t + 1) * kstep;
            const char* a2 = last ? nA : cA + (size_t)(t + 2) * kstep; const char* b2 = last ? nB : cB + (size_t)(t + 2) * kstep;
            const char* a3 = a2 + kstep; const char* b3 = b2 + kstep;
            PG8_LDB(B0, 0, 0); PG8_LDB(B1, 0, 1); PG8_SCHED; PG8_LDA(At, 0, 0); PG8_STAGE_A(PG8_SA(1, 1), a1, 1);
            if constexpr (GATHER) { if (last && has_next) { const u32x4 o = *(const PG8_LAS u32x4*)(gspill + tid * 4); vA[0][0] = o.x; vA[0][1] = o.y; vA[1][0] = o.z; vA[1][1] = o.w; } }
            PG8_WAIT_V(8); PG8_WAIT_L(0); PG8_BAR; PG8_MMA(0, 0, At, B0); PG8_MMA(0, 1, At, B1); PG8_BAR; PG8_SCHED;
            PG8_LDA(At, 0, 1); PG8_STAGE_B(PG8_SB(0, 0), b2); PG8_STAGE_B(PG8_SB(0, 1), b2 + hstepB); PG8_STAGE_A(PG8_SA(0, 0), a2, 0);
            PG8_WAIT_V(8); PG8_WAIT_L(0); PG8_BAR; PG8_MMA(1, 0, At, B0); PG8_MMA(1, 1, At, B1); PG8_BAR; PG8_SCHED;
            PG8_LDB(B0, 1, 0); PG8_LDB(B1, 1, 1); PG8_SCHED; PG8_LDA(At, 1, 0); PG8_STAGE_A(PG8_SA(0, 1), a2, 1);
            PG8_WAIT_V(8); PG8_WAIT_L(0); PG8_BAR; PG8_MMA(0, 0, At, B0); PG8_MMA(0, 1, At, B1); PG8_BAR; PG8_SCHED;
            PG8_LDA(At, 1, 1); PG8_STAGE_B(PG8_SB(1, 0), b3); PG8_STAGE_B(PG8_SB(1, 1), b3 + hstepB); PG8_STAGE_A(PG8_SA(1, 0), a3, 0);
            PG8_WAIT_V(8); PG8_WAIT_L(0); PG8_BAR; PG8_MMA(1, 0, At, B0); PG8_MMA(1, 1, At, B1); PG8_BAR; PG8_SCHED;
        }
        if constexpr (ALIGN_EPI) { if (wr == 0) PG8_BAR; }
        E(acc, cur, wr, wc, fr, fq);
        if (!has_next) break;
#pragma unroll
        for (int a = 0; a < 2; ++a)
#pragma unroll
            for (int b = 0; b < 2; ++b)
#pragma unroll
                for (int m = 0; m < 4; ++m)
#pragma unroll
                    for (int n = 0; n < 2; ++n) acc[a][b][m][n] = (f32x4){0.f, 0.f, 0.f, 0.f};
        cur = nxt; cA = nA; cB = nB; ++ui;
        if constexpr (ALIGN_EPI) { if (wr == 1) PG8_BAR; }
    }
    PG8_WAIT_V(0);
    if constexpr (!ALIGN_EPI) { if (wr == 0) PG8_BAR; }
    PG8_BAR;
#undef PG8_SA
#undef PG8_SB
#undef PG8_STAGE_A
#undef PG8_STAGE_B
#undef PG8_LDA
#undef PG8_LDB
#undef PG8_MMA
#undef PG8_WAIT_V
#undef PG8_WAIT_L
#undef PG8_BAR
#undef PG8_SCHED
}

struct ProjOrder {
    int G, c; const char* A; const char* Bt;
    __device__ __forceinline__ bool next(int i, Unit& u) const {
        const int L = i * G + c; if (L >= 1416) return false;
        int pm, pn;
        if (L < 1408) static_map(L, 128, 11, pm, pn); else { const int j = L - 1408; pm = 128 + (j >> 1); pn = 11 + (j & 1); }
        u.pm = pm; u.pn = pn; u.a = A + (size_t)pm * (256 * 2048); u.b = Bt + (size_t)pn * (256 * 2048); u.e = 0; u.rb = 0; return true;
    }
    __device__ __forceinline__ int arow(const Unit&, int) const { return 0; }
};
struct PlainOrder {
    int G, c, nM, nN; const char* A; const char* Bt; int ldbytes;
    __device__ __forceinline__ bool next(int i, Unit& u) const {
        const int L = i * G + c; if (L >= nM * nN) return false;
        int pm, pn; static_map(L, nM, nN, pm, pn);
        u.pm = pm; u.pn = pn; u.a = A + (size_t)pm * 256 * ldbytes; u.b = Bt + (size_t)pn * 256 * ldbytes; u.e = 0; u.rb = 0; return true;
    }
    __device__ __forceinline__ int arow(const Unit&, int) const { return 0; }
};

struct MoeOrder {
    int G, c, nunits; const PG8_LAS int* blkstart; const PG8_LAS int* blk2e;
    const char* Abase; size_t aBlk; const char* Bbase; size_t bExp, bTile; const int* row_tok; const unsigned* cnt;
    __device__ __forceinline__ bool next(int i, Unit& u) const {
        const int L = i * G + c; if (L >= nunits) return false;
        const int bidx = L >> 2, pn = L & 3;
        const int e = __builtin_amdgcn_readfirstlane(blk2e[bidx]); const int rb = bidx - __builtin_amdgcn_readfirstlane(blkstart[e]);
        u.pm = bidx; u.pn = pn; u.e = e; u.rb = rb; u.a = Abase + (size_t)bidx * aBlk; u.b = Bbase + (size_t)e * bExp + (size_t)pn * bTile; return true;
    }
    __device__ __forceinline__ int arow(const Unit& u, int r) const { const unsigned s = (unsigned)(u.rb * 256 + r); return s < cnt[u.e] ? row_tok[(size_t)u.e * T + s] : 0; }
};

struct EpiProj {
    static constexpr int BMAP = 2;
    PB pb; const int* positions; const float *qn_a, *kn_a, *qn_c, *kn_c;
    __device__ __forceinline__ void operator()(const f32x4 (&acc)[2][2][4][2], const Unit& u, int wr, int wc, int fr, int fq) const {
        asm volatile("" : "+v"(fr), "+v"(fq));
        const int pn = u.pn;
        bf16* dst; int ld, colbase = 0, mode = 3; const float* gain = nullptr; float scale = 1.f; int rowoff = 0;
        if (pn < 2) { dst = pb.QA; ld = 512; colbase = pn * 256; mode = 0; gain = qn_a; scale = QSCALE; }
        else if (pn < 4) { dst = pb.KA; ld = 512; colbase = (pn - 2) * 256; mode = 0; gain = kn_a; }
        else if (pn < 6) { dst = pb.VA; ld = 512; colbase = (pn - 4) * 256; }
        else if (pn == 6) { dst = pb.QB; ld = 256; mode = 1; }
        else if (pn == 7) { dst = pb.KB; ld = 256; mode = 1; scale = 0.125f; }
        else if (pn == 8) { dst = pb.VB; ld = 256; }
        else if (pn == 9) { dst = pb.GB; ld = 256; mode = 2; }
        else if (pn == 10) { dst = pb.QC; ld = 256; mode = 0; gain = qn_c; scale = QSCALE; }
        else if (pn == 11) { dst = pb.KM; ld = 256; mode = 0; gain = kn_c; rowoff = T; }
        else { dst = pb.VM; ld = 256; rowoff = T; }
        const int row0 = u.pm * BM + wr * 64 + fr - rowoff;
        bf16* base = dst + colbase + wc * 64 + 8 * fq;
        if (mode == 0) {
            f32x4 g[2][2];
#pragma unroll
            for (int bj = 0; bj < 2; ++bj)
#pragma unroll
                for (int n = 0; n < 2; ++n) g[bj][n] = *(const f32x4*)(gain + 32 * bj + 8 * fq + 4 * n) * scale;
#pragma unroll
            for (int ai = 0; ai < 2; ++ai)
#pragma unroll
                for (int m = 0; m < 4; ++m) {
                    float ss = 0.f;
#pragma unroll
                    for (int bj = 0; bj < 2; ++bj)
#pragma unroll
                        for (int n = 0; n < 2; ++n) { const f32x4 v = acc[ai][bj][m][n]; ss += (v.x * v.x + v.y * v.y) + (v.z * v.z + v.w * v.w); }
                    ss += __shfl_xor(ss, 16); ss += __shfl_xor(ss, 32);
                    const float r = 1.f / sqrtf(ss * (1.f / 64.f) + EPS);
                    bf16* rowp = base + (size_t)(row0 + ai * HALF + m * 16) * ld;
#pragma unroll
                    for (int bj = 0; bj < 2; ++bj) { const f32x4 v0 = acc[ai][bj][m][0] * g[bj][0] * r, v1 = acc[ai][bj][m][1] * g[bj][1] * r;
                        u32x4 w; w.x = cvt_pk_bf16(v0.x, v0.y); w.y = cvt_pk_bf16(v0.z, v0.w); w.z = cvt_pk_bf16(v1.x, v1.y); w.w = cvt_pk_bf16(v1.z, v1.w);
                        *(u32x4*)(rowp + 32 * bj) = w; }
                }
        } else if (mode == 1) {
            const float lg1 = log2f(1.f - exp2f(-5.f - (float)wc)); const float lgam = pn == 6 ? lg1 : -lg1;
            float inv[2][4];
#pragma unroll
            for (int n = 0; n < 2; ++n)
#pragma unroll
                for (int i = 0; i < 4; ++i) inv[n][i] = exp2f(-(float)(8 * fq + 4 * n + i) * (13.287712379549449f / 32.f)) * 0.15915494309189535f;
#pragma unroll
            for (int ai = 0; ai < 2; ++ai) {
                int posv[4];
#pragma unroll
                for (int m = 0; m < 4; ++m) posv[m] = positions[row0 + ai * HALF + m * 16];
#pragma unroll
                for (int m = 0; m < 4; ++m) {
                    const int row = row0 + ai * HALF + m * 16; const float pos = (float)posv[m];
                    const float rsc = exp2f((float)(row & 63) * lgam) * scale;
                    f32x4 o0[2], o1[2];
#pragma unroll
                    for (int n = 0; n < 2; ++n)
#pragma unroll
                        for (int i = 0; i < 4; ++i) { float rev = pos * inv[n][i]; rev -= floorf(rev);
                            const float sn = __builtin_amdgcn_sinf(rev), cs = __builtin_amdgcn_cosf(rev);
                            const float t1 = acc[ai][0][m][n][i], t2 = acc[ai][1][m][n][i];
                            o0[n][i] = (t1 * cs - t2 * sn) * rsc; o1[n][i] = (t1 * sn + t2 * cs) * rsc; }
                    bf16* rowp = base + (size_t)row * ld;
                    u32x4 w; w.x = cvt_pk_bf16(o0[0].x, o0[0].y); w.y = cvt_pk_bf16(o0[0].z, o0[0].w); w.z = cvt_pk_bf16(o0[1].x, o0[1].y); w.w = cvt_pk_bf16(o0[1].z, o0[1].w);
                    *(u32x4*)(rowp) = w;
                    w.x = cvt_pk_bf16(o1[0].x, o1[0].y); w.y = cvt_pk_bf16(o1[0].z, o1[0].w); w.z = cvt_pk_bf16(o1[1].x, o1[1].y); w.w = cvt_pk_bf16(o1[1].z, o1[1].w);
                    *(u32x4*)(rowp + 32) = w;
                }
            }
        } else {
#pragma unroll
            for (int ai = 0; ai < 2; ++ai)
#pragma unroll
                for (int m = 0; m < 4; ++m) {
                    bf16* rowp = base + (size_t)(row0 + ai * HALF + m * 16) * ld;
#pragma unroll
                    for (int bj = 0; bj < 2; ++bj) { f32x4 v0 = acc[ai][bj][m][0], v1 = acc[ai][bj][m][1];
                        if (mode == 2) {
#pragma unroll
                            for (int i = 0; i < 4; ++i) { v0[i] = v0[i] / (1.f + __expf(-v0[i])); v1[i] = v1[i] / (1.f + __expf(-v1[i])); } }
                        u32x4 w; w.x = cvt_pk_bf16(v0.x, v0.y); w.y = cvt_pk_bf16(v0.z, v0.w); w.z = cvt_pk_bf16(v1.x, v1.y); w.w = cvt_pk_bf16(v1.z, v1.w);
                        *(u32x4*)(rowp + 32 * bj) = w; }
                }
        }
    }
};
struct EpiOutProj {
    static constexpr int BMAP = 1;
    const float* X; bf16* HB;
    __device__ __forceinline__ void operator()(const f32x4 (&acc)[2][2][4][2], const Unit& u, int wr, int wc, int fr, int fq) const {
        asm volatile("" : "+v"(fr), "+v"(fq));
        const int row0 = u.pm * BM + wr * 64 + fr, col0 = u.pn * BM + wc * 32 + 8 * fq;
#pragma unroll
        for (int ai = 0; ai < 2; ++ai)
#pragma unroll
            for (int m = 0; m < 4; ++m) { const size_t off = (size_t)(row0 + ai * HALF + m * 16) * D + col0;
#pragma unroll
                for (int bj = 0; bj < 2; ++bj) { const f32x4 v0 = *(const f32x4*)(X + off + bj * HALF) + acc[ai][bj][m][0], v1 = *(const f32x4*)(X + off + bj * HALF + 4) + acc[ai][bj][m][1];
                    u32x4 w; w.x = cvt_pk_bf16(v0.x, v0.y); w.y = cvt_pk_bf16(v0.z, v0.w); w.z = cvt_pk_bf16(v1.x, v1.y); w.w = cvt_pk_bf16(v1.z, v1.w);
                    *(u32x4*)(HB + off + bj * HALF) = w; } }
    }
};
struct EpiG1 {
    static constexpr int BMAP = 1;
    bf16* ACT; const float* row_r; const unsigned* cnt;
    __device__ __forceinline__ void operator()(const f32x4 (&acc)[2][2][4][2], const Unit& u, int wr, int wc, int fr, int fq) const {
        asm volatile("" : "+v"(fr), "+v"(fq));
        const int r0 = wr * 64 + fr; const unsigned n = cnt[u.e]; const float* rl = row_r + (size_t)u.e * T + u.rb * 256;
        bf16* base = ACT + (size_t)u.pm * BM * DE + u.pn * 128 + wc * 32 + 8 * fq;
        float rsv[2][4];
#pragma unroll
        for (int ai = 0; ai < 2; ++ai)
#pragma unroll
            for (int m = 0; m < 4; ++m) rsv[ai][m] = rl[r0 + ai * HALF + m * 16];
#pragma unroll
        for (int ai = 0; ai < 2; ++ai)
#pragma unroll
            for (int m = 0; m < 4; ++m) {
                const int r = r0 + ai * HALF + m * 16; const float rs = (unsigned)(u.rb * 256 + r) < n ? rsv[ai][m] : 0.f;
                f32x4 o[2];
#pragma unroll
                for (int nn = 0; nn < 2; ++nn)
#pragma unroll
                    for (int i = 0; i < 4; ++i) { const float g = acc[ai][0][m][nn][i] * rs; o[nn][i] = g / (1.f + __expf(-g)) * (acc[ai][1][m][nn][i] * rs); }
                u32x4 w; w.x = cvt_pk_bf16(o[0].x, o[0].y); w.y = cvt_pk_bf16(o[0].z, o[0].w); w.z = cvt_pk_bf16(o[1].x, o[1].y); w.w = cvt_pk_bf16(o[1].z, o[1].w);
                *(u32x4*)(base + (size_t)r * DE) = w;
            }
    }
};
struct EpiG2 {
    static constexpr int BMAP = 1;
    bf16* YB; const float* row_w; const unsigned* cnt;
    __device__ __forceinline__ void operator()(const f32x4 (&acc)[2][2][4][2], const Unit& u, int wr, int wc, int fr, int fq) const {
        asm volatile("" : "+v"(fr), "+v"(fq));
        const int r0 = wr * 64 + fr; const unsigned n = cnt[u.e]; const float* wl = row_w + (size_t)u.e * T + u.rb * 256;
        bf16* base = YB + (size_t)u.pm * BM * D + u.pn * BM + wc * 32 + 8 * fq;
        float wv[2][4];
#pragma unroll
        for (int ai = 0; ai < 2; ++ai)
#pragma unroll
            for (int m = 0; m < 4; ++m) wv[ai][m] = wl[r0 + ai * HALF + m * 16];
#pragma unroll
        for (int ai = 0; ai < 2; ++ai)
#pragma unroll
            for (int m = 0; m < 4; ++m) {
                const int r = r0 + ai * HALF + m * 16; const float w = (unsigned)(u.rb * 256 + r) < n ? wv[ai][m] : 0.f;
                bf16* rowp = base + (size_t)r * D;
#pragma unroll
                for (int bj = 0; bj < 2; ++bj) { const f32x4 v0 = acc[ai][bj][m][0] * w, v1 = acc[ai][bj][m][1] * w;
                    u32x4 q; q.x = cvt_pk_bf16(v0.x, v0.y); q.y = cvt_pk_bf16(v0.z, v0.w); q.z = cvt_pk_bf16(v1.x, v1.y); q.w = cvt_pk_bf16(v1.z, v1.w);
                    *(u32x4*)(rowp + bj * HALF) = q; }
            }
    }
};
}
namespace att {
typedef float f32x16 __attribute__((ext_vector_type(16)));
typedef float f32x2v __attribute__((ext_vector_type(2)));
typedef __bf16 bf16x2v __attribute__((ext_vector_type(2)));
typedef short s16x4 __attribute__((ext_vector_type(4)));
typedef short v4i16_t __attribute__((ext_vector_type(4)));
using pg8::bf16x8;
#define ATT_LAS __attribute__((address_space(3)))
__device__ __forceinline__ int crow(int r, int hi) { return (r & 3) + 8 * (r >> 2) + 4 * hi; }
__device__ __forceinline__ unsigned cvtpk(float lo, float hi) { f32x2v v = {lo, hi}; bf16x2v b = __builtin_convertvector(v, bf16x2v); return __builtin_bit_cast(unsigned, b); }
__device__ __forceinline__ int koff(int key, int ch) { return key * 128 + 16 * (ch ^ ((key >> 1) & 7)); }
__device__ __forceinline__ int voff(int row, int ch) { return 1024 * (row >> 3) + 512 * (ch >> 2) + 64 * (row & 7) + 16 * ((ch & 3) ^ ((row >> 2) & 3)); }
__device__ __forceinline__ s16x4 vtr(const ATT_LAS unsigned char* p) { return __builtin_bit_cast(s16x4, __builtin_amdgcn_ds_read_tr16_b64_v4i16((ATT_LAS v4i16_t*)p)); }
__device__ __forceinline__ bf16x8 pack8(const f32x16& x, int s) {
    u32x4 p; p.x = cvtpk(x[8 * s], x[8 * s + 1]); p.y = cvtpk(x[8 * s + 2], x[8 * s + 3]); p.z = cvtpk(x[8 * s + 4], x[8 * s + 5]); p.w = cvtpk(x[8 * s + 6], x[8 * s + 7]);
    return __builtin_bit_cast(bf16x8, p);
}
__device__ __forceinline__ void dma_src(int tid, int ld, int& ksrc, int& vsrc) {
    const int sl = tid; const int key = sl >> 3, kch = (sl & 7) ^ ((key >> 1) & 7);
    ksrc = key * ld + kch * 8;
    const int row = 8 * (sl >> 6) + ((sl >> 2) & 7), vch = 4 * ((sl >> 5) & 1) + ((sl & 3) ^ ((row >> 2) & 3));
    vsrc = row * ld + vch * 8;
}

template <int MODE>
__device__ __forceinline__ void attn_unit(ATT_LAS unsigned char* lds, const bf16* Qg, int ldq, const bf16* Kg, const bf16* Vg, int ldkv, bf16* Og, int ldo,
                                          int tile0, int t_first, int t_count, const ATT_LAS float* tbl, float negM0) {
    int tid_ = threadIdx.x; asm volatile("" : "+v"(tid_));
    const int tid = tid_, lane = tid & 63, r32 = lane & 31, hi = lane >> 5; const int wid = __builtin_amdgcn_readfirstlane(tid >> 6);
    int ksrc, vsrc; dma_src(tid, ldkv, ksrc, vsrc);
    const unsigned ldsw = (unsigned)wid * 1024u;
#define ATT_DMA(tt, b) do { __builtin_amdgcn_global_load_lds((const unsigned*)(Kg + (size_t)(tile0 + (tt)) * 64 * ldkv + ksrc), (ATT_LAS unsigned*)(lds + (b) * 16384 + ldsw), 16, 0, 0); \
                            __builtin_amdgcn_global_load_lds((const unsigned*)(Vg + (size_t)(tile0 + (tt)) * 64 * ldkv + vsrc), (ATT_LAS unsigned*)(lds + (b) * 16384 + 8192 + ldsw), 16, 0, 0); } while (0)
    __builtin_amdgcn_s_barrier();
    ATT_DMA(t_first, 0);
    bf16x8 qf[4];
    { const bf16* qp = Qg + (size_t)(wid * 32 + r32) * ldq + hi * 8;
#pragma unroll
      for (int s = 0; s < 4; ++s) qf[s] = *(const bf16x8*)(qp + 16 * s); }
    f32x16 o[2];
#pragma unroll
    for (int r = 0; r < 16; ++r) { o[0][r] = 0.f; o[1][r] = 0.f; }
    float lsum = 0.f;
    const int cql = wid >> 1, iq = 32 * (wid & 1) + r32;
    const int q4 = (lane & 15) >> 2, p4 = lane & 3, blk = (lane >> 4) & 1;
    int kofs[4], vofs[2];
#pragma unroll
    for (int s = 0; s < 4; ++s) kofs[s] = koff(r32, 2 * s + hi);
    vofs[0] = voff(4 * hi + q4, 2 * blk + (p4 >> 1)) + 8 * (p4 & 1); vofs[1] = voff(8 + 4 * hi + q4, 2 * blk + (p4 >> 1)) + 8 * (p4 & 1);
#define ATT_STEP(B, it_) do { const int it = (it_); const int tt = t_first + it; \
        asm volatile("s_waitcnt vmcnt(0)" ::: "memory"); __builtin_amdgcn_s_barrier(); asm volatile("" ::: "memory"); \
        if (it + 1 < t_count) ATT_DMA(tt + 1, 1 - (B)); \
        const int jb = MODE == 0 ? tt - cql : 0; \
        if (MODE == 1 || (jb >= 0 && jb <= 8)) { \
            const ATT_LAS unsigned char* Kt = lds + (B) * 16384; const ATT_LAS unsigned char* Vt = Kt + 8192; \
            f32x16 p0, p1; \
            if (MODE == 0 && jb >= 6) { \
                const int base = (8 - jb) * 64 + iq + 63; \
                _Pragma("unroll") for (int r = 0; r < 16; ++r) { const int kk = crow(r, hi); int i0 = base - kk, i1 = base - kk - 32; i0 = i0 > 191 ? 191 : i0; i1 = i1 > 191 ? 191 : i1; p0[r] = tbl[i0]; p1[r] = tbl[i1]; } \
            } else { \
                _Pragma("unroll") for (int r = 0; r < 16; ++r) { p0[r] = negM0; p1[r] = negM0; } \
            } \
            _Pragma("unroll") for (int s = 0; s < 4; ++s) { \
                const bf16x8 k0 = *(const ATT_LAS bf16x8*)(Kt + kofs[s]), k1 = *(const ATT_LAS bf16x8*)(Kt + 4096 + kofs[s]); \
                p0 = __builtin_amdgcn_mfma_f32_32x32x16_bf16(k0, qf[s], p0, 0, 0, 0); \
                p1 = __builtin_amdgcn_mfma_f32_32x32x16_bf16(k1, qf[s], p1, 0, 0, 0); \
            } \
            float sa = 0.f, sb = 0.f; \
            _Pragma("unroll") for (int r = 0; r < 16; ++r) { p0[r] = __builtin_amdgcn_exp2f(p0[r]); p1[r] = __builtin_amdgcn_exp2f(p1[r]); sa += p0[r]; sb += p1[r]; } \
            lsum += sa + sb; \
            bf16x8 pa[4]; pa[0] = pack8(p0, 0); pa[1] = pack8(p0, 1); pa[2] = pack8(p1, 0); pa[3] = pack8(p1, 1); \
            _Pragma("unroll") for (int c = 0; c < 2; ++c) \
                _Pragma("unroll") for (int s = 0; s < 4; ++s) { \
                    const s16x4 lo = vtr(Vt + vofs[0] + 2048 * s + 512 * c); \
                    const s16x4 hh = vtr(Vt + vofs[1] + 2048 * s + 512 * c); \
                    const bf16x8 vf = {lo[0], lo[1], lo[2], lo[3], hh[0], hh[1], hh[2], hh[3]}; \
                    o[c] = __builtin_amdgcn_mfma_f32_32x32x16_bf16(vf, pa[s], o[c], 0, 0, 0); \
                } \
        } } while (0)
#pragma unroll 1
    for (int it2 = 0; it2 < t_count; it2 += 2) {
        ATT_STEP(0, it2);
        if (it2 + 1 < t_count) ATT_STEP(1, it2 + 1);
    }
#undef ATT_STEP
    lsum += __shfl_xor(lsum, 32);
    const float il = 1.f / lsum;
    bf16* op = Og + (size_t)(wid * 32 + r32) * ldo + 4 * hi;
#pragma unroll
    for (int c = 0; c < 2; ++c)
#pragma unroll
        for (int g = 0; g < 4; ++g) { u32x2 w; w.x = cvtpk(o[c][4 * g] * il, o[c][4 * g + 1] * il); w.y = cvtpk(o[c][4 * g + 2] * il, o[c][4 * g + 3] * il);
            *(u32x2*)(op + 32 * c + 8 * g) = w; }
#undef ATT_DMA
}
}
namespace ret {
using namespace att;
__device__ __forceinline__ void kv_unit(ATT_LAS unsigned char* wl, const bf16* Kc, const bf16* Vc, float* KVo, float g63, int lane) {
    const int r32 = lane & 31, hi = lane >> 5, q4 = (lane & 15) >> 2, p4 = lane & 3, blk = (lane >> 4) & 1;
#pragma unroll
    for (int j = 0; j < 8; ++j) { const int sl = 64 * j + lane; const int row = 8 * (sl >> 6) + ((sl >> 2) & 7), ch = 4 * ((sl >> 5) & 1) + ((sl & 3) ^ ((row >> 2) & 3));
        __builtin_amdgcn_global_load_lds((const unsigned*)(Kc + row * 256 + ch * 8), (ATT_LAS unsigned*)(wl + j * 1024), 16, 0, 0);
        __builtin_amdgcn_global_load_lds((const unsigned*)(Vc + row * 256 + ch * 8), (ATT_LAS unsigned*)(wl + 8192 + j * 1024), 16, 0, 0); }
    asm volatile("s_waitcnt vmcnt(0)" ::: "memory");
    int vofs[2];
    vofs[0] = voff(8 * hi + q4, 2 * blk + (p4 >> 1)) + 8 * (p4 & 1); vofs[1] = voff(8 * hi + 4 + q4, 2 * blk + (p4 >> 1)) + 8 * (p4 & 1);
    f32x16 acc[2][2];
#pragma unroll
    for (int a = 0; a < 2; ++a)
#pragma unroll
        for (int b = 0; b < 2; ++b)
#pragma unroll
            for (int r = 0; r < 16; ++r) acc[a][b][r] = 0.f;
#pragma unroll
    for (int s = 0; s < 4; ++s) {
        bf16x8 vf[2], kf[2];
#pragma unroll
        for (int c = 0; c < 2; ++c) {
            const s16x4 vl = vtr(wl + 8192 + vofs[0] + 2048 * s + 512 * c), vh = vtr(wl + 8192 + vofs[1] + 2048 * s + 512 * c);
            const s16x4 kl = vtr(wl + vofs[0] + 2048 * s + 512 * c), kh = vtr(wl + vofs[1] + 2048 * s + 512 * c);
            vf[c] = (bf16x8){vl[0], vl[1], vl[2], vl[3], vh[0], vh[1], vh[2], vh[3]}; kf[c] = (bf16x8){kl[0], kl[1], kl[2], kl[3], kh[0], kh[1], kh[2], kh[3]};
        }
#pragma unroll
        for (int eb = 0; eb < 2; ++eb)
#pragma unroll
            for (int db = 0; db < 2; ++db) acc[eb][db] = __builtin_amdgcn_mfma_f32_32x32x16_bf16(vf[eb], kf[db], acc[eb][db], 0, 0, 0);
    }
#pragma unroll
    for (int eb = 0; eb < 2; ++eb)
#pragma unroll
        for (int db = 0; db < 2; ++db)
#pragma unroll
            for (int r = 0; r < 16; ++r) KVo[(32 * eb + crow(r, hi)) * 64 + 32 * db + r32] = acc[eb][db][r] * g63;
    asm volatile("s_waitcnt lgkmcnt(0)" ::: "memory");
}

__device__ __forceinline__ void ret_unit(ATT_LAS unsigned char* lds, const bf16* Qg, const bf16* Kg, const bf16* Vg, const bf16* Gg, const bf16* STg, const float* gn, bf16* Og) {
    int tid_ = threadIdx.x; asm volatile("" : "+v"(tid_));
    const int tid = tid_, lane = tid & 63, r32 = lane & 31, hi = lane >> 5; const int wid = __builtin_amdgcn_readfirstlane(tid >> 6);
    const int cl = wid >> 1, qh = wid & 1;
    int ksrc, vsrc; dma_src(tid, 256, ksrc, vsrc);
    const unsigned ldsw = (unsigned)wid * 1024u;
    __builtin_amdgcn_s_barrier();
#pragma unroll
    for (int c4 = 0; c4 < 4; ++c4) {
        __builtin_amdgcn_global_load_lds((const unsigned*)(Kg + (size_t)c4 * 64 * 256 + ksrc), (ATT_LAS unsigned*)(lds + c4 * 8192 + ldsw), 16, 0, 0);
        __builtin_amdgcn_global_load_lds((const unsigned*)(Vg + (size_t)c4 * 64 * 256 + vsrc), (ATT_LAS unsigned*)(lds + 32768 + c4 * 8192 + ldsw), 16, 0, 0); }
    const int qrow = cl * 64 + qh * 32 + r32;
    bf16x8 qf[4];
    { const bf16* qp = Qg + (size_t)qrow * 256 + hi * 8;
#pragma unroll
      for (int s = 0; s < 4; ++s) qf[s] = *(const bf16x8*)(qp + 16 * s); }
    bf16x8 sf[2][4];
    { const bf16* sp = STg + (size_t)cl * 4096 + r32 * 64 + hi * 8;
#pragma unroll
      for (int c = 0; c < 2; ++c)
#pragma unroll
          for (int s = 0; s < 4; ++s) sf[c][s] = *(const bf16x8*)(sp + c * 2048 + 16 * s); }
    const int q4 = (lane & 15) >> 2, p4 = lane & 3, blk = (lane >> 4) & 1;
    int kofs[4], vofs[2];
#pragma unroll
    for (int s = 0; s < 4; ++s) kofs[s] = koff(r32, 2 * s + hi);
    vofs[0] = voff(4 * hi + q4, 2 * blk + (p4 >> 1)) + 8 * (p4 & 1); vofs[1] = voff(8 + 4 * hi + q4, 2 * blk + (p4 >> 1)) + 8 * (p4 & 1);
    asm volatile("s_waitcnt vmcnt(0)" ::: "memory"); __builtin_amdgcn_s_barrier(); asm volatile("" ::: "memory");
    const ATT_LAS unsigned char* Kt = lds + cl * 8192; const ATT_LAS unsigned char* Vt = lds + 32768 + cl * 8192;
    f32x16 p0, p1, o[2];
#pragma unroll
    for (int r = 0; r < 16; ++r) { p0[r] = 0.f; p1[r] = 0.f; o[0][r] = 0.f; o[1][r] = 0.f; }
#pragma unroll
    for (int c = 0; c < 2; ++c)
#pragma unroll
        for (int s = 0; s < 4; ++s) o[c] = __builtin_amdgcn_mfma_f32_32x32x16_bf16(sf[c][s], qf[s], o[c], 0, 0, 0);
#pragma unroll
    for (int s = 0; s < 4; ++s) p0 = __builtin_amdgcn_mfma_f32_32x32x16_bf16(*(const ATT_LAS bf16x8*)(Kt + kofs[s]), qf[s], p0, 0, 0, 0);
    if (qh) {
#pragma unroll
        for (int s = 0; s < 4; ++s) p1 = __builtin_amdgcn_mfma_f32_32x32x16_bf16(*(const ATT_LAS bf16x8*)(Kt + 4096 + kofs[s]), qf[s], p1, 0, 0, 0);
#pragma unroll
        for (int r = 0; r < 16; ++r) p1[r] = crow(r, hi) <= r32 ? p1[r] : 0.f;
    } else {
#pragma unroll
        for (int r = 0; r < 16; ++r) p0[r] = crow(r, hi) <= r32 ? p0[r] : 0.f;
    }
    {
        bf16x8 pa[4]; pa[0] = pack8(p0, 0); pa[1] = pack8(p0, 1); pa[2] = pack8(p1, 0); pa[3] = pack8(p1, 1);
#pragma unroll
        for (int c = 0; c < 2; ++c)
#pragma unroll
            for (int s = 0; s < 4; ++s) {
                if (s < 2 || qh) {
                    const s16x4 lo = vtr(Vt + vofs[0] + 2048 * s + 512 * c), hh = vtr(Vt + vofs[1] + 2048 * s + 512 * c);
                    const bf16x8 vf = {lo[0], lo[1], lo[2], lo[3], hh[0], hh[1], hh[2], hh[3]};
                    o[c] = __builtin_amdgcn_mfma_f32_32x32x16_bf16(vf, pa[s], o[c], 0, 0, 0);
                }
            }
    }
    float sm = 0.f;
#pragma unroll
    for (int r = 0; r < 16; ++r) sm += o[0][r] + o[1][r];
    sm += __shfl_xor(sm, 32);
    const float mu = sm * (1.f / 64.f);
    float sv = 0.f;
#pragma unroll
    for (int r = 0; r < 16; ++r) { const float a = o[0][r] - mu, b = o[1][r] - mu; sv += a * a + b * b; }
    sv += __shfl_xor(sv, 32);
    const float rs = 1.f / sqrtf(sv * (1.f / 64.f) + EPS);
    const bf16* gp = Gg + (size_t)qrow * 256 + 4 * hi; bf16* op = Og + (size_t)qrow * D + 4 * hi;
#pragma unroll
    for (int c = 0; c < 2; ++c)
#pragma unroll
        for (int g = 0; g < 4; ++g) {
            const f32x4 gv = *(const f32x4*)(gn + 32 * c + 8 * g + 4 * hi); const u32x2 gb = *(const u32x2*)(gp + 32 * c + 8 * g);
            const float y0 = (o[c][4 * g] - mu) * rs * gv.x * __uint_as_float(gb.x << 16), y1 = (o[c][4 * g + 1] - mu) * rs * gv.y * __uint_as_float(gb.x & 0xffff0000u);
            const float y2 = (o[c][4 * g + 2] - mu) * rs * gv.z * __uint_as_float(gb.y << 16), y3 = (o[c][4 * g + 3] - mu) * rs * gv.w * __uint_as_float(gb.y & 0xffff0000u);
            u32x2 w; w.x = cvtpk(y0, y1); w.y = cvtpk(y2, y3);
            *(u32x2*)(op + 32 * c + 8 * g) = w;
        }
}
}
constexpr int NWAVES = 8;
constexpr int RING_OFF = 0, RING_BYTES = 131072, SCRATCH_BYTES = 147456;
constexpr int GSPILL_OFF = SCRATCH_BYTES;
constexpr int MOE_OFF = GSPILL_OFF + 8192;
constexpr int MISC_OFF = MOE_OFF + 2048;
constexpr int LDS_BYTES = 163840;
static_assert(MISC_OFF + 512 <= LDS_BYTES, "LDS map");
constexpr int CW_BAR = 4096;

#define GAS __attribute__((address_space(1)))
#define LAS __attribute__((address_space(3)))
#define XB_TMO      128
#define XB_XCNT(j)  (256  + 64 * (j))
#define XB_XSUB(j)  (1280 + 64 * (j))
#define XB_XGEN(j)  (2304 + 64 * (j))
#define XB_TOP      3328
#define XB_TOPGEN   3392
#define XCD_BAR_WORDS 3456
#define XB_SPIN_CAP (1u << 18)
__device__ __forceinline__ unsigned xb_ld(unsigned* p)              { return __hip_atomic_load(p, __ATOMIC_RELAXED, __HIP_MEMORY_SCOPE_AGENT); }
__device__ __forceinline__ unsigned xb_add(unsigned* p, unsigned v) { return __hip_atomic_fetch_add(p, v, __ATOMIC_RELAXED, __HIP_MEMORY_SCOPE_AGENT); }
__device__ __forceinline__ unsigned xb_xcc_id() { return (unsigned)__builtin_amdgcn_s_getreg((3 << 11) | 20) & 0xFu; }
#define XB_SPIN(cond, bar) do { unsigned _sp = 0; while (cond) { __builtin_amdgcn_s_sleep(1); \
    if ((++_sp & 255u) == 0u) { if (xb_ld(&(bar)[XB_TMO])) break; if (_sp > XB_SPIN_CAP) { atomicAdd(&(bar)[XB_TMO], 1u); break; } } } } while (0)
struct XcdBarrier { unsigned* bar; unsigned x; volatile LAS unsigned* st; };
__device__ __forceinline__ XcdBarrier xcd_barrier_post(unsigned* bar, volatile LAS unsigned* st) {
    XcdBarrier b; b.bar = bar; b.x = xb_xcc_id(); b.st = st;
    if (threadIdx.x == 0) (void)xb_add(&bar[XB_XCNT(b.x)], 1u);
    return b;
}
__device__ __forceinline__ void xcd_barrier_complete(unsigned* bar, unsigned x, unsigned& nloc, unsigned& nx) {
    const unsigned G = gridDim.x * gridDim.y * gridDim.z;
    unsigned sum, cnt, mine, sp = 0u;
    for (;;) {
        sum = 0u; cnt = 0u; mine = 0u;
#pragma unroll
        for (unsigned j = 0; j < 16; ++j) { const unsigned c = xb_ld(&bar[XB_XCNT(j)]); sum += c; cnt += (c > 0u) ? 1u : 0u; mine = (j == x) ? c : mine; }
        if (sum == G) break;
        __builtin_amdgcn_s_sleep(1);
        if ((++sp & 255u) == 0u) { if (xb_ld(&bar[XB_TMO])) break; if (sp > XB_SPIN_CAP) { atomicAdd(&bar[XB_TMO], 1u); break; } }
    }
    nloc = mine > 0u ? mine : 1u; nx = cnt > 0u ? cnt : 1u;
}
__device__ __forceinline__ void xcd_barrier(const XcdBarrier& b) {
    asm volatile("s_waitcnt vmcnt(0)" ::: "memory");
    __syncthreads();
    if (threadIdx.x == 0) {
        unsigned* bar = b.bar;
        __builtin_amdgcn_s_waitcnt(0);
        unsigned nloc = b.st[0], nx = b.st[1];
        if (nloc == 0u) { xcd_barrier_complete(bar, b.x, nloc, nx); b.st[0] = nloc; b.st[1] = nx; }
        const unsigned old = xb_add(&bar[XB_XSUB(b.x)], 1u);
        const unsigned gen = old / nloc;
        if (old + 1u == (gen + 1u) * nloc) {
            __builtin_amdgcn_fence(__ATOMIC_RELEASE, "agent");
            asm volatile("s_waitcnt vmcnt(0)" ::: "memory");
            const unsigned og = xb_add(&bar[XB_TOP], 1u);
            const unsigned tg = og / nx;
            if (og + 1u == (tg + 1u) * nx) xb_add(&bar[XB_TOPGEN], 1u);
            else XB_SPIN(xb_ld(&bar[XB_TOPGEN]) == tg, bar);
            __builtin_amdgcn_fence(__ATOMIC_ACQUIRE, "agent");
            xb_add(&bar[XB_XGEN(b.x)], 1u);
            asm volatile("s_waitcnt vmcnt(0)" ::: "memory");
        } else {
            XB_SPIN(xb_ld(&bar[XB_XGEN(b.x)]) == gen, bar);
            __builtin_amdgcn_fence(__ATOMIC_ACQUIRE, "agent");
            asm volatile("s_waitcnt vmcnt(0)" ::: "memory");
        }
    }
    __syncthreads();
}

__device__ __forceinline__ void transpose_item_l(const float* W, int K, int N, bf16* WT, int row_off, LAS float* scr, int item, int lane, const float* kscale = nullptr) {
    const int nblk = N / 32, kb = item / nblk, nb = item % nblk, k0 = 64 * kb, n0 = 32 * nb;
#pragma unroll 8
    for (int i = 0; i < 32; ++i) { const int kk = 2 * i + (lane >> 5); scr[kk * 33 + (lane & 31)] = W[(size_t)(k0 + kk) * N + n0 + (lane & 31)]; }
    const int c = lane & 7;
    f32x4 s0 = (f32x4){1.f, 1.f, 1.f, 1.f}, s1 = s0;
    if (kscale) { s0 = *(const f32x4*)(kscale + k0 + 8 * c); s1 = *(const f32x4*)(kscale + k0 + 8 * c + 4); }
    asm volatile("s_waitcnt lgkmcnt(0)" ::: "memory");
#pragma unroll
    for (int j = 0; j < 4; ++j) { const int n = (lane >> 3) + 8 * j; const LAS float* s = scr + (8 * c) * 33 + n;
        u32x4 o; o.x = pk2(s[0 * 33] * s0.x, s[1 * 33] * s0.y); o.y = pk2(s[2 * 33] * s0.z, s[3 * 33] * s0.w); o.z = pk2(s[4 * 33] * s1.x, s[5 * 33] * s1.y); o.w = pk2(s[6 * 33] * s1.z, s[7 * 33] * s1.w);
        *(u32x4*)(WT + (size_t)(row_off + n0 + n) * K + k0 + 8 * c) = o; }
    asm volatile("s_waitcnt lgkmcnt(0)" ::: "memory");
}

struct Args { const void* in[22]; float* out; unsigned char* ws; int ph_lo, ph_hi, li, pad; };

__global__ void __launch_bounds__(NWAVES * 64, 2) mk_fwd(Args args) {
    extern __shared__ __attribute__((aligned(16))) unsigned char lds_raw[];
    LAS unsigned char* lds = (LAS unsigned char*)lds_raw;
    volatile LAS unsigned* MISC = (volatile LAS unsigned*)(lds + MISC_OFF);
    LAS unsigned* gspill = (LAS unsigned*)(lds + GSPILL_OFF);
#define PHASE_IDS() int tid_ = threadIdx.x; asm volatile("" : "+v"(tid_)); const int tid = tid_, lane = tid & 63, wave = __builtin_amdgcn_readfirstlane(tid >> 6); (void)lane; (void)wave
    const int G = gridDim.x, bx = blockIdx.x;
    unsigned char* ws = args.ws;
    unsigned* ctl = (unsigned*)(ws + WS_CTL);
    const float* x = (const float*)args.in[0]; const float* mem = (const float*)args.in[1]; const int* positions = (const int*)args.in[2];
    const float* g_mix = (const float*)args.in[3]; const float* w_in = (const float*)args.in[4]; const float* qn_a = (const float*)args.in[5]; const float* kn_a = (const float*)args.in[6];
    const float* g_mem = (const float*)args.in[9]; const float* w_mem_kv = (const float*)args.in[10];
    const float* qn_c = (const float*)args.in[11]; const float* kn_c = (const float*)args.in[12]; const float* w_out = (const float*)args.in[13];
    const float* w_gate = (const float*)args.in[19]; const float* w_up = (const float*)args.in[20]; const float* w_down = (const float*)args.in[21];
    float* out = args.out;
    PB pb; pb.QA = (bf16*)(ws + WS_QA); pb.KA = (bf16*)(ws + WS_KA); pb.VA = (bf16*)(ws + WS_VA); pb.QB = (bf16*)(ws + WS_QB); pb.KB = (bf16*)(ws + WS_KB);
    pb.VB = (bf16*)(ws + WS_VB); pb.GB = (bf16*)(ws + WS_GB); pb.QC = (bf16*)(ws + WS_QC); pb.KM = (bf16*)(ws + WS_KM); pb.VM = (bf16*)(ws + WS_VM);
    bf16* XN = (bf16*)(ws + WS_XN); bf16* WinT = (bf16*)(ws + WS_WINT); bf16* WoutT = (bf16*)(ws + WS_WOUTT); bf16* WguT = (bf16*)(ws + WS_WGUT); bf16* WdT = (bf16*)(ws + WS_WDT);
    bf16* CAT = (bf16*)(ws + WS_CAT);

    { PHASE_IDS(); for (int u = tid; u < 128; u += NWAVES * 64) MISC[u] = 0u; }
    __syncthreads();
    XcdBarrier bar = xcd_barrier_post(ctl + CW_BAR + args.li * XCD_BAR_WORDS, MISC + 8);
    const int lo = args.ph_lo, hi = args.ph_hi;
#define IN(k) (lo <= (k) && (k) < hi)
#define BOTH(k) (IN(k) && IN((k) + 1))

    if (IN(0)) {
        PHASE_IDS();
        LAS float* scr = (LAS float*)(lds + RING_OFF + wave * 16384); const float* g_ffn0 = (const float*)args.in[14];
        const int gw = bx * NWAVES + wave, NGW = G * NWAVES;
        constexpr int I_IN = 16 * 88, I_KV = 16 * 16, I_O = 16 * 32, I_E = 256;
        constexpr int NITEMS = I_IN + I_KV + I_O + NE * 3 * I_E;
        for (int it = gw; it < NITEMS; it += NGW) {
            int r = it;
            if (r < I_IN) { transpose_item_l(w_in, D, INCOLS, WinT, 0, scr, r, lane); continue; } r -= I_IN;
            if (r < I_KV) { transpose_item_l(w_mem_kv, D, KVCOLS, WinT, INCOLS, scr, r, lane); continue; } r -= I_KV;
            if (r < I_O) { transpose_item_l(w_out, D, D, WoutT, 0, scr, r, lane); continue; } r -= I_O;
            const int e = r / (3 * I_E), q = r % (3 * I_E);
            if (q < I_E) transpose_item_l(w_gate + (size_t)e * D * DE, D, DE, WguT + (size_t)e * D * D, 0, scr, q, lane, g_ffn0);
            else if (q < 2 * I_E) transpose_item_l(w_up + (size_t)e * D * DE, D, DE, WguT + (size_t)e * D * D, DE, scr, q - I_E, lane, g_ffn0);
            else transpose_item_l(w_down + (size_t)e * DE * D, DE, D, WdT + (size_t)e * D * DE, 0, scr, q - 2 * I_E, lane);
        }
        for (int m = gw; m < T + MEMROWS; m += NGW) {
            if (m < T) rms_row_to_bf16(x + (size_t)m * D, g_mix, XN + (size_t)m * D, lane);
            else rms_row_to_bf16(mem + (size_t)(m - T) * D, g_mem, XN + (size_t)m * D, lane);
        }
        if (BOTH(0)) xcd_barrier(bar);
    }
    if (IN(1)) {
        pg8::ProjOrder S{G, bx, (const char*)XN, (const char*)WinT};
        pg8::EpiProj E{pb, positions, qn_a, kn_a, qn_c, kn_c};
        pg8::gemm_phase<pg8::EpiProj, pg8::ProjOrder, true, false>(lds + RING_OFF, D, 128u * 2048u, 32u * 2048u, gspill, S, E);
        if (BOTH(1)) xcd_barrier(bar);
    }
    if (IN(2)) {
        PHASE_IDS();
        float* KV = (float*)(ws + WS_RKV);
        for (int u = bx * NWAVES + wave; u < NBATCH * BH * NCHUNK; u += G * NWAVES) {
            const int bh = u >> 7, c = u & 127, b = bh >> 2, h = bh & 3; const size_t r0 = (size_t)b * SEQ + (size_t)c * 64;
            const float g63 = exp2f(63.f * log2f(1.f - exp2f(-5.f - (float)h)));
            ret::kv_unit(lds + wave * 16384, pb.KB + r0 * 256 + h * 64, pb.VB + r0 * 256 + h * 64, KV + (size_t)u * 4096, g63, lane);
        }
        if (BOTH(2)) xcd_barrier(bar);
    }
    if (IN(3)) {
        PHASE_IDS();
        const float* KV = (const float*)(ws + WS_RKV); bf16* ST = (bf16*)(ws + WS_ST);
        for (int p = bx * NWAVES + wave; p < 2048; p += G * NWAVES) {
            const int hf = lane >> 5, el = p * 32 + (lane & 31), bh = el >> 12, ed = el & 4095, h = bh & 3;
            const float gam = 1.f - exp2f(-5.f - (float)h), g64 = exp2f(64.f * log2f(gam));
            const float* src = KV + (size_t)(bh * 128 + hf * 64) * 4096 + ed;
            float kv[64];
#pragma unroll
            for (int j = 0; j < 64; ++j) kv[j] = src[(size_t)j * 4096];
            float L = 0.f;
#pragma unroll
            for (int j = 0; j < 64; ++j) L = g64 * L + kv[j];
            const float S64 = __shfl(L, lane & 31);
            float st = hf ? S64 : 0.f;
            bf16* dst = ST + (size_t)(bh * 128 + hf * 64) * 4096 + ed;
#pragma unroll
            for (int j = 0; j < 64; ++j) { dst[(size_t)j * 4096] = f2bf(gam * st); st = g64 * st + kv[j]; }
        }
        if (BOTH(3)) xcd_barrier(bar);
    }
    if (IN(4)) {
        PHASE_IDS();
        const float* rel_bias = (const float*)args.in[7]; const float* ret_gn_g = (const float*)args.in[8];
        LAS float* tbl = (LAS float*)(lds + 65536); LAS float* mvals = tbl + 8 * 192;
        {
            const int l4 = tid & 63;
            float gq = fabsf(qn_a[l4]), gk = fabsf(kn_a[l4]), cq = fabsf(qn_c[l4]), ck = fabsf(kn_c[l4]);
            float mb = -3.0e38f;
            for (int i = l4; i < 192; i += 64) mb = fmaxf(mb, rel_bias[wave * 192 + i]);
#pragma unroll
            for (int o = 1; o < 64; o <<= 1) { gq = fmaxf(gq, __shfl_xor(gq, o)); gk = fmaxf(gk, __shfl_xor(gk, o)); cq = fmaxf(cq, __shfl_xor(cq, o)); ck = fmaxf(ck, __shfl_xor(ck, o)); mb = fmaxf(mb, __shfl_xor(mb, o)); }
            const float M0 = 8.f * LOG2E * gq * gk + fmaxf(mb, 0.f) * LOG2E + 1.f;
            for (int i = l4; i < 192; i += 64) tbl[wave * 192 + i] = rel_bias[wave * 192 + i] * LOG2E - M0;
            if (tid == 0) mvals[0] = -(8.f * LOG2E * cq * ck + 1.f);
        }
        __syncthreads();
        const float negM0c = mvals[0];
        for (int u = bx; u < NBATCH * AH * 32; u += G) {
            const int b = u >> 8, h = (u >> 5) & 7, g = u & 31;
            const int t_first = 8 - 4 * g > 0 ? 8 - 4 * g : 0;
            const size_t q0 = (size_t)b * SEQ + (size_t)g * 256, s0 = (size_t)b * SEQ;
            att::attn_unit<0>(lds, pb.QA + q0 * 512 + h * 64, 512, pb.KA + s0 * 512 + h * 64, pb.VA + s0 * 512 + h * 64, 512, CAT + q0 * D + h * 64, D,
                              4 * g - 8, t_first, 12 - t_first, tbl + h * 192, tbl[h * 192 + 191]);
        }
        for (int u = bx; u < NBATCH * BH * 32; u += G) {
            const int b = u >> 7, h = (u >> 5) & 3, g = u & 31;
            const size_t r0 = (size_t)b * SEQ + (size_t)g * 256;
            ret::ret_unit(lds, pb.QB + r0 * 256 + h * 64, pb.KB + r0 * 256 + h * 64, pb.VB + r0 * 256 + h * 64, pb.GB + r0 * 256 + h * 64,
                          (const bf16*)(ws + WS_ST) + (size_t)((b * 4 + h) * 128 + 4 * g) * 4096, ret_gn_g + h * 64, CAT + r0 * D + 512 + h * 64);
        }
        for (int u = bx; u < NBATCH * CH * 32; u += G) {
            const int b = u >> 7, h = (u >> 5) & 3, g = u & 31;
            const size_t q0 = (size_t)b * SEQ + (size_t)g * 256, m0 = (size_t)b * NMEM;
            att::attn_unit<1>(lds, pb.QC + q0 * 256 + h * 64, 256, pb.KM + m0 * 256 + h * 64, pb.VM + m0 * 256 + h * 64, 256, CAT + q0 * D + 768 + h * 64, D,
                              0, 0, 4, tbl, negM0c);
        }
        if (BOTH(4)) xcd_barrier(bar);
    }
    if (IN(5)) {
        pg8::PlainOrder S{G, bx, T / 256, D / 256, (const char*)CAT, (const char*)WoutT, 2048};
        pg8::EpiOutProj E{x, (bf16*)(ws + WS_HB)};
        pg8::gemm_phase<pg8::EpiOutProj, pg8::PlainOrder, true, false>(lds + RING_OFF, D, 128u * 2048u, 128u * 2048u, gspill, S, E);
        if (BOTH(5)) xcd_barrier(bar);
    }
    if (IN(6)) {
        PHASE_IDS();
        const float* g_ffn = (const float*)args.in[14]; const float* w_rg = (const float*)args.in[15]; const float* b_rg = (const float*)args.in[16];
        const float* w_re = (const float*)args.in[17]; const float* b_re = (const float*)args.in[18];
        const bf16* HB = (const bf16*)(ws + WS_HB); unsigned* cnt = ctl + CW_CNT;
        int* row_tok = (int*)(ws + WS_ROWTOK); float* row_w = (float*)(ws + WS_ROWW); float* row_r = (float*)(ws + WS_ROWR); int* toktab = (int*)(ws + WS_TOKTAB);
        constexpr int IMG_LO = 36864, LG_OFF = 73728, TAB_OFF = LG_OFF + 8 * 2304;
        LAS int* tokE = (LAS int*)(lds + TAB_OFF); LAS float* tokW = (LAS float*)(lds + TAB_OFF + 1024); LAS int* tokR = (LAS int*)(lds + TAB_OFF + 2048);
        LAS float* tokN = (LAS float*)(lds + TAB_OFF + 3072); LAS unsigned* hist = (LAS unsigned*)(lds + TAB_OFF + 3584); LAS unsigned* ebase = hist + 32;
        const int r16 = lane & 15, kq = lane >> 4;
        for (int unit = bx; unit < T / 128; unit += G) {
            const int tok0 = unit * 128 + wave * 16;
            const bf16* hrow = HB + (size_t)(tok0 + r16) * D + 8 * kq;
            f32x4 acc[3]; acc[0] = (f32x4){0.f, 0.f, 0.f, 0.f}; acc[1] = acc[0]; acc[2] = acc[0];
            float ss = 0.f;
            if (tid < 64) hist[tid] = 0u;
            for (int kh = 0; kh < 2; ++kh) {
                pg8::bf16x8 av[16];
#pragma unroll
                for (int s = 0; s < 16; ++s) av[s] = *(const pg8::bf16x8*)(hrow + kh * 512 + 32 * s);
                __syncthreads();
                for (int idx = tid; idx < 36 * 512; idx += NWAVES * 64) {
                    const int n = idx >> 9, kk = idx & 511, k = kh * 512 + kk;
                    const float v = g_ffn[k] * (n < 4 ? w_rg[k * 4 + n] : w_re[k * 32 + (n - 4)]);
                    const bf16 vh = f2bf(v), vl = f2bf(v - bf2f(vh));
                    const int addr = n * 1024 + ((((kk >> 3) ^ (n & 15))) << 4) + (kk & 7) * 2;
                    *(LAS bf16*)(lds + addr) = vh; *(LAS bf16*)(lds + IMG_LO + addr) = vl;
                }
                __syncthreads();
#pragma unroll
                for (int s = 0; s < 16; ++s) {
#pragma unroll
                    for (int j = 0; j < 8; ++j) { const float f = __uint_as_float(((unsigned)(unsigned short)av[s][j]) << 16); ss += f * f; }
#pragma unroll
                    for (int nb = 0; nb < 3; ++nb) {
                        int n = 16 * nb + r16; n = n > 35 ? 35 : n;
                        const int addr = n * 1024 + (((4 * s + kq) ^ (n & 15)) << 4);
                        const pg8::bf16x8 bh = *(const LAS pg8::bf16x8*)(lds + addr), bl = *(const LAS pg8::bf16x8*)(lds + IMG_LO + addr);
                        acc[nb] = __builtin_amdgcn_mfma_f32_16x16x32_bf16(av[s], bh, acc[nb], 0, 0, 0);
                        acc[nb] = __builtin_amdgcn_mfma_f32_16x16x32_bf16(av[s], bl, acc[nb], 0, 0, 0);
                    }
                }
            }
            ss += __shfl_xor(ss, 16); ss += __shfl_xor(ss, 32);
            const float rr = 1.f / sqrtf(ss * (1.f / D) + EPS);
            LAS float* LG = (LAS float*)(lds + LG_OFF + wave * 2304);
#pragma unroll
            for (int i = 0; i < 4; ++i) { const float ri = __shfl(rr, 4 * kq + i);
#pragma unroll
                for (int nb = 0; nb < 3; ++nb) { const int n = 16 * nb + r16; if (n < 36) LG[(4 * kq + i) * 36 + n] = acc[nb][i] * ri; } }
            asm volatile("s_waitcnt lgkmcnt(0)" ::: "memory");
            if (lane < 16) {
                const LAS float* lg = LG + lane * 36;
                float gl[4];
#pragma unroll
                for (int g = 0; g < 4; ++g) gl[g] = lg[g] + b_rg[g];
                int gs = 0; float gm = gl[0];
#pragma unroll
                for (int g = 1; g < 4; ++g) if (gl[g] > gm) { gm = gl[g]; gs = g; }
                float gsum = 0.f;
#pragma unroll
                for (int g = 0; g < 4; ++g) gsum += __expf(gl[g] - gm);
                const float pg = 1.f / gsum;
                float el[8];
#pragma unroll
                for (int i = 0; i < 8; ++i) el[i] = lg[4 + gs * 8 + i] + b_re[gs * 8 + i];
                int i0 = 0; float m0 = el[0];
#pragma unroll
                for (int i = 1; i < 8; ++i) if (el[i] > m0) { m0 = el[i]; i0 = i; }
                int i1 = -1; float m1 = -3.0e38f;
#pragma unroll
                for (int i = 0; i < 8; ++i) if (i != i0 && el[i] > m1) { m1 = el[i]; i1 = i; }
                const float p1 = __expf(m1 - m0);
                const int tl = wave * 16 + lane;
                tokE[tl * 2] = gs * 8 + i0; tokE[tl * 2 + 1] = gs * 8 + i1; tokW[tl * 2] = pg / (1.f + p1); tokW[tl * 2 + 1] = pg * p1 / (1.f + p1); tokN[tl] = rr;
            }
            __syncthreads();
            if (tid < 128) { tokR[tid * 2] = (int)__hip_atomic_fetch_add(hist + tokE[tid * 2], 1u, __ATOMIC_RELAXED, __HIP_MEMORY_SCOPE_WORKGROUP);
                             tokR[tid * 2 + 1] = (int)__hip_atomic_fetch_add(hist + tokE[tid * 2 + 1], 1u, __ATOMIC_RELAXED, __HIP_MEMORY_SCOPE_WORKGROUP); }
            __syncthreads();
            if (tid < 32) { const unsigned hc = hist[tid]; ebase[tid] = hc ? atomicAdd(cnt + tid, hc) : 0u; }
            __syncthreads();
            if (tid < 128) {
                const int tok = unit * 128 + tid; const float rn = tokN[tid];
                const int e0 = tokE[tid * 2], e1 = tokE[tid * 2 + 1]; const int s0 = (int)ebase[e0] + tokR[tid * 2], s1 = (int)ebase[e1] + tokR[tid * 2 + 1];
                row_tok[(size_t)e0 * T + s0] = tok; row_w[(size_t)e0 * T + s0] = tokW[tid * 2]; row_r[(size_t)e0 * T + s0] = rn;
                row_tok[(size_t)e1 * T + s1] = tok; row_w[(size_t)e1 * T + s1] = tokW[tid * 2 + 1]; row_r[(size_t)e1 * T + s1] = rn;
                *(int4*)(toktab + tok * 4) = make_int4(e0, s0, e1, s1);
            }
        }
        if (BOTH(6)) xcd_barrier(bar);
    }
    LAS int* blkstart = (LAS int*)(lds + MOE_OFF); LAS int* blk2e = blkstart + 40;
    if (IN(7) || IN(8) || IN(9)) {
        PHASE_IDS();
        const unsigned* cnt = ctl + CW_CNT;
        if (tid == 0) { int s = 0; for (int e = 0; e < NE; ++e) { blkstart[e] = s; s += (int)((cnt[e] + 255u) >> 8); } blkstart[NE] = s; }
        __syncthreads();
        const int nb = blkstart[NE];
        for (int b = tid; b < nb; b += NWAVES * 64) { int e = 0; while (blkstart[e + 1] <= b) ++e; blk2e[b] = e; }
        __syncthreads();
    }
    if (IN(7)) {
        pg8::MoeOrder S{G, bx, blkstart[NE] * 4, blkstart, blk2e, (const char*)(ws + WS_HB), 0, (const char*)WguT, (size_t)D * D * 2, (size_t)128 * 2048, (const int*)(ws + WS_ROWTOK), ctl + CW_CNT};
        pg8::EpiG1 E{(bf16*)(ws + WS_ACT), (const float*)(ws + WS_ROWR), ctl + CW_CNT};
        pg8::gemm_phase<pg8::EpiG1, pg8::MoeOrder, true, true>(lds + RING_OFF, D, 0u, 512u * 2048u, gspill, S, E);
        if (BOTH(7)) xcd_barrier(bar);
    }
    if (IN(8)) {
        pg8::MoeOrder S{G, bx, blkstart[NE] * 4, blkstart, blk2e, (const char*)(ws + WS_ACT), (size_t)256 * 1024, (const char*)WdT, (size_t)D * DE * 2, (size_t)256 * 1024, (const int*)(ws + WS_ROWTOK), ctl + CW_CNT};
        pg8::EpiG2 E{(bf16*)(ws + WS_YB), (const float*)(ws + WS_ROWW), ctl + CW_CNT};
        pg8::gemm_phase<pg8::EpiG2, pg8::MoeOrder, true, false>(lds + RING_OFF, DE, 128u * 1024u, 128u * 1024u, gspill, S, E);
        if (BOTH(8)) xcd_barrier(bar);
    }
    if (IN(9)) {
        PHASE_IDS();
        const bf16* YB = (const bf16*)(ws + WS_YB); const bf16* HB = (const bf16*)(ws + WS_HB); const int* toktab = (const int*)(ws + WS_TOKTAB);
        for (int tb = (bx * NWAVES + wave) * 4; tb < T; tb += G * NWAVES * 4) {
            int4 tt[4];
#pragma unroll
            for (int k = 0; k < 4; ++k) tt[k] = *(const int4*)(toktab + (tb + k) * 4);
#pragma unroll
            for (int k = 0; k < 4; ++k) {
                const int tok = tb + k;
                const size_t p0 = (size_t)blkstart[tt[k].x] * 256 + tt[k].y, p1 = (size_t)blkstart[tt[k].z] * 256 + tt[k].w;
                f32x4* orow = (f32x4*)(out + (size_t)tok * D) + lane; const u32x2* hr = (const u32x2*)(HB + (size_t)tok * D) + lane;
                const u32x2* y0 = (const u32x2*)(YB + p0 * D) + lane; const u32x2* y1 = (const u32x2*)(YB + p1 * D) + lane;
                u32x2 hh[4], ya[4], yb[4];
#pragma unroll
                for (int q = 0; q < 4; ++q) { hh[q] = hr[64 * q]; ya[q] = y0[64 * q]; yb[q] = y1[64 * q]; }
#pragma unroll
                for (int q = 0; q < 4; ++q) { f32x4 o;
                    o.x = __uint_as_float(hh[q].x << 16) + (__uint_as_float(ya[q].x << 16) + __uint_as_float(yb[q].x << 16)); o.y = __uint_as_float(hh[q].x & 0xffff0000u) + (__uint_as_float(ya[q].x & 0xffff0000u) + __uint_as_float(yb[q].x & 0xffff0000u));
                    o.z = __uint_as_float(hh[q].y << 16) + (__uint_as_float(ya[q].y << 16) + __uint_as_float(yb[q].y << 16)); o.w = __uint_as_float(hh[q].y & 0xffff0000u) + (__uint_as_float(ya[q].y & 0xffff0000u) + __uint_as_float(yb[q].y & 0xffff0000u));
                    orow[64 * q] = o; }
            }
        }
    }
#undef IN
#undef BOTH
}

extern "C" void kernel_launch(void* const* d_in, const int* in_sizes, int n_in, void* d_out, int out_size, void* d_ws, size_t ws_size, hipStream_t stream) {
    if (n_in != 22 || out_size != T * D || ws_size < WS_END) { fprintf(stderr, "kernel_launch: unexpected sizes (n_in %d out %d ws %zu)\n", n_in, out_size, ws_size); return; }
    static int grid = 0;
    if (grid == 0) {
        int dev = 0, cus = 0;
        if (hipGetDevice(&dev) != hipSuccess || hipDeviceGetAttribute(&cus, hipDeviceAttributeMultiprocessorCount, dev) != hipSuccess) { grid = -1; return; }
        if (hipFuncSetAttribute((const void*)mk_fwd, hipFuncAttributeMaxDynamicSharedMemorySize, LDS_BYTES) != hipSuccess) { fprintf(stderr, "hipFuncSetAttribute failed\n"); grid = -1; return; }
        int per_cu = 0;
        if (hipOccupancyMaxActiveBlocksPerMultiprocessor(&per_cu, (const void*)mk_fwd, NWAVES * 64, LDS_BYTES) != hipSuccess || per_cu < 1) fprintf(stderr, "occupancy query: %d\n", per_cu);
        (void)hipGetLastError();
        grid = cus;
    }
    if (grid < 0) return;
    const float* x = (const float*)d_in[0];
    const float* rel_bias = (const float*)d_in[7]; const float* ret_gn_g = (const float*)d_in[8];
    const float* g_ffn = (const float*)d_in[14];
    const float* w_rg = (const float*)d_in[15]; const float* b_rg = (const float*)d_in[16]; const float* w_re = (const float*)d_in[17]; const float* b_re = (const float*)d_in[18];
    const float* w_gate = (const float*)d_in[19]; const float* w_up = (const float*)d_in[20]; const float* w_down = (const float*)d_in[21];
    unsigned char* ws = (unsigned char*)d_ws; float* out = (float*)d_out;
    (void)hipMemsetAsync(ws + WS_CTL, 0, CTL_BYTES, stream);
    unsigned* cnt = (unsigned*)(ws + WS_CTL) + CW_CNT;
    PB pb{}; pb.QA = (bf16*)(ws + WS_QA); pb.KA = (bf16*)(ws + WS_KA); pb.VA = (bf16*)(ws + WS_VA); pb.QB = (bf16*)(ws + WS_QB); pb.KB = (bf16*)(ws + WS_KB);
    pb.VB = (bf16*)(ws + WS_VB); pb.GB = (bf16*)(ws + WS_GB); pb.QC = (bf16*)(ws + WS_QC); pb.KM = (bf16*)(ws + WS_KM); pb.VM = (bf16*)(ws + WS_VM);
    bf16* CAT = (bf16*)(ws + WS_CAT); bf16* ACT = (bf16*)(ws + WS_ACT); bf16* YB = (bf16*)(ws + WS_YB);
    float* RET = (float*)(ws + WS_RKV); int* row_tok = (int*)(ws + WS_ROWTOK); float* row_w = (float*)(ws + WS_ROWW); int* toktab = (int*)(ws + WS_TOKTAB);

    Args a{};
    for (int i = 0; i < 22; ++i) a.in[i] = d_in[i];
    a.out = out; a.ws = ws;
    int li = 0;
#define MK(lo_, hi_) do { a.ph_lo = (lo_); a.ph_hi = (hi_); a.li = li++; hipLaunchKernelGGL(mk_fwd, dim3(grid), dim3(NWAVES * 64), LDS_BYTES, stream, a); } while (0)
    MK(0, 10);
#ifdef PROBE_PHASE
    MK(PROBE_PHASE, PROBE_PHASE + PROBE_COUNT);
#endif
#undef MK
}
```

```cpp
#define PROBE_SUB 0
#include <hip/hip_runtime.h>
#include <cstdio>
#include <cstdint>

typedef unsigned short bf16;
typedef float f32x4 __attribute__((ext_vector_type(4)));
typedef unsigned u32x4 __attribute__((ext_vector_type(4)));
typedef unsigned u32x2 __attribute__((ext_vector_type(2)));

constexpr int T = 32768, D = 1024, SEQ = 8192, NBATCH = 4, NMEM = 256, MEMROWS = NBATCH * NMEM;
constexpr int HD = 64, AH = 8, BH = 4, CH = 4;
constexpr int INCOLS = 2816, KVCOLS = 512;
constexpr int CHUNK = 64, NCHUNK = SEQ / CHUNK;
constexpr int NE = 32, DE = 512;
constexpr int MAXBLK = 288;
constexpr float EPS = 1e-6f;
constexpr float LOG2E = 1.4426950408889634f;
constexpr float QSCALE = 0.125f * LOG2E;

constexpr size_t MiB = 1u << 20;
constexpr size_t WS_CTL = 0, CTL_BYTES = 1 * MiB;
constexpr size_t WS_WINT = 2 * MiB;
constexpr size_t WS_WOUTT = 9 * MiB;
constexpr size_t WS_WGUT = 12 * MiB;
constexpr size_t WS_WDT = 76 * MiB;
constexpr size_t WS_XN = 108 * MiB;
constexpr size_t WS_ACT = 108 * MiB;
constexpr size_t WS_QA = 180 * MiB, WS_KA = 212 * MiB, WS_VA = 244 * MiB, WS_QB = 276 * MiB, WS_KB = 292 * MiB, WS_VB = 308 * MiB, WS_GB = 324 * MiB, WS_QC = 340 * MiB;
constexpr size_t WS_KM = 356 * MiB, WS_VM = 356 * MiB + 512 * 1024;
constexpr size_t WS_YB = 180 * MiB;
constexpr size_t WS_RKV = 357 * MiB;
constexpr size_t WS_CAT = 389 * MiB;
constexpr size_t WS_HB = 324 * MiB;
constexpr size_t WS_ROWTOK = 453 * MiB, WS_ROWW = 457 * MiB, WS_TOKTAB = 461 * MiB, WS_ST = 462 * MiB, WS_ROWR = 478 * MiB, WS_END = 482 * MiB;
constexpr int CW_CNT = 64;

struct PB { bf16 *QA, *KA, *VA, *QB, *KB, *VB, *GB, *QC, *KM, *VM; };

__device__ __forceinline__ float bf2f(bf16 v) { return __uint_as_float(((unsigned)v) << 16); }
__device__ __forceinline__ bf16 f2bf(float f) { unsigned u = __float_as_uint(f); return (bf16)((u + 0x7fffu + ((u >> 16) & 1u)) >> 16); }
__device__ __forceinline__ unsigned pk2(float lo, float hi) { return (unsigned)f2bf(lo) | ((unsigned)f2bf(hi) << 16); }
__device__ __forceinline__ float wave_sum(float v) {
#pragma unroll
    for (int o = 1; o < 64; o <<= 1) v += __shfl_xor(v, o);
    return v;
}
__device__ __forceinline__ float silu_f(float x) { return x / (1.f + __expf(-x)); }

__device__ __forceinline__ bf16* proj_ptr(const PB& pb, int row, int col) {
    if (col < 512) return pb.QA + (size_t)row * 512 + col;
    if (col < 1024) return pb.KA + (size_t)row * 512 + (col - 512);
    if (col < 1536) return pb.VA + (size_t)row * 512 + (col - 1024);
    if (col < 1792) return pb.QB + (size_t)row * 256 + (col - 1536);
    if (col < 2048) return pb.KB + (size_t)row * 256 + (col - 1792);
    if (col < 2304) return pb.VB + (size_t)row * 256 + (col - 2048);
    if (col < 2560) return pb.GB + (size_t)row * 256 + (col - 2304);
    if (col < 2816) return pb.QC + (size_t)row * 256 + (col - 2560);
    if (col < 3072) return pb.KM + (size_t)(row - T) * 256 + (col - 2816);
    return pb.VM + (size_t)(row - T) * 256 + (col - 3072);
}

__device__ __forceinline__ void transpose_item(const float* W, int K, int N, bf16* WT, int row_off, float* scr, int item, int lane) {
    const int nblk = N / 32, kb = item / nblk, nb = item % nblk, k0 = 64 * kb, n0 = 32 * nb;
#pragma unroll 8
    for (int i = 0; i < 32; ++i) { const int kk = 2 * i + (lane >> 5); scr[kk * 33 + (lane & 31)] = W[(size_t)(k0 + kk) * N + n0 + (lane & 31)]; }
    asm volatile("s_waitcnt lgkmcnt(0)" ::: "memory");
    const int c = lane & 7;
#pragma unroll
    for (int j = 0; j < 4; ++j) { const int n = (lane >> 3) + 8 * j; const float* s = scr + (8 * c) * 33 + n;
        u32x4 o; o.x = pk2(s[0 * 33], s[1 * 33]); o.y = pk2(s[2 * 33], s[3 * 33]); o.z = pk2(s[4 * 33], s[5 * 33]); o.w = pk2(s[6 * 33], s[7 * 33]);
        *(u32x4*)(WT + (size_t)(row_off + n0 + n) * K + k0 + 8 * c) = o; }
    asm volatile("s_waitcnt lgkmcnt(0)" ::: "memory");
}
__device__ __forceinline__ void rms_row_to_bf16(const float* xrow, const float* gain, bf16* orow, int lane) {
    const f32x4* xr = (const f32x4*)xrow + lane; const f32x4* gr = (const f32x4*)gain + lane;
    f32x4 v[4]; float s = 0.f;
#pragma unroll
    for (int j = 0; j < 4; ++j) { v[j] = xr[64 * j]; s += (v[j].x * v[j].x + v[j].y * v[j].y) + (v[j].z * v[j].z + v[j].w * v[j].w); }
    const float r = 1.f / sqrtf(wave_sum(s) * (1.f / D) + EPS);
    unsigned long long* o8 = (unsigned long long*)orow + lane;
#pragma unroll
    for (int j = 0; j < 4; ++j) { const f32x4 g = gr[64 * j];
        o8[64 * j] = (unsigned long long)pk2(v[j].x * r * g.x, v[j].y * r * g.y) | ((unsigned long long)pk2(v[j].z * r * g.z, v[j].w * r * g.w) << 32); }
}

struct P0Args { const float *x, *mem, *g_mix, *g_mem, *w_in, *w_mem_kv, *w_out, *w_gate, *w_up, *w_down; bf16 *XN, *WinT, *WoutT, *WguT, *WdT; };
__global__ void __launch_bounds__(512) k_prologue(P0Args a) {
    __shared__ float scr_all[8 * 64 * 33];
    const int lane = threadIdx.x & 63, wave = threadIdx.x >> 6;
    float* scr = scr_all + wave * 64 * 33;
    const int gw = blockIdx.x * 8 + wave, NGW = gridDim.x * 8;
    constexpr int I_IN = 16 * 88, I_KV = 16 * 16, I_O = 16 * 32, I_E = 256;
    constexpr int NITEMS = I_IN + I_KV + I_O + NE * 3 * I_E;
    for (int it = gw; it < NITEMS; it += NGW) {
        int r = it;
        if (r < I_IN) { transpose_item(a.w_in, D, INCOLS, a.WinT, 0, scr, r, lane); continue; } r -= I_IN;
        if (r < I_KV) { transpose_item(a.w_mem_kv, D, KVCOLS, a.WinT, INCOLS, scr, r, lane); continue; } r -= I_KV;
        if (r < I_O) { transpose_item(a.w_out, D, D, a.WoutT, 0, scr, r, lane); continue; } r -= I_O;
        const int e = r / (3 * I_E), q = r % (3 * I_E);
        if (q < I_E) transpose_item(a.w_gate + (size_t)e * D * DE, D, DE, a.WguT + (size_t)e * D * D, 0, scr, q, lane);
        else if (q < 2 * I_E) transpose_item(a.w_up + (size_t)e * D * DE, D, DE, a.WguT + (size_t)e * D * D, DE, scr, q - I_E, lane);
        else transpose_item(a.w_down + (size_t)e * DE * D, DE, D, a.WdT + (size_t)e * D * DE, 0, scr, q - 2 * I_E, lane);
    }
    for (int m = gw; m < T + MEMROWS; m += NGW) {
        if (m < T) rms_row_to_bf16(a.x + (size_t)m * D, a.g_mix, a.XN + (size_t)m * D, lane);
        else rms_row_to_bf16(a.mem + (size_t)(m - T) * D, a.g_mem, a.XN + (size_t)m * D, lane);
    }
}

template <bool DUAL, class RowMap, class Epi>
__device__ __forceinline__ void nv_gemm_tile(const bf16* A, int lda, const float* B, const float* B2, int ldb, int K, int row0, int col0, RowMap rm, Epi epi) {
    __shared__ float As[16][68];
    __shared__ float Bs[16][68];
    __shared__ float Bs2[DUAL ? 16 : 1][68];
    const int tid = threadIdx.x, tx = tid & 15, ty = tid >> 4;
    float acc[4][4], acc2[4][4];
#pragma unroll
    for (int i = 0; i < 4; ++i)
#pragma unroll
        for (int j = 0; j < 4; ++j) { acc[i][j] = 0.f; acc2[i][j] = 0.f; }
    const int ar = tid >> 2, akq = (tid & 3) * 4;
    const bf16* arow = A + (size_t)rm(row0 + ar) * lda + akq;
    const int bk = tid >> 4, bn = (tid & 15) * 4;
    for (int k0 = 0; k0 < K; k0 += 16) {
        const u32x2 av = *(const u32x2*)(arow + k0);
        As[akq + 0][ar] = __uint_as_float(av.x << 16); As[akq + 1][ar] = __uint_as_float(av.x & 0xffff0000u);
        As[akq + 2][ar] = __uint_as_float(av.y << 16); As[akq + 3][ar] = __uint_as_float(av.y & 0xffff0000u);
        const f32x4 bv = *(const f32x4*)(B + (size_t)(k0 + bk) * ldb + col0 + bn);
        Bs[bk][bn] = bv.x; Bs[bk][bn + 1] = bv.y; Bs[bk][bn + 2] = bv.z; Bs[bk][bn + 3] = bv.w;
        if (DUAL) { const f32x4 b2 = *(const f32x4*)(B2 + (size_t)(k0 + bk) * ldb + col0 + bn);
            Bs2[bk][bn] = b2.x; Bs2[bk][bn + 1] = b2.y; Bs2[bk][bn + 2] = b2.z; Bs2[bk][bn + 3] = b2.w; }
        __syncthreads();
#pragma unroll
        for (int k = 0; k < 16; ++k) {
            float a[4], b[4], c[4];
#pragma unroll
            for (int i = 0; i < 4; ++i) { a[i] = As[k][ty * 4 + i]; b[i] = Bs[k][tx * 4 + i]; c[i] = DUAL ? Bs2[k][tx * 4 + i] : 0.f; }
#pragma unroll
            for (int i = 0; i < 4; ++i)
#pragma unroll
                for (int j = 0; j < 4; ++j) { acc[i][j] += a[i] * b[j]; if (DUAL) acc2[i][j] += a[i] * c[j]; }
        }
        __syncthreads();
    }
#pragma unroll
    for (int i = 0; i < 4; ++i)
#pragma unroll
        for (int j = 0; j < 4; ++j) epi(row0 + ty * 4 + i, col0 + tx * 4 + j, acc[i][j], acc2[i][j]);
}
struct IdMap { __device__ __forceinline__ int operator()(int r) const { return r; } };

__global__ void __launch_bounds__(256) k_nv_inproj(const bf16* XN, const float* W, int ldb, int rowbase, int coloff, PB pb) {
    const int row0 = rowbase + blockIdx.y * 64, col0 = blockIdx.x * 64;
    auto epi = [&](int r, int c, float v, float) { *proj_ptr(pb, r, c + coloff) = f2bf(v); };
    nv_gemm_tile<false>(XN, D, W, nullptr, ldb, D, row0, col0, IdMap(), epi);
}
__global__ void __launch_bounds__(256) k_nv_outproj(const bf16* CAT, const float* W, const float* X, float* OUT) {
    const int row0 = blockIdx.y * 64, col0 = blockIdx.x * 64;
    auto epi = [&](int r, int c, float v, float) { OUT[(size_t)r * D + c] = X[(size_t)r * D + c] + v; };
    nv_gemm_tile<false>(CAT, D, W, nullptr, D, D, row0, col0, IdMap(), epi);
}

__global__ void __launch_bounds__(256) k_nv_postproc(PB pb, const int* positions, const float* qn_a, const float* kn_a, const float* qn_c, const float* kn_c) {
    const long id = (long)blockIdx.x * 256 + threadIdx.x;
    bf16* p; const float* gain = nullptr; float scale = 1.f; int mode; int row;
    if (id < (long)T * 32) {
        row = (int)(id >> 5); const int hi = (int)(id & 31);
        if (hi < 8) { p = pb.QA + (size_t)row * 512 + hi * 64; gain = qn_a; scale = QSCALE; mode = 0; }
        else if (hi < 16) { p = pb.KA + (size_t)row * 512 + (hi - 8) * 64; gain = kn_a; mode = 0; }
        else if (hi < 20) { p = pb.QB + (size_t)row * 256 + (hi - 16) * 64; mode = 1; }
        else if (hi < 24) { p = pb.KB + (size_t)row * 256 + (hi - 20) * 64; mode = 1; scale = 0.125f; }
        else if (hi < 28) { p = pb.GB + (size_t)row * 256 + (hi - 24) * 64; mode = 2; }
        else { p = pb.QC + (size_t)row * 256 + (hi - 28) * 64; gain = qn_c; scale = QSCALE; mode = 0; }
    } else {
        const long id2 = id - (long)T * 32; if (id2 >= MEMROWS * 4) return;
        row = (int)(id2 >> 2); p = pb.KM + (size_t)row * 256 + (id2 & 3) * 64; gain = kn_c; mode = 0;
    }
    if (mode == 0) {
        float ss = 0.f;
        for (int d = 0; d < 64; ++d) { const float v = bf2f(p[d]); ss += v * v; }
        const float r = 1.f / sqrtf(ss * (1.f / 64.f) + EPS);
        for (int d = 0; d < 64; ++d) p[d] = f2bf(bf2f(p[d]) * r * gain[d] * scale);
    } else if (mode == 1) {
        const float pos = (float)positions[row];
        for (int i = 0; i < 32; ++i) {
            const float inv = exp2f(-(float)i * (13.287712379549449f / 32.f));
            float rev = pos * inv * 0.15915494309189535f; rev -= floorf(rev);
            const float sn = __builtin_amdgcn_sinf(rev), cs = __builtin_amdgcn_cosf(rev);
            const float t1 = bf2f(p[i]), t2 = bf2f(p[i + 32]);
            p[i] = f2bf((t1 * cs - t2 * sn) * scale); p[i + 32] = f2bf((t1 * sn + t2 * cs) * scale);
        }
    } else {
        for (int d = 0; d < 64; ++d) p[d] = f2bf(silu_f(bf2f(p[d])));
    }
}

__device__ __forceinline__ void nv_attnA_unit(int u, int lane_, const bf16* QA, const bf16* KA, const bf16* VA, const float* rel_bias, bf16* CAT) {
    const int c = u % NCHUNK, h = (u / NCHUNK) % AH, b = u / (NCHUNK * AH);
    const int i = lane_; const size_t qrow = (size_t)b * SEQ + c * CHUNK + i;
    float q[64];
#pragma unroll
    for (int d8 = 0; d8 < 8; ++d8) { const u32x4 v = *(const u32x4*)(QA + qrow * 512 + h * 64 + d8 * 8);
        q[d8 * 8 + 0] = __uint_as_float(v.x << 16); q[d8 * 8 + 1] = __uint_as_float(v.x & 0xffff0000u); q[d8 * 8 + 2] = __uint_as_float(v.y << 16); q[d8 * 8 + 3] = __uint_as_float(v.y & 0xffff0000u);
        q[d8 * 8 + 4] = __uint_as_float(v.z << 16); q[d8 * 8 + 5] = __uint_as_float(v.z & 0xffff0000u); q[d8 * 8 + 6] = __uint_as_float(v.w << 16); q[d8 * 8 + 7] = __uint_as_float(v.w & 0xffff0000u); }
    const float* bias = rel_bias + h * 192;
    float m = -3.0e38f;
    for (int pass = 0; pass < 2; ++pass) {
        float l = 0.f; float o[64];
#pragma unroll
        for (int d = 0; d < 64; ++d) o[d] = 0.f;
        for (int j = 0; j < 9; ++j) {
            const int kc = c - 8 + j; if (kc < 0) continue;
            for (int kk = 0; kk < 64; ++kk) {
                const size_t krow = (size_t)b * SEQ + kc * CHUNK + kk;
                const bf16* kp = KA + krow * 512 + h * 64;
                float s = 0.f;
#pragma unroll
                for (int d8 = 0; d8 < 8; ++d8) { const u32x4 v = *(const u32x4*)(kp + d8 * 8);
                    s += q[d8 * 8 + 0] * __uint_as_float(v.x << 16) + q[d8 * 8 + 1] * __uint_as_float(v.x & 0xffff0000u) + q[d8 * 8 + 2] * __uint_as_float(v.y << 16) + q[d8 * 8 + 3] * __uint_as_float(v.y & 0xffff0000u)
                       + q[d8 * 8 + 4] * __uint_as_float(v.z << 16) + q[d8 * 8 + 5] * __uint_as_float(v.z & 0xffff0000u) + q[d8 * 8 + 6] * __uint_as_float(v.w << 16) + q[d8 * 8 + 7] * __uint_as_float(v.w & 0xffff0000u); }
                int rel = (8 - j) * 64 + i - kk; rel = rel < -63 ? -63 : (rel > 128 ? 128 : rel);
                s += bias[rel + 63] * LOG2E;
                if (pass == 0) { m = fmaxf(m, s); }
                else {
                    const float p = exp2f(s - m); l += p;
                    const bf16* vp = VA + krow * 512 + h * 64;
#pragma unroll
                    for (int d8 = 0; d8 < 8; ++d8) { const u32x4 v = *(const u32x4*)(vp + d8 * 8);
                        o[d8 * 8 + 0] += p * __uint_as_float(v.x << 16); o[d8 * 8 + 1] += p * __uint_as_float(v.x & 0xffff0000u); o[d8 * 8 + 2] += p * __uint_as_float(v.y << 16); o[d8 * 8 + 3] += p * __uint_as_float(v.y & 0xffff0000u);
                        o[d8 * 8 + 4] += p * __uint_as_float(v.z << 16); o[d8 * 8 + 5] += p * __uint_as_float(v.z & 0xffff0000u); o[d8 * 8 + 6] += p * __uint_as_float(v.w << 16); o[d8 * 8 + 7] += p * __uint_as_float(v.w & 0xffff0000u); }
                }
            }
        }
        if (pass == 1) {
            const float il = 1.f / l; bf16* op = CAT + qrow * D + h * 64;
#pragma unroll
            for (int d = 0; d < 64; d += 2) *(unsigned*)(op + d) = pk2(o[d] * il, o[d + 1] * il);
        }
    }
}
__device__ __forceinline__ void nv_cross_unit(int u, int lane_, const bf16* QC, const bf16* KM, const bf16* VM, bf16* CAT) {
    const int c = u % NCHUNK, h = (u / NCHUNK) % CH, b = u / (NCHUNK * CH);
    const int i = lane_; const size_t qrow = (size_t)b * SEQ + c * CHUNK + i;
    float q[64];
#pragma unroll
    for (int d8 = 0; d8 < 8; ++d8) { const u32x4 v = *(const u32x4*)(QC + qrow * 256 + h * 64 + d8 * 8);
        q[d8 * 8 + 0] = __uint_as_float(v.x << 16); q[d8 * 8 + 1] = __uint_as_float(v.x & 0xffff0000u); q[d8 * 8 + 2] = __uint_as_float(v.y << 16); q[d8 * 8 + 3] = __uint_as_float(v.y & 0xffff0000u);
        q[d8 * 8 + 4] = __uint_as_float(v.z << 16); q[d8 * 8 + 5] = __uint_as_float(v.z & 0xffff0000u); q[d8 * 8 + 6] = __uint_as_float(v.w << 16); q[d8 * 8 + 7] = __uint_as_float(v.w & 0xffff0000u); }
    float m = -3.0e38f;
    for (int pass = 0; pass < 2; ++pass) {
        float l = 0.f; float o[64];
#pragma unroll
        for (int d = 0; d < 64; ++d) o[d] = 0.f;
        for (int kk = 0; kk < NMEM; ++kk) {
            const size_t krow = (size_t)b * NMEM + kk;
            const bf16* kp = KM + krow * 256 + h * 64;
            float s = 0.f;
#pragma unroll
            for (int d8 = 0; d8 < 8; ++d8) { const u32x4 v = *(const u32x4*)(kp + d8 * 8);
                s += q[d8 * 8 + 0] * __uint_as_float(v.x << 16) + q[d8 * 8 + 1] * __uint_as_float(v.x & 0xffff0000u) + q[d8 * 8 + 2] * __uint_as_float(v.y << 16) + q[d8 * 8 + 3] * __uint_as_float(v.y & 0xffff0000u)
                   + q[d8 * 8 + 4] * __uint_as_float(v.z << 16) + q[d8 * 8 + 5] * __uint_as_float(v.z & 0xffff0000u) + q[d8 * 8 + 6] * __uint_as_float(v.w << 16) + q[d8 * 8 + 7] * __uint_as_float(v.w & 0xffff0000u); }
            if (pass == 0) { m = fmaxf(m, s); }
            else {
                const float p = exp2f(s - m); l += p;
                const bf16* vp = VM + krow * 256 + h * 64;
#pragma unroll
                for (int d8 = 0; d8 < 8; ++d8) { const u32x4 v = *(const u32x4*)(vp + d8 * 8);
                    o[d8 * 8 + 0] += p * __uint_as_float(v.x << 16); o[d8 * 8 + 1] += p * __uint_as_float(v.x & 0xffff0000u); o[d8 * 8 + 2] += p * __uint_as_float(v.y << 16); o[d8 * 8 + 3] += p * __uint_as_float(v.y & 0xffff0000u);
                    o[d8 * 8 + 4] += p * __uint_as_float(v.z << 16); o[d8 * 8 + 5] += p * __uint_as_float(v.z & 0xffff0000u); o[d8 * 8 + 6] += p * __uint_as_float(v.w << 16); o[d8 * 8 + 7] += p * __uint_as_float(v.w & 0xffff0000u); }
            }
        }
        if (pass == 1) {
            const float il = 1.f / l; bf16* op = CAT + qrow * D + 768 + h * 64;
#pragma unroll
            for (int d = 0; d < 64; d += 2) *(unsigned*)(op + d) = pk2(o[d] * il, o[d + 1] * il);
        }
    }
}
__device__ __forceinline__ void nv_ret_unit(int u, int lane_, const bf16* QB, const bf16* KB, const bf16* VB, float* RET) {
    const int e = u & 63, h = (u >> 6) & 3, b = u >> 8; const int d = lane_;
    const float gamma = 1.f - exp2f(-5.f - (float)h);
    float S = 0.f;
    for (int n = 0; n < SEQ; ++n) {
        const size_t row = (size_t)b * SEQ + n;
        const float kd = bf2f(KB[row * 256 + h * 64 + d]), qd = bf2f(QB[row * 256 + h * 64 + d]), ve = bf2f(VB[row * 256 + h * 64 + e]);
        S = gamma * S + kd * ve;
        const float o = wave_sum(qd * S);
        if (d == 0) RET[row * 256 + h * 64 + e] = o;
    }
}
__device__ __forceinline__ void nv_retnorm_item(int id, const float* RET, const bf16* GB, const float* gn_g, bf16* CAT) {
    const int row = id >> 2, h = id & 3;
    const float* r = RET + (size_t)row * 256 + h * 64;
    float mu = 0.f; for (int d = 0; d < 64; ++d) mu += r[d]; mu *= (1.f / 64.f);
    float var = 0.f; for (int d = 0; d < 64; ++d) { const float t = r[d] - mu; var += t * t; } var *= (1.f / 64.f);
    const float rs = 1.f / sqrtf(var + EPS);
    for (int d = 0; d < 64; ++d) { const float y = (r[d] - mu) * rs * gn_g[h * 64 + d];
        CAT[(size_t)row * D + 512 + h * 64 + d] = f2bf(bf2f(GB[(size_t)row * 256 + h * 64 + d]) * y); }
}

__global__ void __launch_bounds__(256) k_nv_router(const float* H, const float* g_ffn, const float* w_rg, const float* b_rg, const float* w_re, const float* b_re,
                                                   bf16* HN, unsigned* cnt, int* row_tok, float* row_w, int* toktab) {
    const int lane = threadIdx.x & 63, tok = blockIdx.x * 4 + (threadIdx.x >> 6);
    const float* hrow = H + (size_t)tok * D;
    float ss = 0.f;
#pragma unroll
    for (int j = 0; j < 16; ++j) { const float v = hrow[lane + 64 * j]; ss += v * v; }
    const float r = 1.f / sqrtf(wave_sum(ss) * (1.f / D) + EPS);
    float acc[36];
#pragma unroll
    for (int q = 0; q < 36; ++q) acc[q] = 0.f;
#pragma unroll 2
    for (int j = 0; j < 16; ++j) {
        const int k = lane + 64 * j; const float hn = hrow[k] * r * g_ffn[k];
        HN[(size_t)tok * D + k] = f2bf(hn);
        const f32x4 wg = *(const f32x4*)(w_rg + (size_t)k * 4);
        acc[0] += hn * wg.x; acc[1] += hn * wg.y; acc[2] += hn * wg.z; acc[3] += hn * wg.w;
#pragma unroll
        for (int q = 0; q < 8; ++q) { const f32x4 we = *(const f32x4*)(w_re + (size_t)k * 32 + 4 * q);
            acc[4 + 4 * q] += hn * we.x; acc[5 + 4 * q] += hn * we.y; acc[6 + 4 * q] += hn * we.z; acc[7 + 4 * q] += hn * we.w; }
    }
#pragma unroll
    for (int q = 0; q < 36; ++q) acc[q] = wave_sum(acc[q]);
    float gl[4];
#pragma unroll
    for (int g = 0; g < 4; ++g) gl[g] = acc[g] + b_rg[g];
    int gs = 0; float gm = gl[0];
#pragma unroll
    for (int g = 1; g < 4; ++g) if (gl[g] > gm) { gm = gl[g]; gs = g; }
    float gsum = 0.f;
#pragma unroll
    for (int g = 0; g < 4; ++g) gsum += __expf(gl[g] - gm);
    const float pg = 1.f / gsum;
    float el[8];
#pragma unroll
    for (int i = 0; i < 8; ++i) { const float k0 = gs == 0 ? 1.f : 0.f, k1 = gs == 1 ? 1.f : 0.f, k2 = gs == 2 ? 1.f : 0.f, k3 = gs == 3 ? 1.f : 0.f;
        el[i] = k0 * acc[4 + i] + k1 * acc[12 + i] + k2 * acc[20 + i] + k3 * acc[28 + i] + b_re[gs * 8 + i]; }
    int i0 = 0; float m0 = el[0];
#pragma unroll
    for (int i = 1; i < 8; ++i) if (el[i] > m0) { m0 = el[i]; i0 = i; }
    int i1 = -1; float m1 = -3.0e38f;
#pragma unroll
    for (int i = 0; i < 8; ++i) if (i != i0 && el[i] > m1) { m1 = el[i]; i1 = i; }
    const float p1 = __expf(m1 - m0);
    const float w0 = pg / (1.f + p1), w1 = pg * p1 / (1.f + p1);
    if (lane == 0) {
        const int e0 = gs * 8 + i0, e1 = gs * 8 + i1;
        const unsigned s0 = atomicAdd(&cnt[e0], 1u), s1 = atomicAdd(&cnt[e1], 1u);
        row_tok[(size_t)e0 * T + s0] = tok; row_w[(size_t)e0 * T + s0] = w0;
        row_tok[(size_t)e1 * T + s1] = tok; row_w[(size_t)e1 * T + s1] = w1;
        toktab[tok * 4 + 0] = e0; toktab[tok * 4 + 1] = (int)s0; toktab[tok * 4 + 2] = e1; toktab[tok * 4 + 3] = (int)s1;
    }
}

__device__ __forceinline__ void moe_blkstart(const unsigned* cnt, int* blkstart  ) {
    int s = 0;
    for (int e = 0; e < NE; ++e) { blkstart[e] = s; s += (int)((cnt[e] + 255u) >> 8); }
    blkstart[NE] = s;
}
struct GatherMap { const int* tok; unsigned n; int base; __device__ __forceinline__ int operator()(int r) const { const unsigned s = (unsigned)(r - base); return s < n ? tok[s] : 0; } };

__global__ void __launch_bounds__(256) k_nv_g1(const bf16* HN, const float* w_gate, const float* w_up, const unsigned* cnt, const int* row_tok, bf16* ACT) {
    __shared__ int bs[33];
    if (threadIdx.x == 0) moe_blkstart(cnt, bs);
    __syncthreads();
    const int sb = blockIdx.x, bidx = sb >> 2; if (bidx >= bs[NE]) return;
    int e = 0; while (bs[e + 1] <= bidx) ++e;
    const int rb = bidx - bs[e]; const int slot0 = rb * 256 + (sb & 3) * 64;
    const int prow0 = bidx * 256 + (sb & 3) * 64;
    GatherMap gm{row_tok + (size_t)e * T, cnt[e], prow0 - slot0};
    auto epi = [&](int r, int c, float g, float u) { ACT[(size_t)r * DE + c] = f2bf(silu_f(g) * u); };
    nv_gemm_tile<true>(HN, D, w_gate + (size_t)e * D * DE, w_up + (size_t)e * D * DE, DE, D, prow0, blockIdx.y * 64, gm, epi);
}
__global__ void __launch_bounds__(256) k_nv_g2(const bf16* ACT, const float* w_down, const unsigned* cnt, const float* row_w, bf16* YB) {
    __shared__ int bs[33];
    if (threadIdx.x == 0) moe_blkstart(cnt, bs);
    __syncthreads();
    const int sb = blockIdx.x, bidx = sb >> 2; if (bidx >= bs[NE]) return;
    int e = 0; while (bs[e + 1] <= bidx) ++e;
    const int rb = bidx - bs[e]; const int prow0 = bidx * 256 + (sb & 3) * 64; const int sbase = prow0 - (rb * 256 + (sb & 3) * 64);
    const float* wl = row_w + (size_t)e * T; const unsigned n = cnt[e];
    auto epi = [&](int r, int c, float v, float) { const unsigned s = (unsigned)(r - sbase); const float w = s < n ? wl[s] : 0.f; YB[(size_t)r * D + c] = f2bf(w * v); };
    nv_gemm_tile<false>(ACT, DE, w_down + (size_t)e * DE * D, nullptr, D, DE, prow0, blockIdx.y * 64, IdMap(), epi);
}
__global__ void __launch_bounds__(256) k_combine(float* OUT, const bf16* YB, const unsigned* cnt, const int* toktab) {
    __shared__ int bs[33];
    if (threadIdx.x == 0) moe_blkstart(cnt, bs);
    __syncthreads();
    const int tok = blockIdx.x; const int c = threadIdx.x * 4;
    const int e0 = toktab[tok * 4], s0 = toktab[tok * 4 + 1], e1 = toktab[tok * 4 + 2], s1 = toktab[tok * 4 + 3];
    const size_t p0 = (size_t)bs[e0] * 256 + s0, p1 = (size_t)bs[e1] * 256 + s1;
    f32x4 o = *(f32x4*)(OUT + (size_t)tok * D + c);
    const u32x2 a = *(const u32x2*)(YB + p0 * D + c), b = *(const u32x2*)(YB + p1 * D + c);
    o.x += __uint_as_float(a.x << 16) + __uint_as_float(b.x << 16); o.y += __uint_as_float(a.x & 0xffff0000u) + __uint_as_float(b.x & 0xffff0000u);
    o.z += __uint_as_float(a.y << 16) + __uint_as_float(b.y << 16); o.w += __uint_as_float(a.y & 0xffff0000u) + __uint_as_float(b.y & 0xffff0000u);
    *(f32x4*)(OUT + (size_t)tok * D + c) = o;
}

__global__ void __launch_bounds__(64) k_nv_attnA(const bf16* QA, const bf16* KA, const bf16* VA, const float* rel_bias, bf16* CAT) { nv_attnA_unit(blockIdx.x, threadIdx.x, QA, KA, VA, rel_bias, CAT); }
__global__ void __launch_bounds__(64) k_nv_cross(const bf16* QC, const bf16* KM, const bf16* VM, bf16* CAT) { nv_cross_unit(blockIdx.x, threadIdx.x, QC, KM, VM, CAT); }
__global__ void __launch_bounds__(64) k_nv_ret(const bf16* QB, const bf16* KB, const bf16* VB, float* RET) { nv_ret_unit(blockIdx.x, threadIdx.x, QB, KB, VB, RET); }
__global__ void __launch_bounds__(256) k_nv_retnorm(const float* RET, const bf16* GB, const float* gn_g, bf16* CAT) { nv_retnorm_item(blockIdx.x * 256 + threadIdx.x, RET, GB, gn_g, CAT); }
namespace pg8 {
#define PG8_LAS __attribute__((address_space(3)))
typedef short bf16x8 __attribute__((ext_vector_type(8)));
constexpr int BM = 256, BK = 64, HALF = 128, HTB = HALF * BK * 2, STAGE_BYTES = 8 * HTB, NXCD = 8, WGM = 8;

__host__ __device__ __forceinline__ int lds_byte(int r, int c) { const int st = (r >> 4) * 2 + (c >> 5), rr = r & 15, cc = c & 31, ob = rr * 64 + cc * 2; return st * 1024 + (ob ^ (((ob >> 9) & 1) << 5)); }
__host__ __device__ __forceinline__ void stage_rc(int b, int& R, int& C) { const int st = b / 1024, sb = b % 1024, swz = sb ^ (((sb >> 9) & 1) << 5); R = (st >> 1) * 16 + swz / 64; C = (st & 1) * 32 + (swz % 64) / 2; }
__host__ __device__ __forceinline__ int perm32(int rho) { const int n = rho >> 4, i = rho & 15; return 8 * (i >> 2) + 4 * n + (i & 3); }

struct Unit { int pm, pn; const char* a; const char* b; int e, rb; };

__device__ __forceinline__ void static_map(int L, int nM, int nN, int& pm, int& pn) {
    const int nwg = nM * nN; int wgid = L;
    { const int q = nwg / NXCD, r = nwg % NXCD, xcd = wgid % NXCD, off = wgid / NXCD; wgid = (xcd < r ? xcd * (q + 1) : r * (q + 1) + (xcd - r) * q) + off; }
    const int nig = WGM * nN, gid = wgid / nig, fm = gid * WGM, gsz = (nM - fm) < WGM ? (nM - fm) : WGM;
    pm = fm + ((wgid % nig) % gsz); pn = (wgid % nig) / gsz;
}

__device__ __forceinline__ unsigned cvt_pk_bf16(float lo, float hi) { unsigned r; asm volatile("v_cvt_pk_bf16_f32 %0, %1, %2" : "=v"(r) : "v"(lo), "v"(hi)); return r; }

template <class Epi, class Sched, bool ALIGN_EPI, bool GATHER>
__device__ __forceinline__ void gemm_phase(PG8_LAS unsigned char* lds, const int K, const unsigned hstepA, const unsigned hstepB, PG8_LAS unsigned* gspill, const Sched& S, const Epi& E) {
    int tid_ = threadIdx.x; asm volatile("" : "+v"(tid_));
    const int tid = tid_, wid = __builtin_amdgcn_readfirstlane(tid >> 6), lane = tid & 63, wr = wid >> 2, wc = wid & 3, fr = lane & 15, fq = lane >> 4;
    const int nt = K / BK;
    unsigned vA[2][2], voffB[2];
#pragma unroll
    for (int i = 0; i < 2; ++i) { int R, C; stage_rc(tid * 16 + i * 8192, R, C);
        const int Rb = Epi::BMAP == 0 ? R : (Epi::BMAP == 1 ? ((R & ~31) + perm32(R & 31)) : (2 * (R & ~31) + perm32(R & 31)));
        voffB[i] = (unsigned)(Rb * K + C) * 2u; vA[0][i] = (unsigned)(R * K + C) * 2u; vA[1][i] = vA[0][i] + hstepA; }
    const size_t kstep = (size_t)(BK * 2);
    const unsigned ldsw = (unsigned)wid * 1024u;
    const int aoff = lds_byte(wr * 64 + fr, fq * 8), boff = lds_byte(wc * 32 + fr, fq * 8);
#define PG8_SA(b, h) (((b) * 2 + (h)) * HTB)
#define PG8_SB(b, h) ((4 + (b) * 2 + (h)) * HTB)
#define PG8_STAGE_B(bufoff, gbase) do { _Pragma("unroll") for (int _i = 0; _i < 2; ++_i) \
        __builtin_amdgcn_global_load_lds((const unsigned*)((const char*)(gbase) + voffB[_i]), (PG8_LAS unsigned*)(lds + (bufoff) + ldsw + _i * 8192), 16, 0, 0); } while (0)
#define PG8_STAGE_A(bufoff, gbase, h) do { _Pragma("unroll") for (int _i = 0; _i < 2; ++_i) \
        __builtin_amdgcn_global_load_lds((const unsigned*)((const char*)(gbase) + vA[h][_i]), (PG8_LAS unsigned*)(lds + (bufoff) + ldsw + _i * 8192), 16, 0, 0); } while (0)
#define PG8_LDA(dst, b, h) do { _Pragma("unroll") for (int m = 0; m < 4; ++m) _Pragma("unroll") for (int k = 0; k < 2; ++k) dst[m][k] = *(const PG8_LAS bf16x8*)(lds + PG8_SA(b, h) + aoff + m * 2048 + k * 1024); } while (0)
#define PG8_LDB(dst, b, h) do { _Pragma("unroll") for (int n = 0; n < 2; ++n) _Pragma("unroll") for (int k = 0; k < 2; ++k) dst[n][k] = *(const PG8_LAS bf16x8*)(lds + PG8_SB(b, h) + boff + n * 2048 + k * 1024); } while (0)
#define PG8_MMA(ai, bj, At, Bt) do { __builtin_amdgcn_s_setprio(1); _Pragma("unroll") for (int m = 0; m < 4; ++m) _Pragma("unroll") for (int n = 0; n < 2; ++n) _Pragma("unroll") for (int k = 0; k < 2; ++k) \
        acc[ai][bj][m][n] = __builtin_amdgcn_mfma_f32_16x16x32_bf16(Bt[n][k], At[m][k], acc[ai][bj][m][n], 0, 0, 0); __builtin_amdgcn_s_setprio(0); } while (0)
#define PG8_WAIT_V(n) asm volatile("s_waitcnt vmcnt(" #n ")" ::: "memory")
#define PG8_WAIT_L(n) asm volatile("s_waitcnt lgkmcnt(" #n ")" ::: "memory")
#define PG8_BAR __builtin_amdgcn_s_barrier()
#define PG8_SCHED __builtin_amdgcn_sched_barrier(0)
    Unit cur, nxt; int ui = 0;
    if (!S.next(0, cur)) return;
    if constexpr (GATHER) {
#pragma unroll
        for (int i = 0; i < 2; ++i) { int R, C; stage_rc(tid * 16 + i * 8192, R, C);
#pragma unroll
            for (int h = 0; h < 2; ++h) vA[h][i] = (unsigned)S.arow(cur, h * HALF + R) * (unsigned)(K * 2) + (unsigned)(C * 2); }
    }
    f32x4 acc[2][2][4][2];
#pragma unroll
    for (int a = 0; a < 2; ++a)
#pragma unroll
        for (int b = 0; b < 2; ++b)
#pragma unroll
            for (int m = 0; m < 4; ++m)
#pragma unroll
                for (int n = 0; n < 2; ++n) acc[a][b][m][n] = (f32x4){0.f, 0.f, 0.f, 0.f};
    bf16x8 At[4][2], B0[2][2], B1[2][2];
    const char* cA = cur.a; const char* cB = cur.b;
    PG8_STAGE_B(PG8_SB(0, 0), cB); PG8_STAGE_B(PG8_SB(0, 1), cB + hstepB); PG8_STAGE_A(PG8_SA(0, 0), cA, 0); PG8_STAGE_A(PG8_SA(0, 1), cA, 1);
    if (wr == 1) PG8_BAR;
    PG8_WAIT_V(2); PG8_BAR;
    PG8_STAGE_B(PG8_SB(1, 0), cB + kstep); PG8_STAGE_A(PG8_SA(1, 0), cA + kstep, 0); PG8_STAGE_B(PG8_SB(1, 1), cB + hstepB + kstep);
    PG8_WAIT_V(6); PG8_BAR;
    for (;;) {
        const bool has_next = S.next(ui + 1, nxt);
        const char* nA = has_next ? nxt.a : cA; const char* nB = has_next ? nxt.b : cB;
        if constexpr (GATHER) {
            if (has_next) {
                unsigned o[4];
#pragma unroll
                for (int i = 0; i < 2; ++i) { int R, C; stage_rc(tid * 16 + i * 8192, R, C);
#pragma unroll
                    for (int h = 0; h < 2; ++h) o[h * 2 + i] = (unsigned)S.arow(nxt, h * HALF + R) * (unsigned)(K * 2) + (unsigned)(C * 2); }
                *(PG8_LAS u32x4*)(gspill + tid * 4) = (u32x4){o[0], o[1], o[2], o[3]};
            }
        }
        for (int t = 0; t < nt; t += 2) {
            const bool last = (t == nt - 2);
            const char* a1 = cA + (size_t)(t + 1) * kstep;
            const char* a2 = last ? nA : cA + (size_t)(t + 2) * kstep; const char* b2 = last ? nB : cB + (size_t)(t + 2) * kstep;
            const char* a3 = a2 + kstep; const char* b3 = b2 + kstep;
            PG8_LDB(B0, 0, 0); PG8_LDB(B1, 0, 1); PG8_SCHED; PG8_LDA(At, 0, 0); PG8_STAGE_A(PG8_SA(1, 1), a1, 1);
            if constexpr (GATHER) { if (last && has_next) { const u32x4 o = *(const PG8_LAS u32x4*)(gspill + tid * 4); vA[0][0] = o.x; vA[0][1] = o.y; vA[1][0] = o.z; vA[1][1] = o.w; } }
            PG8_WAIT_V(8); PG8_WAIT_L(0); PG8_BAR; PG8_MMA(0, 0, At, B0); PG8_MMA(0, 1, At, B1); PG8_BAR; PG8_SCHED;
            PG8_LDA(At, 0, 1); PG8_STAGE_B(PG8_SB(0, 0), b2); PG8_STAGE_B(PG8_SB(0, 1), b2 + hstepB); PG8_STAGE_A(PG8_SA(0, 0), a2, 0);
            PG8_WAIT_V(8); PG8_WAIT_L(0); PG8_BAR; PG8_MMA(1, 0, At, B0); PG8_MMA(1, 1, At, B1); PG8_BAR; PG8_SCHED;
            PG8_LDB(B0, 1, 0); PG8_LDB(B1, 1, 1); PG8_SCHED; PG8_LDA(At, 1, 0); PG8_STAGE_A(PG8_SA(0, 1), a2, 1);
            PG8_WAIT_V(8); PG8_WAIT_L(0); PG8_BAR; PG8_MMA(0, 0, At, B0); PG8_MMA(0, 1, At, B1); PG8_BAR; PG8_SCHED;
            PG8_LDA(At, 1, 1); PG8_STAGE_B(PG8_SB(1, 0), b3); PG8_STAGE_B(PG8_SB(1, 1), b3 + hstepB); PG8_STAGE_A(PG8_SA(1, 0), a3, 0);
            PG8_WAIT_V(8); PG8_WAIT_L(0); PG8_BAR; PG8_MMA(1, 0, At, B0); PG8_MMA(1, 1, At, B1); PG8_BAR; PG8_SCHED;
        }
        if constexpr (ALIGN_EPI) { if (wr == 0) PG8_BAR; }
        E(acc, cur, wr, wc, fr, fq);
        if (!has_next) break;
#pragma unroll
        for (int a = 0; a < 2; ++a)
#pragma unroll
            for (int b = 0; b < 2; ++b)
#pragma unroll
                for (int m = 0; m < 4; ++m)
#pragma unroll
                    for (int n = 0; n < 2; ++n) acc[a][b][m][n] = (f32x4){0.f, 0.f, 0.f, 0.f};
        cur = nxt; cA = nA; cB = nB; ++ui;
        if constexpr (ALIGN_EPI) { if (wr == 1) PG8_BAR; }
    }
    PG8_WAIT_V(0);
    if constexpr (!ALIGN_EPI) { if (wr == 0) PG8_BAR; }
    PG8_BAR;
#undef PG8_SA
#undef PG8_SB
#undef PG8_STAGE_A
#undef PG8_STAGE_B
#undef PG8_LDA
#undef PG8_LDB
#undef PG8_MMA
#undef PG8_WAIT_V
#undef PG8_WAIT_L
#undef PG8_BAR
#undef PG8_SCHED
}

struct ProjOrder {
    int G, c; const char* A; const char* Bt;
    __device__ __forceinline__ bool next(int i, Unit& u) const {
        const int L = i * G + c; if (L >= 1416) return false;
        int pm, pn;
        if (L < 1408) static_map(L, 128, 11, pm, pn); else { const int j = L - 1408; pm = 128 + (j >> 1); pn = 11 + (j & 1); }
        u.pm = pm; u.pn = pn; u.a = A + (size_t)pm * (256 * 2048); u.b = Bt + (size_t)pn * (256 * 2048); u.e = 0; u.rb = 0; return true;
    }
    __device__ __forceinline__ int arow(const Unit&, int) const { return 0; }
};
struct PlainOrder {
    int G, c, nM, nN; const char* A; const char* Bt; int ldbytes;
    __device__ __forceinline__ bool next(int i, Unit& u) const {
        const int L = i * G + c; if (L >= nM * nN) return false;
        int pm, pn; static_map(L, nM, nN, pm, pn);
        u.pm = pm; u.pn = pn; u.a = A + (size_t)pm * 256 * ldbytes; u.b = Bt + (size_t)pn * 256 * ldbytes; u.e = 0; u.rb = 0; return true;
    }
    __device__ __forceinline__ int arow(const Unit&, int) const { return 0; }
};

struct MoeOrder {
    int G, c, nunits; const PG8_LAS int* blkstart; const PG8_LAS int* blk2e;
    const char* Abase; size_t aBlk; const char* Bbase; size_t bExp, bTile; const int* row_tok; const unsigned* cnt;
    __device__ __forceinline__ bool next(int i, Unit& u) const {
        const int L = i * G + c; if (L >= nunits) return false;
        const int bidx = L >> 2, pn = L & 3;
        const int e = __builtin_amdgcn_readfirstlane(blk2e[bidx]); const int rb = bidx - __builtin_amdgcn_readfirstlane(blkstart[e]);
        u.pm = bidx; u.pn = pn; u.e = e; u.rb = rb; u.a = Abase + (size_t)bidx * aBlk; u.b = Bbase + (size_t)e * bExp + (size_t)pn * bTile; return true;
    }
    __device__ __forceinline__ int arow(const Unit& u, int r) const { const unsigned s = (unsigned)(u.rb * 256 + r); return s < cnt[u.e] ? row_tok[(size_t)u.e * T + s] : 0; }
};

struct EpiProj {
    static constexpr int BMAP = 2;
    PB pb; const int* positions; const float *qn_a, *kn_a, *qn_c, *kn_c;
    __device__ __forceinline__ void operator()(const f32x4 (&acc)[2][2][4][2], const Unit& u, int wr, int wc, int fr, int fq) const {
        asm volatile("" : "+v"(fr), "+v"(fq));
        const int pn = u.pn;
        bf16* dst; int ld, colbase = 0, mode = 3; const float* gain = nullptr; float scale = 1.f; int rowoff = 0;
        if (pn < 2) { dst = pb.QA; ld = 512; colbase = pn * 256; mode = 0; gain = qn_a; scale = QSCALE; }
        else if (pn < 4) { dst = pb.KA; ld = 512; colbase = (pn - 2) * 256; mode = 0; gain = kn_a; }
        else if (pn < 6) { dst = pb.VA; ld = 512; colbase = (pn - 4) * 256; }
        else if (pn == 6) { dst = pb.QB; ld = 256; mode = 1; }
        else if (pn == 7) { dst = pb.KB; ld = 256; mode = 1; scale = 0.125f; }
        else if (pn == 8) { dst = pb.VB; ld = 256; }
        else if (pn == 9) { dst = pb.GB; ld = 256; mode = 2; }
        else if (pn == 10) { dst = pb.QC; ld = 256; mode = 0; gain = qn_c; scale = QSCALE; }
        else if (pn == 11) { dst = pb.KM; ld = 256; mode = 0; gain = kn_c; rowoff = T; }
        else { dst = pb.VM; ld = 256; rowoff = T; }
        const int row0 = u.pm * BM + wr * 64 + fr - rowoff;
        bf16* base = dst + colbase + wc * 64 + 8 * fq;
        if (mode == 0) {
            f32x4 g[2][2];
#pragma unroll
            for (int bj = 0; bj < 2; ++bj)
#pragma unroll
                for (int n = 0; n < 2; ++n) g[bj][n] = *(const f32x4*)(gain + 32 * bj + 8 * fq + 4 * n) * scale;
#pragma unroll
            for (int ai = 0; ai < 2; ++ai)
#pragma unroll
                for (int m = 0; m < 4; ++m) {
                    float ss = 0.f;
#pragma unroll
                    for (int bj = 0; bj < 2; ++bj)
#pragma unroll
                        for (int n = 0; n < 2; ++n) { const f32x4 v = acc[ai][bj][m][n]; ss += (v.x * v.x + v.y * v.y) + (v.z * v.z + v.w * v.w); }
                    ss += __shfl_xor(ss, 16); ss += __shfl_xor(ss, 32);
                    const float r = 1.f / sqrtf(ss * (1.f / 64.f) + EPS);
                    bf16* rowp = base + (size_t)(row0 + ai * HALF + m * 16) * ld;
#pragma unroll
                    for (int bj = 0; bj < 2; ++bj) { const f32x4 v0 = acc[ai][bj][m][0] * g[bj][0] * r, v1 = acc[ai][bj][m][1] * g[bj][1] * r;
                        u32x4 w; w.x = cvt_pk_bf16(v0.x, v0.y); w.y = cvt_pk_bf16(v0.z, v0.w); w.z = cvt_pk_bf16(v1.x, v1.y); w.w = cvt_pk_bf16(v1.z, v1.w);
                        *(u32x4*)(rowp + 32 * bj) = w; }
                }
        } else if (mode == 1) {
            const float lg1 = log2f(1.f - exp2f(-5.f - (float)wc)); const float lgam = pn == 6 ? lg1 : -lg1;
            float inv[2][4];
#pragma unroll
            for (int n = 0; n < 2; ++n)
#pragma unroll
                for (int i = 0; i < 4; ++i) inv[n][i] = exp2f(-(float)(8 * fq + 4 * n + i) * (13.287712379549449f / 32.f)) * 0.15915494309189535f;
#pragma unroll
            for (int ai = 0; ai < 2; ++ai) {
                int posv[4];
#pragma unroll
                for (int m = 0; m < 4; ++m) posv[m] = positions[row0 + ai * HALF + m * 16];
#pragma unroll
                for (int m = 0; m < 4; ++m) {
                    const int row = row0 + ai * HALF + m * 16; const float pos = (float)posv[m];
                    const float rsc = exp2f((float)(row & 63) * lgam) * scale;
                    f32x4 o0[2], o1[2];
#pragma unroll
                    for (int n = 0; n < 2; ++n)
#pragma unroll
                        for (int i = 0; i < 4; ++i) { float rev = pos * inv[n][i]; rev -= floorf(rev);
                            const float sn = __builtin_amdgcn_sinf(rev), cs = __builtin_amdgcn_cosf(rev);
                            const float t1 = acc[ai][0][m][n][i], t2 = acc[ai][1][m][n][i];
                            o0[n][i] = (t1 * cs - t2 * sn) * rsc; o1[n][i] = (t1 * sn + t2 * cs) * rsc; }
                    bf16* rowp = base + (size_t)row * ld;
                    u32x4 w; w.x = cvt_pk_bf16(o0[0].x, o0[0].y); w.y = cvt_pk_bf16(o0[0].z, o0[0].w); w.z = cvt_pk_bf16(o0[1].x, o0[1].y); w.w = cvt_pk_bf16(o0[1].z, o0[1].w);
                    *(u32x4*)(rowp) = w;
                    w.x = cvt_pk_bf16(o1[0].x, o1[0].y); w.y = cvt_pk_bf16(o1[0].z, o1[0].w); w.z = cvt_pk_bf16(o1[1].x, o1[1].y); w.w = cvt_pk_bf16(o1[1].z, o1[1].w);
                    *(u32x4*)(rowp + 32) = w;
                }
            }
        } else {
#pragma unroll
            for (int ai = 0; ai < 2; ++ai)
#pragma unroll
                for (int m = 0; m < 4; ++m) {
                    bf16* rowp = base + (size_t)(row0 + ai * HALF + m * 16) * ld;
#pragma unroll
                    for (int bj = 0; bj < 2; ++bj) { f32x4 v0 = acc[ai][bj][m][0], v1 = acc[ai][bj][m][1];
                        if (mode == 2) {
#pragma unroll
                            for (int i = 0; i < 4; ++i) { v0[i] = v0[i] * __builtin_amdgcn_rcpf(1.f + __builtin_amdgcn_exp2f(-LOG2E * v0[i])); v1[i] = v1[i] * __builtin_amdgcn_rcpf(1.f + __builtin_amdgcn_exp2f(-LOG2E * v1[i])); } }
                        u32x4 w; w.x = cvt_pk_bf16(v0.x, v0.y); w.y = cvt_pk_bf16(v0.z, v0.w); w.z = cvt_pk_bf16(v1.x, v1.y); w.w = cvt_pk_bf16(v1.z, v1.w);
                        *(u32x4*)(rowp + 32 * bj) = w; }
                }
        }
    }
};
struct EpiOutProj {
    static constexpr int BMAP = 1;
    const float* X; bf16* HB;
    __device__ __forceinline__ void operator()(const f32x4 (&acc)[2][2][4][2], const Unit& u, int wr, int wc, int fr, int fq) const {
        asm volatile("" : "+v"(fr), "+v"(fq));
        const int row0 = u.pm * BM + wr * 64 + fr, col0 = u.pn * BM + wc * 32 + 8 * fq;
#pragma unroll
        for (int ai = 0; ai < 2; ++ai)
#pragma unroll
            for (int m = 0; m < 4; ++m) { const size_t off = (size_t)(row0 + ai * HALF + m * 16) * D + col0;
#pragma unroll
                for (int bj = 0; bj < 2; ++bj) { const f32x4 v0 = *(const f32x4*)(X + off + bj * HALF) + acc[ai][bj][m][0], v1 = *(const f32x4*)(X + off + bj * HALF + 4) + acc[ai][bj][m][1];
                    u32x4 w; w.x = cvt_pk_bf16(v0.x, v0.y); w.y = cvt_pk_bf16(v0.z, v0.w); w.z = cvt_pk_bf16(v1.x, v1.y); w.w = cvt_pk_bf16(v1.z, v1.w);
                    *(u32x4*)(HB + off + bj * HALF) = w; } }
    }
};
struct EpiG1 {
    static constexpr int BMAP = 1;
    bf16* ACT; const float* row_r; const unsigned* cnt;
    __device__ __forceinline__ void operator()(const f32x4 (&acc)[2][2][4][2], const Unit& u, int wr, int wc, int fr, int fq) const {
        asm volatile("" : "+v"(fr), "+v"(fq));
        const int r0 = wr * 64 + fr; const unsigned n = cnt[u.e]; const float* rl = row_r + (size_t)u.e * T + u.rb * 256;
        bf16* base = ACT + (size_t)u.pm * BM * DE + u.pn * 128 + wc * 32 + 8 * fq;
        float rsv[2][4];
#pragma unroll
        for (int ai = 0; ai < 2; ++ai)
#pragma unroll
            for (int m = 0; m < 4; ++m) rsv[ai][m] = rl[r0 + ai * HALF + m * 16];
#pragma unroll
        for (int ai = 0; ai < 2; ++ai)
#pragma unroll
            for (int m = 0; m < 4; ++m) {
                const int r = r0 + ai * HALF + m * 16; const float rs = (unsigned)(u.rb * 256 + r) < n ? rsv[ai][m] : 0.f;
                f32x4 o[2];
#pragma unroll
                for (int nn = 0; nn < 2; ++nn)
#pragma unroll
                    for (int i = 0; i < 4; ++i) { const float g = acc[ai][0][m][nn][i] * rs; o[nn][i] = g * __builtin_amdgcn_rcpf(1.f + __builtin_amdgcn_exp2f(-LOG2E * g)) * (acc[ai][1][m][nn][i] * rs); }
                u32x4 w; w.x = cvt_pk_bf16(o[0].x, o[0].y); w.y = cvt_pk_bf16(o[0].z, o[0].w); w.z = cvt_pk_bf16(o[1].x, o[1].y); w.w = cvt_pk_bf16(o[1].z, o[1].w);
                *(u32x4*)(base + (size_t)r * DE) = w;
            }
    }
};
struct EpiG2 {
    static constexpr int BMAP = 1;
    bf16* YB; const float* row_w; const unsigned* cnt;
    __device__ __forceinline__ void operator()(const f32x4 (&acc)[2][2][4][2], const Unit& u, int wr, int wc, int fr, int fq) const {
        asm volatile("" : "+v"(fr), "+v"(fq));
        const int r0 = wr * 64 + fr; const unsigned n = cnt[u.e]; const float* wl = row_w + (size_t)u.e * T + u.rb * 256;
        bf16* base = YB + (size_t)u.pm * BM * D + u.pn * BM + wc * 32 + 8 * fq;
        float wv[2][4];
#pragma unroll
        for (int ai = 0; ai < 2; ++ai)
#pragma unroll
            for (int m = 0; m < 4; ++m) wv[ai][m] = wl[r0 + ai * HALF + m * 16];
#pragma unroll
        for (int ai = 0; ai < 2; ++ai)
#pragma unroll
            for (int m = 0; m < 4; ++m) {
                const int r = r0 + ai * HALF + m * 16; const float w = (unsigned)(u.rb * 256 + r) < n ? wv[ai][m] : 0.f;
                bf16* rowp = base + (size_t)r * D;
#pragma unroll
                for (int bj = 0; bj < 2; ++bj) { const f32x4 v0 = acc[ai][bj][m][0] * w, v1 = acc[ai][bj][m][1] * w;
                    u32x4 q; q.x = cvt_pk_bf16(v0.x, v0.y); q.y = cvt_pk_bf16(v0.z, v0.w); q.z = cvt_pk_bf16(v1.x, v1.y); q.w = cvt_pk_bf16(v1.z, v1.w);
                    *(u32x4*)(rowp + bj * HALF) = q; }
            }
    }
};
}
namespace att {
typedef float f32x16 __attribute__((ext_vector_type(16)));
typedef float f32x2v __attribute__((ext_vector_type(2)));
typedef __bf16 bf16x2v __attribute__((ext_vector_type(2)));
typedef short s16x4 __attribute__((ext_vector_type(4)));
typedef short v4i16_t __attribute__((ext_vector_type(4)));
using pg8::bf16x8;
#define ATT_LAS __attribute__((address_space(3)))
__device__ __forceinline__ int crow(int r, int hi) { return (r & 3) + 8 * (r >> 2) + 4 * hi; }
__device__ __forceinline__ unsigned cvtpk(float lo, float hi) { f32x2v v = {lo, hi}; bf16x2v b = __builtin_convertvector(v, bf16x2v); return __builtin_bit_cast(unsigned, b); }
__device__ __forceinline__ int koff(int key, int ch) { return key * 128 + 16 * (ch ^ ((key >> 1) & 7)); }
__device__ __forceinline__ int voff(int row, int ch) { return 1024 * (row >> 3) + 512 * (ch >> 2) + 64 * (row & 7) + 16 * ((ch & 3) ^ ((row >> 2) & 3)); }
#define ATT_TR(dst, addr, off) asm volatile("ds_read_b64_tr_b16 %0, %1 offset:%2" : "=&v"(dst) : "v"(addr), "i"(off) : "memory")
__device__ __forceinline__ s16x4 vtr(const ATT_LAS unsigned char* p) { return __builtin_bit_cast(s16x4, __builtin_amdgcn_ds_read_tr16_b64_v4i16((ATT_LAS v4i16_t*)p)); }
__device__ __forceinline__ bf16x8 pack8(const f32x16& x, int s) {
    u32x4 p; p.x = cvtpk(x[8 * s], x[8 * s + 1]); p.y = cvtpk(x[8 * s + 2], x[8 * s + 3]); p.z = cvtpk(x[8 * s + 4], x[8 * s + 5]); p.w = cvtpk(x[8 * s + 6], x[8 * s + 7]);
    return __builtin_bit_cast(bf16x8, p);
}
__device__ __forceinline__ void dma_src(int tid, int ld, int& ksrc, int& vsrc) {
    const int sl = tid; const int key = sl >> 3, kch = (sl & 7) ^ ((key >> 1) & 7);
    ksrc = key * ld + kch * 8;
    const int row = 8 * (sl >> 6) + ((sl >> 2) & 7), vch = 4 * ((sl >> 5) & 1) + ((sl & 3) ^ ((row >> 2) & 3));
    vsrc = row * ld + vch * 8;
}

template <int MODE>
__device__ __forceinline__ void attn_unit(ATT_LAS unsigned char* lds, const bf16* Qg, int ldq, const bf16* Kg, const bf16* Vg, int ldkv, bf16* Og, int ldo,
                                          int tile0, int t_first, int t_count, const ATT_LAS float* tbl, float negM0) {
    int tid_ = threadIdx.x; asm volatile("" : "+v"(tid_));
    const int tid = tid_, lane = tid & 63, r32 = lane & 31, hi = lane >> 5; const int wid = __builtin_amdgcn_readfirstlane(tid >> 6);
    int ksrc, vsrc; dma_src(tid, ldkv, ksrc, vsrc);
    const unsigned ldsw = (unsigned)wid * 1024u;
#define ATT_DMA(tt, b) do { __builtin_amdgcn_global_load_lds((const unsigned*)(Kg + (size_t)(tile0 + (tt)) * 64 * ldkv + ksrc), (ATT_LAS unsigned*)(lds + (b) * 16384 + ldsw), 16, 0, 0); \
                            __builtin_amdgcn_global_load_lds((const unsigned*)(Vg + (size_t)(tile0 + (tt)) * 64 * ldkv + vsrc), (ATT_LAS unsigned*)(lds + (b) * 16384 + 8192 + ldsw), 16, 0, 0); } while (0)
    __builtin_amdgcn_s_barrier();
    ATT_DMA(t_first, 0);
    if (t_count > 1) ATT_DMA(t_first + 1, 1);
    bf16x8 qf[4];
    { const bf16* qp = Qg + (size_t)(wid * 32 + r32) * ldq + hi * 8;
#pragma unroll
      for (int s = 0; s < 4; ++s) qf[s] = *(const bf16x8*)(qp + 16 * s); }
    f32x16 o[2];
#pragma unroll
    for (int r = 0; r < 16; ++r) { o[0][r] = 0.f; o[1][r] = 0.f; }
    float lsum = 0.f;
    const int cql = wid >> 1, iq = 32 * (wid & 1) + r32;
    const int q4 = (lane & 15) >> 2, p4 = lane & 3, blk = (lane >> 4) & 1;
    int kofs[4], vofs[2];
#pragma unroll
    for (int s = 0; s < 4; ++s) kofs[s] = koff(r32, 2 * s + hi);
    vofs[0] = voff(4 * hi + q4, 2 * blk + (p4 >> 1)) + 8 * (p4 & 1); vofs[1] = voff(8 + 4 * hi + q4, 2 * blk + (p4 >> 1)) + 8 * (p4 & 1);
#define ATT_STEP(B, it_) do { const int it = (it_); const int tt = t_first + it; \
        if (it == 0 || it + 1 >= t_count) asm volatile("s_waitcnt vmcnt(0)" ::: "memory"); else asm volatile("s_waitcnt vmcnt(2)" ::: "memory");     \
        __builtin_amdgcn_s_barrier(); asm volatile("" ::: "memory"); \
        if (it + 2 < t_count) ATT_DMA(tt + 2, ((B) + 2) % 3); \
        const int jb = MODE == 0 ? tt - cql : 0; \
        if (MODE == 1 || (jb >= 0 && jb <= 8)) { \
            const ATT_LAS unsigned char* Kt = lds + (B) * 16384; const ATT_LAS unsigned char* Vt = Kt + 8192; \
            f32x16 p0, p1; \
            if (MODE == 0 && jb >= 6) { \
                const int base = (8 - jb) * 64 + iq + 63; \
                _Pragma("unroll") for (int r = 0; r < 16; ++r) { const int kk = crow(r, hi); int i0 = base - kk, i1 = base - kk - 32; i0 = i0 > 191 ? 191 : i0; i1 = i1 > 191 ? 191 : i1; p0[r] = tbl[i0]; p1[r] = tbl[i1]; } \
            } else { \
                _Pragma("unroll") for (int r = 0; r < 16; ++r) { p0[r] = negM0; p1[r] = negM0; } \
            } \
            _Pragma("unroll") for (int s = 0; s < 4; ++s) { \
                const bf16x8 k0 = *(const ATT_LAS bf16x8*)(Kt + kofs[s]), k1 = *(const ATT_LAS bf16x8*)(Kt + 4096 + kofs[s]); \
                p0 = __builtin_amdgcn_mfma_f32_32x32x16_bf16(k0, qf[s], p0, 0, 0, 0); \
                p1 = __builtin_amdgcn_mfma_f32_32x32x16_bf16(k1, qf[s], p1, 0, 0, 0); \
            } \
            s16x4 vl[8], vh[8]; { const unsigned va0 = (unsigned)(size_t)Vt + vofs[0], va1 = (unsigned)(size_t)Vt + vofs[1]; \
                ATT_TR(vl[0], va0, 0); ATT_TR(vh[0], va1, 0); ATT_TR(vl[1], va0, 2048); ATT_TR(vh[1], va1, 2048); ATT_TR(vl[2], va0, 4096); ATT_TR(vh[2], va1, 4096); ATT_TR(vl[3], va0, 6144); ATT_TR(vh[3], va1, 6144); \
                ATT_TR(vl[4], va0, 512); ATT_TR(vh[4], va1, 512); ATT_TR(vl[5], va0, 2560); ATT_TR(vh[5], va1, 2560); ATT_TR(vl[6], va0, 4608); ATT_TR(vh[6], va1, 4608); ATT_TR(vl[7], va0, 6656); ATT_TR(vh[7], va1, 6656); } \
            float sa = 0.f, sb = 0.f; \
            _Pragma("unroll") for (int r = 0; r < 16; ++r) { p0[r] = __builtin_amdgcn_exp2f(p0[r]); p1[r] = __builtin_amdgcn_exp2f(p1[r]); sa += p0[r]; sb += p1[r]; } \
            lsum += sa + sb; \
            bf16x8 pa[4]; pa[0] = pack8(p0, 0); pa[1] = pack8(p0, 1); pa[2] = pack8(p1, 0); pa[3] = pack8(p1, 1); \
            asm volatile("s_waitcnt lgkmcnt(0)" : "+v"(vl[0]), "+v"(vl[1]), "+v"(vl[2]), "+v"(vl[3]), "+v"(vl[4]), "+v"(vl[5]), "+v"(vl[6]), "+v"(vl[7]), \
                                                  "+v"(vh[0]), "+v"(vh[1]), "+v"(vh[2]), "+v"(vh[3]), "+v"(vh[4]), "+v"(vh[5]), "+v"(vh[6]), "+v"(vh[7]) :: "memory"); \
            _Pragma("unroll") for (int c = 0; c < 2; ++c) \
                _Pragma("unroll") for (int s = 0; s < 4; ++s) { \
                    const bf16x8 vf = {vl[4 * c + s][0], vl[4 * c + s][1], vl[4 * c + s][2], vl[4 * c + s][3], vh[4 * c + s][0], vh[4 * c + s][1], vh[4 * c + s][2], vh[4 * c + s][3]}; \
                    o[c] = __builtin_amdgcn_mfma_f32_32x32x16_bf16(vf, pa[s], o[c], 0, 0, 0); \
                } \
        } } while (0)
#pragma unroll 1
    for (int it3 = 0; it3 < t_count; it3 += 3) {
        ATT_STEP(0, it3);
        if (it3 + 1 < t_count) ATT_STEP(1, it3 + 1);
        if (it3 + 2 < t_count) ATT_STEP(2, it3 + 2);
    }
#undef ATT_STEP
    lsum += __shfl_xor(lsum, 32);
    const float il = 1.f / lsum;
    bf16* op = Og + (size_t)(wid * 32 + r32) * ldo + 4 * hi;
#pragma unroll
    for (int c = 0; c < 2; ++c)
#pragma unroll
        for (int g = 0; g < 4; ++g) { u32x2 w; w.x = cvtpk(o[c][4 * g] * il, o[c][4 * g + 1] * il); w.y = cvtpk(o[c][4 * g + 2] * il, o[c][4 * g + 3] * il);
            *(u32x2*)(op + 32 * c + 8 * g) = w; }
#undef ATT_DMA
}
}
namespace ret {
using namespace att;
__device__ __forceinline__ void kv_unit(ATT_LAS unsigned char* wl, const bf16* Kc, const bf16* Vc, float* KVo, float g63, int lane) {
    const int r32 = lane & 31, hi = lane >> 5, q4 = (lane & 15) >> 2, p4 = lane & 3, blk = (lane >> 4) & 1;
#pragma unroll
    for (int j = 0; j < 8; ++j) { const int sl = 64 * j + lane; const int row = 8 * (sl >> 6) + ((sl >> 2) & 7), ch = 4 * ((sl >> 5) & 1) + ((sl & 3) ^ ((row >> 2) & 3));
        __builtin_amdgcn_global_load_lds((const unsigned*)(Kc + row * 256 + ch * 8), (ATT_LAS unsigned*)(wl + j * 1024), 16, 0, 0);
        __builtin_amdgcn_global_load_lds((const unsigned*)(Vc + row * 256 + ch * 8), (ATT_LAS unsigned*)(wl + 8192 + j * 1024), 16, 0, 0); }
    asm volatile("s_waitcnt vmcnt(0)" ::: "memory");
    int vofs[2];
    vofs[0] = voff(8 * hi + q4, 2 * blk + (p4 >> 1)) + 8 * (p4 & 1); vofs[1] = voff(8 * hi + 4 + q4, 2 * blk + (p4 >> 1)) + 8 * (p4 & 1);
    f32x16 acc[2][2];
#pragma unroll
    for (int a = 0; a < 2; ++a)
#pragma unroll
        for (int b = 0; b < 2; ++b)
#pragma unroll
            for (int r = 0; r < 16; ++r) acc[a][b][r] = 0.f;
#pragma unroll
    for (int s = 0; s < 4; ++s) {
        bf16x8 vf[2], kf[2];
#pragma unroll
        for (int c = 0; c < 2; ++c) {
            const s16x4 vl = vtr(wl + 8192 + vofs[0] + 2048 * s + 512 * c), vh = vtr(wl + 8192 + vofs[1] + 2048 * s + 512 * c);
            const s16x4 kl = vtr(wl + vofs[0] + 2048 * s + 512 * c), kh = vtr(wl + vofs[1] + 2048 * s + 512 * c);
            vf[c] = (bf16x8){vl[0], vl[1], vl[2], vl[3], vh[0], vh[1], vh[2], vh[3]}; kf[c] = (bf16x8){kl[0], kl[1], kl[2], kl[3], kh[0], kh[1], kh[2], kh[3]};
        }
#pragma unroll
        for (int eb = 0; eb < 2; ++eb)
#pragma unroll
            for (int db = 0; db < 2; ++db) acc[eb][db] = __builtin_amdgcn_mfma_f32_32x32x16_bf16(vf[eb], kf[db], acc[eb][db], 0, 0, 0);
    }
#pragma unroll
    for (int eb = 0; eb < 2; ++eb)
#pragma unroll
        for (int db = 0; db < 2; ++db)
#pragma unroll
            for (int r = 0; r < 16; ++r) KVo[(32 * eb + crow(r, hi)) * 64 + 32 * db + r32] = acc[eb][db][r] * g63;
    asm volatile("s_waitcnt lgkmcnt(0)" ::: "memory");
}

__device__ __forceinline__ void ret_unit(ATT_LAS unsigned char* lds, const bf16* Qg, const bf16* Kg, const bf16* Vg, const bf16* Gg, const bf16* STg, const float* gn, bf16* Og) {
    int tid_ = threadIdx.x; asm volatile("" : "+v"(tid_));
    const int tid = tid_, lane = tid & 63, r32 = lane & 31, hi = lane >> 5; const int wid = __builtin_amdgcn_readfirstlane(tid >> 6);
    const int cl = wid >> 1, qh = wid & 1;
    int ksrc, vsrc; dma_src(tid, 256, ksrc, vsrc);
    const unsigned ldsw = (unsigned)wid * 1024u;
    __builtin_amdgcn_s_barrier();
#pragma unroll
    for (int c4 = 0; c4 < 4; ++c4) {
        __builtin_amdgcn_global_load_lds((const unsigned*)(Kg + (size_t)c4 * 64 * 256 + ksrc), (ATT_LAS unsigned*)(lds + c4 * 8192 + ldsw), 16, 0, 0);
        __builtin_amdgcn_global_load_lds((const unsigned*)(Vg + (size_t)c4 * 64 * 256 + vsrc), (ATT_LAS unsigned*)(lds + 32768 + c4 * 8192 + ldsw), 16, 0, 0); }
    const int qrow = cl * 64 + qh * 32 + r32;
    bf16x8 qf[4];
    { const bf16* qp = Qg + (size_t)qrow * 256 + hi * 8;
#pragma unroll
      for (int s = 0; s < 4; ++s) qf[s] = *(const bf16x8*)(qp + 16 * s); }
    bf16x8 sf[2][4];
    { const bf16* sp = STg + (size_t)cl * 4096 + r32 * 64 + hi * 8;
#pragma unroll
      for (int c = 0; c < 2; ++c)
#pragma unroll
          for (int s = 0; s < 4; ++s) sf[c][s] = *(const bf16x8*)(sp + c * 2048 + 16 * s); }
    f32x4 gnv[2][4]; u32x2 gbv[2][4];
    { const bf16* gp0 = Gg + (size_t)qrow * 256 + 4 * hi;
#pragma unroll
      for (int c = 0; c < 2; ++c)
#pragma unroll
          for (int g = 0; g < 4; ++g) { gnv[c][g] = *(const f32x4*)(gn + 32 * c + 8 * g + 4 * hi); gbv[c][g] = *(const u32x2*)(gp0 + 32 * c + 8 * g); } }
    const int q4 = (lane & 15) >> 2, p4 = lane & 3, blk = (lane >> 4) & 1;
    int kofs[4], vofs[2];
#pragma unroll
    for (int s = 0; s < 4; ++s) kofs[s] = koff(r32, 2 * s + hi);
    vofs[0] = voff(4 * hi + q4, 2 * blk + (p4 >> 1)) + 8 * (p4 & 1); vofs[1] = voff(8 + 4 * hi + q4, 2 * blk + (p4 >> 1)) + 8 * (p4 & 1);
    asm volatile("s_waitcnt vmcnt(0)" ::: "memory"); __builtin_amdgcn_s_barrier(); asm volatile("" ::: "memory");
    const ATT_LAS unsigned char* Kt = lds + cl * 8192; const ATT_LAS unsigned char* Vt = lds + 32768 + cl * 8192;
    f32x16 p0, p1, o[2];
#pragma unroll
    for (int r = 0; r < 16; ++r) { p0[r] = 0.f; p1[r] = 0.f; o[0][r] = 0.f; o[1][r] = 0.f; }
#pragma unroll
    for (int c = 0; c < 2; ++c)
#pragma unroll
        for (int s = 0; s < 4; ++s) o[c] = __builtin_amdgcn_mfma_f32_32x32x16_bf16(sf[c][s], qf[s], o[c], 0, 0, 0);
#pragma unroll
    for (int s = 0; s < 4; ++s) p0 = __builtin_amdgcn_mfma_f32_32x32x16_bf16(*(const ATT_LAS bf16x8*)(Kt + kofs[s]), qf[s], p0, 0, 0, 0);
    if (qh) {
#pragma unroll
        for (int s = 0; s < 4; ++s) p1 = __builtin_amdgcn_mfma_f32_32x32x16_bf16(*(const ATT_LAS bf16x8*)(Kt + 4096 + kofs[s]), qf[s], p1, 0, 0, 0);
#pragma unroll
        for (int r = 0; r < 16; ++r) p1[r] = crow(r, hi) <= r32 ? p1[r] : 0.f;
    } else {
#pragma unroll
        for (int r = 0; r < 16; ++r) p0[r] = crow(r, hi) <= r32 ? p0[r] : 0.f;
    }
    {
        bf16x8 pa[4]; pa[0] = pack8(p0, 0); pa[1] = pack8(p0, 1); pa[2] = pack8(p1, 0); pa[3] = pack8(p1, 1);
        s16x4 vl[8], vh[8]; { const unsigned va0 = (unsigned)(size_t)Vt + vofs[0], va1 = (unsigned)(size_t)Vt + vofs[1];
            ATT_TR(vl[0], va0, 0); ATT_TR(vh[0], va1, 0); ATT_TR(vl[1], va0, 2048); ATT_TR(vh[1], va1, 2048); ATT_TR(vl[2], va0, 4096); ATT_TR(vh[2], va1, 4096); ATT_TR(vl[3], va0, 6144); ATT_TR(vh[3], va1, 6144);
            ATT_TR(vl[4], va0, 512); ATT_TR(vh[4], va1, 512); ATT_TR(vl[5], va0, 2560); ATT_TR(vh[5], va1, 2560); ATT_TR(vl[6], va0, 4608); ATT_TR(vh[6], va1, 4608); ATT_TR(vl[7], va0, 6656); ATT_TR(vh[7], va1, 6656); }
        asm volatile("s_waitcnt lgkmcnt(0)" : "+v"(vl[0]), "+v"(vl[1]), "+v"(vl[2]), "+v"(vl[3]), "+v"(vl[4]), "+v"(vl[5]), "+v"(vl[6]), "+v"(vl[7]),
                                              "+v"(vh[0]), "+v"(vh[1]), "+v"(vh[2]), "+v"(vh[3]), "+v"(vh[4]), "+v"(vh[5]), "+v"(vh[6]), "+v"(vh[7]) :: "memory");
#pragma unroll
        for (int c = 0; c < 2; ++c)
#pragma unroll
            for (int s = 0; s < 4; ++s) {
                if (s < 2 || qh) {
                    const bf16x8 vf = {vl[4 * c + s][0], vl[4 * c + s][1], vl[4 * c + s][2], vl[4 * c + s][3], vh[4 * c + s][0], vh[4 * c + s][1], vh[4 * c + s][2], vh[4 * c + s][3]};
                    o[c] = __builtin_amdgcn_mfma_f32_32x32x16_bf16(vf, pa[s], o[c], 0, 0, 0);
                }
            }
    }
    float sm = 0.f;
#pragma unroll
    for (int r = 0; r < 16; ++r) sm += o[0][r] + o[1][r];
    sm += __shfl_xor(sm, 32);
    const float mu = sm * (1.f / 64.f);
    float sv = 0.f;
#pragma unroll
    for (int r = 0; r < 16; ++r) { const float a = o[0][r] - mu, b = o[1][r] - mu; sv += a * a + b * b; }
    sv += __shfl_xor(sv, 32);
    const float rs = 1.f / sqrtf(sv * (1.f / 64.f) + EPS);
    bf16* op = Og + (size_t)qrow * D + 4 * hi;
#pragma unroll
    for (int c = 0; c < 2; ++c)
#pragma unroll
        for (int g = 0; g < 4; ++g) {
            const f32x4 gv = gnv[c][g]; const u32x2 gb = gbv[c][g];
            const float y0 = (o[c][4 * g] - mu) * rs * gv.x * __uint_as_float(gb.x << 16), y1 = (o[c][4 * g + 1] - mu) * rs * gv.y * __uint_as_float(gb.x & 0xffff0000u);
            const float y2 = (o[c][4 * g + 2] - mu) * rs * gv.z * __uint_as_float(gb.y << 16), y3 = (o[c][4 * g + 3] - mu) * rs * gv.w * __uint_as_float(gb.y & 0xffff0000u);
            u32x2 w; w.x = cvtpk(y0, y1); w.y = cvtpk(y2, y3);
            *(u32x2*)(op + 32 * c + 8 * g) = w;
        }
}
}
constexpr int NWAVES = 8;
constexpr int RING_OFF = 0, RING_BYTES = 131072, SCRATCH_BYTES = 147456;
constexpr int GSPILL_OFF = SCRATCH_BYTES;
constexpr int MOE_OFF = GSPILL_OFF + 8192;
constexpr int MISC_OFF = MOE_OFF + 2048;
constexpr int LDS_BYTES = 163840;
static_assert(MISC_OFF + 512 <= LDS_BYTES, "LDS map");
constexpr int CW_BAR = 4096;

#define GAS __attribute__((address_space(1)))
#define LAS __attribute__((address_space(3)))
#define XB_TMO      128
#define XB_XCNT(j)  (256  + 64 * (j))
#define XB_XSUB(j)  (1280 + 64 * (j))
#define XB_XGEN(j)  (2304 + 64 * (j))
#define XB_TOP      3328
#define XB_TOPGEN   3392
#define XCD_BAR_WORDS 3456
#define XB_SPIN_CAP (1u << 18)
__device__ __forceinline__ unsigned xb_ld(unsigned* p)              { return __hip_atomic_load(p, __ATOMIC_RELAXED, __HIP_MEMORY_SCOPE_AGENT); }
__device__ __forceinline__ unsigned xb_add(unsigned* p, unsigned v) { return __hip_atomic_fetch_add(p, v, __ATOMIC_RELAXED, __HIP_MEMORY_SCOPE_AGENT); }
__device__ __forceinline__ unsigned xb_xcc_id() { return (unsigned)__builtin_amdgcn_s_getreg((3 << 11) | 20) & 0xFu; }
#define XB_SPIN(cond, bar) do { unsigned _sp = 0; while (cond) { __builtin_amdgcn_s_sleep(1); \
    if ((++_sp & 255u) == 0u) { if (xb_ld(&(bar)[XB_TMO])) break; if (_sp > XB_SPIN_CAP) { atomicAdd(&(bar)[XB_TMO], 1u); break; } } } } while (0)
struct XcdBarrier { unsigned* bar; unsigned x; volatile LAS unsigned* st; };
__device__ __forceinline__ XcdBarrier xcd_barrier_post(unsigned* bar, volatile LAS unsigned* st) {
    XcdBarrier b; b.bar = bar; b.x = xb_xcc_id(); b.st = st;
    if (threadIdx.x == 0) (void)xb_add(&bar[XB_XCNT(b.x)], 1u);
    return b;
}
__device__ __forceinline__ void xcd_barrier_complete(unsigned* bar, unsigned x, unsigned& nloc, unsigned& nx) {
    const unsigned G = gridDim.x * gridDim.y * gridDim.z;
    unsigned sum, cnt, mine, sp = 0u;
    for (;;) {
        sum = 0u; cnt = 0u; mine = 0u;
#pragma unroll
        for (unsigned j = 0; j < 16; ++j) { const unsigned c = xb_ld(&bar[XB_XCNT(j)]); sum += c; cnt += (c > 0u) ? 1u : 0u; mine = (j == x) ? c : mine; }
        if (sum == G) break;
        __builtin_amdgcn_s_sleep(1);
        if ((++sp & 255u) == 0u) { if (xb_ld(&bar[XB_TMO])) break; if (sp > XB_SPIN_CAP) { atomicAdd(&bar[XB_TMO], 1u); break; } }
    }
    nloc = mine > 0u ? mine : 1u; nx = cnt > 0u ? cnt : 1u;
}
__device__ __forceinline__ void xcd_barrier(const XcdBarrier& b) {
    asm volatile("s_waitcnt vmcnt(0)" ::: "memory");
    __syncthreads();
    if (threadIdx.x == 0) {
        unsigned* bar = b.bar;
        __builtin_amdgcn_s_waitcnt(0);
        unsigned nloc = b.st[0], nx = b.st[1];
        if (nloc == 0u) { xcd_barrier_complete(bar, b.x, nloc, nx); b.st[0] = nloc; b.st[1] = nx; }
        const unsigned old = xb_add(&bar[XB_XSUB(b.x)], 1u);
        const unsigned gen = old / nloc;
        if (old + 1u == (gen + 1u) * nloc) {
            __builtin_amdgcn_fence(__ATOMIC_RELEASE, "agent");
            asm volatile("s_waitcnt vmcnt(0)" ::: "memory");
            const unsigned og = xb_add(&bar[XB_TOP], 1u);
            const unsigned tg = og / nx;
            if (og + 1u == (tg + 1u) * nx) xb_add(&bar[XB_TOPGEN], 1u);
            else XB_SPIN(xb_ld(&bar[XB_TOPGEN]) == tg, bar);
            __builtin_amdgcn_fence(__ATOMIC_ACQUIRE, "agent");
            xb_add(&bar[XB_XGEN(b.x)], 1u);
            asm volatile("s_waitcnt vmcnt(0)" ::: "memory");
        } else {
            XB_SPIN(xb_ld(&bar[XB_XGEN(b.x)]) == gen, bar);
            __builtin_amdgcn_fence(__ATOMIC_ACQUIRE, "agent");
            asm volatile("s_waitcnt vmcnt(0)" ::: "memory");
        }
    }
    __syncthreads();
}

struct TrItem { const float* W; bf16* WT; const float* kscale; int K, N, row_off, item; };
__device__ __forceinline__ void tr_load(const TrItem& t, f32x4 (&wv)[8], int lane) {
    const int nblk = t.N / 32, kb = t.item / nblk, nb = t.item % nblk, k0 = 64 * kb, n0 = 32 * nb;
    const float* wp = t.W + (size_t)(k0 + (lane >> 3)) * t.N + n0 + 4 * (lane & 7);
#pragma unroll
    for (int i = 0; i < 8; ++i) wv[i] = *(const f32x4*)(wp + (size_t)(8 * i) * t.N);
}
__device__ __forceinline__ void tr_store(const TrItem& t, const f32x4 (&wv)[8], LAS float* scr, int lane) {
    const int nblk = t.N / 32, kb = t.item / nblk, nb = t.item % nblk, k0 = 64 * kb, n0 = 32 * nb;
#pragma unroll
    for (int i = 0; i < 8; ++i) { LAS float* d = scr + (8 * i + (lane >> 3)) * 33 + 4 * (lane & 7); d[0] = wv[i].x; d[1] = wv[i].y; d[2] = wv[i].z; d[3] = wv[i].w; }
    const int c = lane & 7;
    f32x4 s0 = (f32x4){1.f, 1.f, 1.f, 1.f}, s1 = s0;
    if (t.kscale) { s0 = *(const f32x4*)(t.kscale + k0 + 8 * c); s1 = *(const f32x4*)(t.kscale + k0 + 8 * c + 4); }
    asm volatile("s_waitcnt lgkmcnt(0)" ::: "memory");
#pragma unroll
    for (int j = 0; j < 4; ++j) { const int n = (lane >> 3) + 8 * j; const LAS float* s = scr + (8 * c) * 33 + n;
        u32x4 o; o.x = pk2(s[0 * 33] * s0.x, s[1 * 33] * s0.y); o.y = pk2(s[2 * 33] * s0.z, s[3 * 33] * s0.w); o.z = pk2(s[4 * 33] * s1.x, s[5 * 33] * s1.y); o.w = pk2(s[6 * 33] * s1.z, s[7 * 33] * s1.w);
        *(u32x4*)(t.WT + (size_t)(t.row_off + n0 + n) * t.K + k0 + 8 * c) = o; }
    asm volatile("s_waitcnt lgkmcnt(0)" ::: "memory");
}

struct Args { const void* in[22]; float* out; unsigned char* ws; int ph_lo, ph_hi, li, pad; };

__global__ void __launch_bounds__(NWAVES * 64, 2) mk_fwd(Args args) {
    extern __shared__ __attribute__((aligned(16))) unsigned char lds_raw[];
    LAS unsigned char* lds = (LAS unsigned char*)lds_raw;
    volatile LAS unsigned* MISC = (volatile LAS unsigned*)(lds + MISC_OFF);
    LAS unsigned* gspill = (LAS unsigned*)(lds + GSPILL_OFF);
#define PHASE_IDS() int tid_ = threadIdx.x; asm volatile("" : "+v"(tid_)); const int tid = tid_, lane = tid & 63, wave = __builtin_amdgcn_readfirstlane(tid >> 6); (void)lane; (void)wave
    const int G = gridDim.x, bx = blockIdx.x;
    unsigned char* ws = args.ws;
    unsigned* ctl = (unsigned*)(ws + WS_CTL);
    const float* x = (const float*)args.in[0]; const float* mem = (const float*)args.in[1]; const int* positions = (const int*)args.in[2];
    const float* g_mix = (const float*)args.in[3]; const float* w_in = (const float*)args.in[4]; const float* qn_a = (const float*)args.in[5]; const float* kn_a = (const float*)args.in[6];
    const float* g_mem = (const float*)args.in[9]; const float* w_mem_kv = (const float*)args.in[10];
    const float* qn_c = (const float*)args.in[11]; const float* kn_c = (const float*)args.in[12]; const float* w_out = (const float*)args.in[13];
    const float* w_gate = (const float*)args.in[19]; const float* w_up = (const float*)args.in[20]; const float* w_down = (const float*)args.in[21];
    float* out = args.out;
    PB pb; pb.QA = (bf16*)(ws + WS_QA); pb.KA = (bf16*)(ws + WS_KA); pb.VA = (bf16*)(ws + WS_VA); pb.QB = (bf16*)(ws + WS_QB); pb.KB = (bf16*)(ws + WS_KB);
    pb.VB = (bf16*)(ws + WS_VB); pb.GB = (bf16*)(ws + WS_GB); pb.QC = (bf16*)(ws + WS_QC); pb.KM = (bf16*)(ws + WS_KM); pb.VM = (bf16*)(ws + WS_VM);
    bf16* XN = (bf16*)(ws + WS_XN); bf16* WinT = (bf16*)(ws + WS_WINT); bf16* WoutT = (bf16*)(ws + WS_WOUTT); bf16* WguT = (bf16*)(ws + WS_WGUT); bf16* WdT = (bf16*)(ws + WS_WDT);
    bf16* CAT = (bf16*)(ws + WS_CAT);

    { PHASE_IDS(); for (int u = tid; u < 128; u += NWAVES * 64) MISC[u] = 0u; }
    __syncthreads();
    XcdBarrier bar = xcd_barrier_post(ctl + CW_BAR + args.li * XCD_BAR_WORDS, MISC + 8);
    const int lo = args.ph_lo, hi = args.ph_hi;
#define IN(k) (lo <= (k) && (k) < hi)
#define BOTH(k) (IN(k) && IN((k) + 1))

    constexpr int I_IN = 16 * 88, I_KV = 16 * 16, I_O = 16 * 32, I_BASE = I_IN + I_KV + I_O;
    const int GG = (G == 256) ? 236 : G, E_SPLIT = (G == 256) ? 26 : NE;
    auto mk_item = [&](int it) -> TrItem {
        TrItem t; t.kscale = nullptr; t.row_off = 0; int r = it;
        if (r < I_IN) { t.W = w_in; t.K = D; t.N = INCOLS; t.WT = WinT; t.item = r; return t; } r -= I_IN;
        if (r < I_KV) { t.W = w_mem_kv; t.K = D; t.N = KVCOLS; t.WT = WinT; t.row_off = INCOLS; t.item = r; return t; } r -= I_KV;
        if (r < I_O) { t.W = w_out; t.K = D; t.N = D; t.WT = WoutT; t.item = r; return t; } r -= I_O;
        const int e = r / 768, q = r % 768; const float* g_ffn0 = (const float*)args.in[14];
        if (q < 256) { t.W = w_gate + (size_t)e * D * DE; t.K = D; t.N = DE; t.WT = WguT + (size_t)e * D * D; t.item = q; t.kscale = g_ffn0; }
        else if (q < 512) { t.W = w_up + (size_t)e * D * DE; t.K = D; t.N = DE; t.WT = WguT + (size_t)e * D * D; t.row_off = DE; t.item = q - 256; t.kscale = g_ffn0; }
        else { t.W = w_down + (size_t)e * DE * D; t.K = DE; t.N = D; t.WT = WdT + (size_t)e * D * DE; t.item = q - 512; }
        return t; };
#define CONVERT_ITEMS(first_, last_, stride_) do { PHASE_IDS(); LAS float* scr = (LAS float*)(lds + RING_OFF + wave * 16384); \
        for (int it = (first_); it < (last_); it += (stride_)) { const TrItem ta = mk_item(it); f32x4 va[8]; tr_load(ta, va, lane); tr_store(ta, va, scr, lane); } } while (0)
    if (IN(0)) {
        { CONVERT_ITEMS(bx * NWAVES + wave, I_BASE + E_SPLIT * 768, G * NWAVES); }
        PHASE_IDS();
        const int gw = bx * NWAVES + wave, NGW = G * NWAVES;
        for (int m = gw; m < T + MEMROWS; m += NGW) {
            if (m < T) rms_row_to_bf16(x + (size_t)m * D, g_mix, XN + (size_t)m * D, lane);
            else rms_row_to_bf16(mem + (size_t)(m - T) * D, g_mem, XN + (size_t)m * D, lane);
        }
        if (BOTH(0)) xcd_barrier(bar);
    }
    if (IN(1)) {
        if (bx < GG) {
            pg8::ProjOrder S{GG, bx, (const char*)XN, (const char*)WinT};
            pg8::EpiProj E{pb, positions, qn_a, kn_a, qn_c, kn_c};
            pg8::gemm_phase<pg8::EpiProj, pg8::ProjOrder, true, false>(lds + RING_OFF, D, 128u * 2048u, 32u * 2048u, gspill, S, E);
        } else {
            CONVERT_ITEMS(I_BASE + E_SPLIT * 768 + (bx - GG) * NWAVES + wave, I_BASE + NE * 768, (G - GG) * NWAVES);
        }
        if (BOTH(1)) xcd_barrier(bar);
    }
    if (IN(2)) {
        PHASE_IDS();
        float* KV = (float*)(ws + WS_RKV);
        for (int u = bx * NWAVES + wave; u < NBATCH * BH * NCHUNK; u += G * NWAVES) {
            const int bh = u >> 7, c = u & 127, b = bh >> 2, h = bh & 3; const size_t r0 = (size_t)b * SEQ + (size_t)c * 64;
            const float g63 = exp2f(63.f * log2f(1.f - exp2f(-5.f - (float)h)));
            ret::kv_unit(lds + wave * 16384, pb.KB + r0 * 256 + h * 64, pb.VB + r0 * 256 + h * 64, KV + (size_t)u * 4096, g63, lane);
        }
        if (BOTH(2)) xcd_barrier(bar);
    }
    if (IN(3)) {
        PHASE_IDS();
        const float* KV = (const float*)(ws + WS_RKV); bf16* ST = (bf16*)(ws + WS_ST);
        for (int p = bx * NWAVES + wave; p < 2048; p += G * NWAVES) {
            const int hf = lane >> 5, el = p * 32 + (lane & 31), bh = el >> 12, ed = el & 4095, h = bh & 3;
            const float gam = 1.f - exp2f(-5.f - (float)h), g64 = exp2f(64.f * log2f(gam));
            const float* src = KV + (size_t)(bh * 128 + hf * 64) * 4096 + ed;
            float kv[64];
#pragma unroll
            for (int j = 0; j < 64; ++j) kv[j] = src[(size_t)j * 4096];
            float L = 0.f;
#pragma unroll
            for (int j = 0; j < 64; ++j) L = g64 * L + kv[j];
            const float S64 = __shfl(L, lane & 31);
            float st = hf ? S64 : 0.f;
            bf16* dst = ST + (size_t)(bh * 128 + hf * 64) * 4096 + ed;
#pragma unroll
            for (int j = 0; j < 64; ++j) { dst[(size_t)j * 4096] = f2bf(gam * st); st = g64 * st + kv[j]; }
        }
        if (BOTH(3)) xcd_barrier(bar);
    }
    if (IN(4)) {
        PHASE_IDS();
        const float* rel_bias = (const float*)args.in[7]; const float* ret_gn_g = (const float*)args.in[8];
        LAS float* tbl = (LAS float*)(lds + 65536); LAS float* mvals = tbl + 8 * 192;
        {
            const int l4 = tid & 63;
            float gq = fabsf(qn_a[l4]), gk = fabsf(kn_a[l4]), cq = fabsf(qn_c[l4]), ck = fabsf(kn_c[l4]);
            float mb = -3.0e38f;
            for (int i = l4; i < 192; i += 64) mb = fmaxf(mb, rel_bias[wave * 192 + i]);
#pragma unroll
            for (int o = 1; o < 64; o <<= 1) { gq = fmaxf(gq, __shfl_xor(gq, o)); gk = fmaxf(gk, __shfl_xor(gk, o)); cq = fmaxf(cq, __shfl_xor(cq, o)); ck = fmaxf(ck, __shfl_xor(ck, o)); mb = fmaxf(mb, __shfl_xor(mb, o)); }
            const float M0 = 8.f * LOG2E * gq * gk + fmaxf(mb, 0.f) * LOG2E + 1.f;
            for (int i = l4; i < 192; i += 64) tbl[wave * 192 + i] = rel_bias[wave * 192 + i] * LOG2E - M0;
            if (tid == 0) mvals[0] = -(8.f * LOG2E * cq * ck + 1.f);
        }
        __syncthreads();
        const float negM0c = mvals[0];
        const int sub = args.pad;
        if (sub == 0 || sub == 1) for (int u = bx; u < NBATCH * AH * 32; u += G) {
            const int b = u >> 8, h = (u >> 5) & 7, g = u & 31;
            const int t_first = 8 - 4 * g > 0 ? 8 - 4 * g : 0;
            const size_t q0 = (size_t)b * SEQ + (size_t)g * 256, s0 = (size_t)b * SEQ;
            att::attn_unit<0>(lds, pb.QA + q0 * 512 + h * 64, 512, pb.KA + s0 * 512 + h * 64, pb.VA + s0 * 512 + h * 64, 512, CAT + q0 * D + h * 64, D,
                              4 * g - 8, t_first, 12 - t_first, tbl + h * 192, tbl[h * 192 + 191]);
        }
        if (sub == 0 || sub == 2) for (int u = bx; u < NBATCH * BH * 32; u += G) {
            const int b = u >> 7, h = (u >> 5) & 3, g = u & 31;
            const size_t r0 = (size_t)b * SEQ + (size_t)g * 256;
            ret::ret_unit(lds, pb.QB + r0 * 256 + h * 64, pb.KB + r0 * 256 + h * 64, pb.VB + r0 * 256 + h * 64, pb.GB + r0 * 256 + h * 64,
                          (const bf16*)(ws + WS_ST) + (size_t)((b * 4 + h) * 128 + 4 * g) * 4096, ret_gn_g + h * 64, CAT + r0 * D + 512 + h * 64);
        }
        if (sub == 0 || sub == 3) for (int u = bx; u < NBATCH * CH * 32; u += G) {
            const int b = u >> 7, h = (u >> 5) & 3, g = u & 31;
            const size_t q0 = (size_t)b * SEQ + (size_t)g * 256, m0 = (size_t)b * NMEM;
            att::attn_unit<1>(lds, pb.QC + q0 * 256 + h * 64, 256, pb.KM + m0 * 256 + h * 64, pb.VM + m0 * 256 + h * 64, 256, CAT + q0 * D + 768 + h * 64, D,
                              0, 0, 4, tbl, negM0c);
        }
        if (BOTH(4)) xcd_barrier(bar);
    }
    if (IN(5)) {
        pg8::PlainOrder S{G, bx, T / 256, D / 256, (const char*)CAT, (const char*)WoutT, 2048};
        pg8::EpiOutProj E{x, (bf16*)(ws + WS_HB)};
        pg8::gemm_phase<pg8::EpiOutProj, pg8::PlainOrder, true, false>(lds + RING_OFF, D, 128u * 2048u, 128u * 2048u, gspill, S, E);
        if (BOTH(5)) xcd_barrier(bar);
    }
    if (IN(6)) {
        PHASE_IDS();
        const float* g_ffn = (const float*)args.in[14]; const float* w_rg = (const float*)args.in[15]; const float* b_rg = (const float*)args.in[16];
        const float* w_re = (const float*)args.in[17]; const float* b_re = (const float*)args.in[18];
        const bf16* HB = (const bf16*)(ws + WS_HB); unsigned* cnt = ctl + CW_CNT;
        int* row_tok = (int*)(ws + WS_ROWTOK); float* row_w = (float*)(ws + WS_ROWW); float* row_r = (float*)(ws + WS_ROWR); int* toktab = (int*)(ws + WS_TOKTAB);
        constexpr int IMG_LO = 36864, LG_OFF = 73728, TAB_OFF = LG_OFF + 8 * 2304;
        LAS int* tokE = (LAS int*)(lds + TAB_OFF); LAS float* tokW = (LAS float*)(lds + TAB_OFF + 1024); LAS int* tokR = (LAS int*)(lds + TAB_OFF + 2048);
        LAS float* tokN = (LAS float*)(lds + TAB_OFF + 3072); LAS unsigned* hist = (LAS unsigned*)(lds + TAB_OFF + 3584); LAS unsigned* ebase = hist + 32;
        const int r16 = lane & 15, kq = lane >> 4;
        for (int unit = bx; unit < T / 128; unit += G) {
            const int tok0 = unit * 128 + wave * 16;
            const bf16* hrow = HB + (size_t)(tok0 + r16) * D + 8 * kq;
            f32x4 acc[3]; acc[0] = (f32x4){0.f, 0.f, 0.f, 0.f}; acc[1] = acc[0]; acc[2] = acc[0];
            float ss = 0.f;
            if (tid < 64) hist[tid] = 0u;
            for (int kh = 0; kh < 2; ++kh) {
                pg8::bf16x8 av[16];
#pragma unroll
                for (int s = 0; s < 16; ++s) av[s] = *(const pg8::bf16x8*)(hrow + kh * 512 + 32 * s);
                __syncthreads();
                for (int idx = tid; idx < 36 * 512; idx += NWAVES * 64) {
                    const int n = idx >> 9, kk = idx & 511, k = kh * 512 + kk;
                    const float v = g_ffn[k] * (n < 4 ? w_rg[k * 4 + n] : w_re[k * 32 + (n - 4)]);
                    const bf16 vh = f2bf(v), vl = f2bf(v - bf2f(vh));
                    const int addr = n * 1024 + ((((kk >> 3) ^ (n & 15))) << 4) + (kk & 7) * 2;
                    *(LAS bf16*)(lds + addr) = vh; *(LAS bf16*)(lds + IMG_LO + addr) = vl;
                }
                __syncthreads();
#pragma unroll
                for (int s = 0; s < 16; ++s) {
#pragma unroll
                    for (int j = 0; j < 8; ++j) { const float f = __uint_as_float(((unsigned)(unsigned short)av[s][j]) << 16); ss += f * f; }
#pragma unroll
                    for (int nb = 0; nb < 3; ++nb) {
                        int n = 16 * nb + r16; n = n > 35 ? 35 : n;
                        const int addr = n * 1024 + (((4 * s + kq) ^ (n & 15)) << 4);
                        const pg8::bf16x8 bh = *(const LAS pg8::bf16x8*)(lds + addr), bl = *(const LAS pg8::bf16x8*)(lds + IMG_LO + addr);
                        acc[nb] = __builtin_amdgcn_mfma_f32_16x16x32_bf16(av[s], bh, acc[nb], 0, 0, 0);
                        acc[nb] = __builtin_amdgcn_mfma_f32_16x16x32_bf16(av[s], bl, acc[nb], 0, 0, 0);
                    }
                }
            }
            ss += __shfl_xor(ss, 16); ss += __shfl_xor(ss, 32);
            const float rr = 1.f / sqrtf(ss * (1.f / D) + EPS);
            LAS float* LG = (LAS float*)(lds + LG_OFF + wave * 2304);
#pragma unroll
            for (int i = 0; i < 4; ++i) { const float ri = __shfl(rr, 4 * kq + i);
#pragma unroll
                for (int nb = 0; nb < 3; ++nb) { const int n = 16 * nb + r16; if (n < 36) LG[(4 * kq + i) * 36 + n] = acc[nb][i] * ri; } }
            asm volatile("s_waitcnt lgkmcnt(0)" ::: "memory");
            if (lane < 16) {
                const LAS float* lg = LG + lane * 36;
                float gl[4];
#pragma unroll
                for (int g = 0; g < 4; ++g) gl[g] = lg[g] + b_rg[g];
                int gs = 0; float gm = gl[0];
#pragma unroll
                for (int g = 1; g < 4; ++g) if (gl[g] > gm) { gm = gl[g]; gs = g; }
                float gsum = 0.f;
#pragma unroll
                for (int g = 0; g < 4; ++g) gsum += __expf(gl[g] - gm);
                const float pg = 1.f / gsum;
                float el[8];
#pragma unroll
                for (int i = 0; i < 8; ++i) el[i] = lg[4 + gs * 8 + i] + b_re[gs * 8 + i];
                int i0 = 0; float m0 = el[0];
#pragma unroll
                for (int i = 1; i < 8; ++i) if (el[i] > m0) { m0 = el[i]; i0 = i; }
                int i1 = -1; float m1 = -3.0e38f;
#pragma unroll
                for (int i = 0; i < 8; ++i) if (i != i0 && el[i] > m1) { m1 = el[i]; i1 = i; }
                const float p1 = __expf(m1 - m0);
                const int tl = wave * 16 + lane;
                tokE[tl * 2] = gs * 8 + i0; tokE[tl * 2 + 1] = gs * 8 + i1; tokW[tl * 2] = pg / (1.f + p1); tokW[tl * 2 + 1] = pg * p1 / (1.f + p1); tokN[tl] = rr;
            }
            __syncthreads();
            if (tid < 128) { tokR[tid * 2] = (int)__hip_atomic_fetch_add(hist + tokE[tid * 2], 1u, __ATOMIC_RELAXED, __HIP_MEMORY_SCOPE_WORKGROUP);
                             tokR[tid * 2 + 1] = (int)__hip_atomic_fetch_add(hist + tokE[tid * 2 + 1], 1u, __ATOMIC_RELAXED, __HIP_MEMORY_SCOPE_WORKGROUP); }
            __syncthreads();
            if (tid < 32) { const unsigned hc = hist[tid]; ebase[tid] = hc ? atomicAdd(cnt + tid, hc) : 0u; }
            __syncthreads();
            if (tid < 128) {
                const int tok = unit * 128 + tid; const float rn = tokN[tid];
                const int e0 = tokE[tid * 2], e1 = tokE[tid * 2 + 1]; const int s0 = (int)ebase[e0] + tokR[tid * 2], s1 = (int)ebase[e1] + tokR[tid * 2 + 1];
                row_tok[(size_t)e0 * T + s0] = tok; row_w[(size_t)e0 * T + s0] = tokW[tid * 2]; row_r[(size_t)e0 * T + s0] = rn;
                row_tok[(size_t)e1 * T + s1] = tok; row_w[(size_t)e1 * T + s1] = tokW[tid * 2 + 1]; row_r[(size_t)e1 * T + s1] = rn;
                *(int4*)(toktab + tok * 4) = make_int4(e0, s0, e1, s1);
            }
        }
        if (BOTH(6)) xcd_barrier(bar);
    }
    LAS int* blkstart = (LAS int*)(lds + MOE_OFF); LAS int* blk2e = blkstart + 40;
    if (IN(7) || IN(8) || IN(9)) {
        PHASE_IDS();
        const unsigned* cnt = ctl + CW_CNT;
        if (tid == 0) { int s = 0; for (int e = 0; e < NE; ++e) { blkstart[e] = s; s += (int)((cnt[e] + 255u) >> 8); } blkstart[NE] = s; }
        __syncthreads();
        const int nb = blkstart[NE];
        for (int b = tid; b < nb; b += NWAVES * 64) { int e = 0; while (blkstart[e + 1] <= b) ++e; blk2e[b] = e; }
        __syncthreads();
    }
#define STAGGER(nunits_, unit_ticks_) do { const int nu_ = (nunits_); const int full_ = nu_ / G, rem_ = nu_ % G; \
        if (rem_ > 0 && bx >= rem_ && full_ > 0) { const unsigned long long t0_ = __builtin_amdgcn_s_memrealtime(); const unsigned long long dl_ = (unsigned long long)(((bx % 3) + 1) * (unit_ticks_) / 4); \
            while (__builtin_amdgcn_s_memrealtime() - t0_ < dl_) __builtin_amdgcn_s_sleep(8); } } while (0)
    if (IN(7)) {
        pg8::MoeOrder S{G, bx, blkstart[NE] * 4, blkstart, blk2e, (const char*)(ws + WS_HB), 0, (const char*)WguT, (size_t)D * D * 2, (size_t)128 * 2048, (const int*)(ws + WS_ROWTOK), ctl + CW_CNT};
        pg8::EpiG1 E{(bf16*)(ws + WS_ACT), (const float*)(ws + WS_ROWR), ctl + CW_CNT};
        pg8::gemm_phase<pg8::EpiG1, pg8::MoeOrder, true, true>(lds + RING_OFF, D, 0u, 512u * 2048u, gspill, S, E);
        if (BOTH(7)) xcd_barrier(bar);
    }
    if (IN(8)) {
        pg8::MoeOrder S{G, bx, blkstart[NE] * 4, blkstart, blk2e, (const char*)(ws + WS_ACT), (size_t)256 * 1024, (const char*)WdT, (size_t)D * DE * 2, (size_t)256 * 1024, (const int*)(ws + WS_ROWTOK), ctl + CW_CNT};
        pg8::EpiG2 E{(bf16*)(ws + WS_YB), (const float*)(ws + WS_ROWW), ctl + CW_CNT};
        pg8::gemm_phase<pg8::EpiG2, pg8::MoeOrder, true, false>(lds + RING_OFF, DE, 128u * 1024u, 128u * 1024u, gspill, S, E);
        if (BOTH(8)) xcd_barrier(bar);
    }
    if (IN(9)) {
        PHASE_IDS();
        const bf16* YB = (const bf16*)(ws + WS_YB); const bf16* HB = (const bf16*)(ws + WS_HB); const int* toktab = (const int*)(ws + WS_TOKTAB);
        for (int tb = (bx * NWAVES + wave) * 4; tb < T; tb += G * NWAVES * 4) {
            int4 tt[4];
#pragma unroll
            for (int k = 0; k < 4; ++k) tt[k] = *(const int4*)(toktab + (tb + k) * 4);
#pragma unroll
            for (int k = 0; k < 4; ++k) {
                const int tok = tb + k;
                const size_t p0 = (size_t)blkstart[tt[k].x] * 256 + tt[k].y, p1 = (size_t)blkstart[tt[k].z] * 256 + tt[k].w;
                f32x4* orow = (f32x4*)(out + (size_t)tok * D) + lane; const u32x2* hr = (const u32x2*)(HB + (size_t)tok * D) + lane;
                const u32x2* y0 = (const u32x2*)(YB + p0 * D) + lane; const u32x2* y1 = (const u32x2*)(YB + p1 * D) + lane;
                u32x2 hh[4], ya[4], yb[4];
#pragma unroll
                for (int q = 0; q < 4; ++q) { hh[q] = hr[64 * q]; ya[q] = y0[64 * q]; yb[q] = y1[64 * q]; }
#pragma unroll
                for (int q = 0; q < 4; ++q) { f32x4 o;
                    o.x = __uint_as_float(hh[q].x << 16) + (__uint_as_float(ya[q].x << 16) + __uint_as_float(yb[q].x << 16)); o.y = __uint_as_float(hh[q].x & 0xffff0000u) + (__uint_as_float(ya[q].x & 0xffff0000u) + __uint_as_float(yb[q].x & 0xffff0000u));
                    o.z = __uint_as_float(hh[q].y << 16) + (__uint_as_float(ya[q].y << 16) + __uint_as_float(yb[q].y << 16)); o.w = __uint_as_float(hh[q].y & 0xffff0000u) + (__uint_as_float(ya[q].y & 0xffff0000u) + __uint_as_float(yb[q].y & 0xffff0000u));
                    orow[64 * q] = o; }
            }
        }
    }
#undef IN
#undef BOTH
}

extern "C" void kernel_launch(void* const* d_in, const int* in_sizes, int n_in, void* d_out, int out_size, void* d_ws, size_t ws_size, hipStream_t stream) {
    if (n_in != 22 || out_size != T * D || ws_size < WS_END) { fprintf(stderr, "kernel_launch: unexpected sizes (n_in %d out %d ws %zu)\n", n_in, out_size, ws_size); return; }
    static int grid = 0;
    if (grid == 0) {
        int dev = 0, cus = 0;
        if (hipGetDevice(&dev) != hipSuccess || hipDeviceGetAttribute(&cus, hipDeviceAttributeMultiprocessorCount, dev) != hipSuccess) { grid = -1; return; }
        if (hipFuncSetAttribute((const void*)mk_fwd, hipFuncAttributeMaxDynamicSharedMemorySize, LDS_BYTES) != hipSuccess) { fprintf(stderr, "hipFuncSetAttribute failed\n"); grid = -1; return; }
        int per_cu = 0;
        if (hipOccupancyMaxActiveBlocksPerMultiprocessor(&per_cu, (const void*)mk_fwd, NWAVES * 64, LDS_BYTES) != hipSuccess || per_cu < 1) fprintf(stderr, "occupancy query: %d\n", per_cu);
        (void)hipGetLastError();
        grid = cus;
    }
    if (grid < 0) return;
    const float* x = (const float*)d_in[0];
    const float* rel_bias = (const float*)d_in[7]; const float* ret_gn_g = (const float*)d_in[8];
    const float* g_ffn = (const float*)d_in[14];
    const float* w_rg = (const float*)d_in[15]; const float* b_rg = (const float*)d_in[16]; const float* w_re = (const float*)d_in[17]; const float* b_re = (const float*)d_in[18];
    const float* w_gate = (const float*)d_in[19]; const float* w_up = (const float*)d_in[20]; const float* w_down = (const float*)d_in[21];
    unsigned char* ws = (unsigned char*)d_ws; float* out = (float*)d_out;
    (void)hipMemsetAsync(ws + WS_CTL, 0, CTL_BYTES, stream);
    unsigned* cnt = (unsigned*)(ws + WS_CTL) + CW_CNT;
    PB pb{}; pb.QA = (bf16*)(ws + WS_QA); pb.KA = (bf16*)(ws + WS_KA); pb.VA = (bf16*)(ws + WS_VA); pb.QB = (bf16*)(ws + WS_QB); pb.KB = (bf16*)(ws + WS_KB);
    pb.VB = (bf16*)(ws + WS_VB); pb.GB = (bf16*)(ws + WS_GB); pb.QC = (bf16*)(ws + WS_QC); pb.KM = (bf16*)(ws + WS_KM); pb.VM = (bf16*)(ws + WS_VM);
    bf16* CAT = (bf16*)(ws + WS_CAT); bf16* ACT = (bf16*)(ws + WS_ACT); bf16* YB = (bf16*)(ws + WS_YB);
    float* RET = (float*)(ws + WS_RKV); int* row_tok = (int*)(ws + WS_ROWTOK); float* row_w = (float*)(ws + WS_ROWW); int* toktab = (int*)(ws + WS_TOKTAB);

    Args a{};
    for (int i = 0; i < 22; ++i) a.in[i] = d_in[i];
    a.out = out; a.ws = ws;
    int li = 0;
#define MK(lo_, hi_) do { a.ph_lo = (lo_); a.ph_hi = (hi_); a.li = li++; hipLaunchKernelGGL(mk_fwd, dim3(grid), dim3(NWAVES * 64), LDS_BYTES, stream, a); } while (0)
    MK(0, 10);
#ifdef PROBE_PHASE
    a.pad = PROBE_SUB; MK(PROBE_PHASE, PROBE_PHASE + PROBE_COUNT);
#endif
#undef MK
}
```
